# Optimizing an MI355X kernel written in HIP

```python
import jax, jax.numpy as jnp
from jax import lax
import numpy as np

D_MODEL = 2048
BATCH = 1
SEQ = 8192
DEPTH = 2

P_DIM = 256
EPS = 1e-6
NEG = -1e30
BRANCH_WIDTH = 2048
N_BRANCH = 3

A_INNER = BRANCH_WIDTH
A_HEAD_DIM = 64
A_HEADS = A_INNER // A_HEAD_DIM
A_GROUPS = 8
A_STATE = 128
A_CONV = 4
A_CONV_CH = A_INNER + 2 * A_GROUPS * A_STATE
A_CHUNK = 128

B_HEADS = 16
B_KV_HEADS = 4
B_HEAD_DIM = BRANCH_WIDTH // B_HEADS
B_KV_DIM = B_KV_HEADS * B_HEAD_DIM
CMP_LEN = 32
CMP_STRIDE = 16
CMP_HIDDEN = 256
SEL_LEN = 64
SEL_TOPK = 16
SEL_LOCAL = 2
WINDOW = 512
Q_BLOCK = 128

C_HEADS = 8
C_HEAD_DIM = BRANCH_WIDTH // C_HEADS
C_CHUNK = 128
ROPE_BASE = 10000.0

IN_SIZES = (
    A_INNER, A_INNER, A_GROUPS * A_STATE, A_GROUPS * A_STATE, A_HEADS,
    BRANCH_WIDTH, B_KV_DIM, B_KV_DIM, B_KV_DIM, B_KV_DIM, B_KV_DIM, B_KV_DIM, 3 * B_HEADS, BRANCH_WIDTH,
    BRANCH_WIDTH, BRANCH_WIDTH, BRANCH_WIDTH, BRANCH_WIDTH,
    N_BRANCH * D_MODEL,
)
IN_DIM = sum(IN_SIZES)

kernel_name = 'hybrid_ssd_nsa_retention_block'


def rms_norm(x, gain=None):
    xf = x.astype(jnp.float32)
    y = xf * lax.rsqrt(jnp.mean(xf * xf, axis=-1, keepdims=True) + EPS)
    if gain is not None:
        y = y * gain.astype(jnp.float32)
    return y.astype(x.dtype)


def masked_softmax(s, mask):
    s = jnp.where(mask, s.astype(jnp.float32), NEG)
    return jax.nn.softmax(s, axis=-1) * mask


def causal_dwconv(u, w, b):
    k, c = w.shape
    y = lax.conv_general_dilated(u, w[:, None, :].astype(u.dtype), window_strides=(1,),
                                 padding=[(k - 1, 0)], dimension_numbers=('NWC', 'WIO', 'NWC'),
                                 feature_group_count=c)
    return y + b.astype(u.dtype)


def ssd_mixer(xs, z, bm, cm, dt, conv_w, conv_b, dt_bias, a_log, d_skip, norm_w):
    b, L, _ = xs.shape
    xbc = jax.nn.silu(causal_dwconv(jnp.concatenate([xs, bm, cm], axis=-1), conv_w, conv_b))
    xs, bm, cm = jnp.split(xbc, [A_INNER, A_INNER + A_GROUPS * A_STATE], axis=-1)
    dt = jax.nn.softplus((dt + dt_bias).astype(jnp.float32))
    a = -jnp.exp(a_log.astype(jnp.float32)) * dt
    nc, r = L // A_CHUNK, A_HEADS // A_GROUPS
    xh = xs.reshape(b, nc, A_CHUNK, A_GROUPS, r, A_HEAD_DIM)
    xdt = xh * dt.reshape(b, nc, A_CHUNK, A_GROUPS, r, 1).astype(xh.dtype)
    bm = bm.reshape(b, nc, A_CHUNK, A_GROUPS, A_STATE)
    cm = cm.reshape(b, nc, A_CHUNK, A_GROUPS, A_STATE)
    a_cs = jnp.cumsum(a.reshape(b, nc, A_CHUNK, A_GROUPS, r), axis=2)
    causal = jnp.tril(jnp.ones((A_CHUNK, A_CHUNK), dtype=bool))[None, None, :, :, None, None]
    seg = a_cs[:, :, :, None] - a_cs[:, :, None, :]
    decay = jnp.exp(jnp.where(causal, seg, -jnp.inf))
    cb = jnp.einsum('bclgn,bcsgn->bclsg', cm, bm)
    y_diag = jnp.einsum('bclsg,bclsgr,bcsgrp->bclgrp', cb, decay, xdt)
    decay_end = jnp.exp(a_cs[:, :, -1:] - a_cs)
    states = jnp.einsum('bclgn,bclgr,bclgrp->bcgrpn', bm, decay_end, xdt)
    chunk_decay = jnp.exp(a_cs[:, :, -1])

    def step(hs, inp):
        s_c, d_c = inp
        return hs * d_c[..., None, None] + s_c, hs

    h0 = jnp.zeros((b, A_GROUPS, r, A_HEAD_DIM, A_STATE), jnp.float32)
    _, prev = lax.scan(step, h0, (states.astype(jnp.float32).swapaxes(0, 1), chunk_decay.swapaxes(0, 1)))
    prev = prev.swapaxes(0, 1)
    y_off = jnp.einsum('bclgn,bcgrpn,bclgr->bclgrp', cm, prev, jnp.exp(a_cs))
    y = y_diag + y_off + xh * d_skip.reshape(A_GROUPS, r, 1)
    y = y.reshape(b, L, A_INNER).astype(xs.dtype)
    return rms_norm(y * jax.nn.silu(z), norm_w)


def compress(kv, pe, w1, w2):
    b, L, hk, d = kv.shape
    n_cmp = (L - CMP_LEN) // CMP_STRIDE + 1
    idx = np.arange(n_cmp)[:, None] * CMP_STRIDE + np.arange(CMP_LEN)[None, :]
    blocks = kv[:, idx] + pe[:, None, :]
    blocks = blocks.transpose(0, 1, 3, 2, 4).reshape(b, n_cmp, hk, CMP_LEN * d)
    return jax.nn.silu(blocks @ w1) @ w2


def nsa_mixer(q, kc, vc, ks, vs, kw, vw, gates, z, cmp_pe, cmp_w1, cmp_w2):
    b, L, _ = q.shape
    r = B_HEADS // B_KV_HEADS
    scale = B_HEAD_DIM ** -0.5
    q = q.reshape(b, L, B_KV_HEADS, r, B_HEAD_DIM)
    kvs = (b, L, B_KV_HEADS, B_HEAD_DIM)
    kc, vc, ks, vs, kw, vw = [t.reshape(kvs) for t in (kc, vc, ks, vs, kw, vw)]
    kc = compress(kc, cmp_pe[0], cmp_w1[0], cmp_w2[0])
    vc = compress(vc, cmp_pe[1], cmp_w1[1], cmp_w2[1])
    n_cmp, n_sel = kc.shape[1], L // SEL_LEN
    top_k = min(SEL_TOPK, n_sel)
    cmp_end = np.arange(n_cmp) * CMP_STRIDE + CMP_LEN - 1
    ci, sj = np.arange(n_cmp)[:, None], np.arange(n_sel)[None, :]
    overlap = jnp.asarray(((ci * CMP_STRIDE < (sj + 1) * SEL_LEN) &
                           (ci * CMP_STRIDE + CMP_LEN > sj * SEL_LEN)).astype(np.float32))
    pad = jnp.zeros((b, WINDOW, B_KV_HEADS, B_HEAD_DIM), kw.dtype)
    kw_p = jnp.concatenate([pad, kw], axis=1)
    vw_p = jnp.concatenate([pad, vw], axis=1)
    gates = jax.nn.sigmoid(gates.astype(jnp.float32)).reshape(b, L, B_KV_HEADS, r, 3)
    bidx = jnp.arange(b)[:, None, None, None]
    hidx = jnp.arange(B_KV_HEADS)[None, None, :, None]
    blk = jnp.arange(n_sel)

    def block(i):
        s0 = i * Q_BLOCK
        qb = lax.dynamic_slice_in_dim(q, s0, Q_BLOCK, axis=1)
        t = s0 + jnp.arange(Q_BLOCK)
        s_c = jnp.einsum('btgrd,bngd->bgrtn', qb, kc) * scale
        p_c = masked_softmax(s_c, cmp_end[None, :] <= t[:, None])
        o_c = jnp.einsum('bgrtn,bngd->btgrd', p_c.astype(vc.dtype), vc)
        imp = jnp.einsum('bgrtn,nj->btgj', p_c, overlap)
        cur = t // SEL_LEN
        eligible = blk[None, :] * SEL_LEN <= t[:, None]
        dist = cur[:, None] - blk[None, :]
        forced = (blk[None, :] == 0) | ((dist >= 0) & (dist < SEL_LOCAL))
        imp = jnp.where(forced[None, :, None, :], jnp.inf,
                        jnp.where(eligible[None, :, None, :], imp, -jnp.inf))
        top_val, top_idx = lax.top_k(imp, top_k)
        tok = (top_idx[..., None] * SEL_LEN + jnp.arange(SEL_LEN)).reshape(b, Q_BLOCK, B_KV_HEADS, top_k * SEL_LEN)
        tok_ok = jnp.repeat(top_val > -jnp.inf, SEL_LEN, axis=-1) & (tok <= t[None, :, None, None])
        k_sel = ks[bidx, tok, hidx]
        v_sel = vs[bidx, tok, hidx]
        s_s = jnp.einsum('btgrd,btgsd->btgrs', qb, k_sel) * scale
        p_s = masked_softmax(s_s, tok_ok[:, :, :, None, :])
        o_s = jnp.einsum('btgrs,btgsd->btgrd', p_s.astype(v_sel.dtype), v_sel)
        kwb = lax.dynamic_slice_in_dim(kw_p, s0, WINDOW + Q_BLOCK, axis=1)
        vwb = lax.dynamic_slice_in_dim(vw_p, s0, WINDOW + Q_BLOCK, axis=1)
        kpos = s0 - WINDOW + jnp.arange(WINDOW + Q_BLOCK)
        m_w = (kpos[None, :] <= t[:, None]) & (kpos[None, :] > t[:, None] - WINDOW) & (kpos[None, :] >= 0)
        s_w = jnp.einsum('btgrd,bsgd->bgrts', qb, kwb) * scale
        p_w = masked_softmax(s_w, m_w)
        o_w = jnp.einsum('bgrts,bsgd->btgrd', p_w.astype(vwb.dtype), vwb)
        gb = lax.dynamic_slice_in_dim(gates, s0, Q_BLOCK, axis=1)
        o = gb[..., 0:1] * o_c + gb[..., 1:2] * o_s + gb[..., 2:3] * o_w
        return o.astype(q.dtype)

    out = lax.map(block, jnp.arange(L // Q_BLOCK))
    out = out.transpose(1, 0, 2, 3, 4, 5).reshape(b, L, BRANCH_WIDTH)
    return out * jax.nn.silu(z)


def rotary(x, pos):
    d = x.shape[-1]
    inv = ROPE_BASE ** (-jnp.arange(0, d, 2, dtype=jnp.float32) / d)
    ang = pos.astype(jnp.float32)[:, None] * inv[None, :]
    cos = jnp.cos(ang)[None, :, None, :]
    sin = jnp.sin(ang)[None, :, None, :]
    xf = x.astype(jnp.float32)
    x1, x2 = xf[..., 0::2], xf[..., 1::2]
    out = jnp.stack([x1 * cos - x2 * sin, x1 * sin + x2 * cos], axis=-1).reshape(x.shape)
    return out.astype(x.dtype)


def retention_mixer(q, k, v, z, gn_w):
    b, L, _ = q.shape
    H, d, T = C_HEADS, C_HEAD_DIM, C_CHUNK
    nc = L // T
    pos = jnp.arange(L)
    q = rotary(q.reshape(b, L, H, d), pos).reshape(b, nc, T, H, d)
    k = (rotary(k.reshape(b, L, H, d), pos) * (d ** -0.5)).reshape(b, nc, T, H, d)
    v = v.reshape(b, nc, T, H, d)
    log_g = jnp.log1p(-jnp.exp2(-5.0 - jnp.arange(H, dtype=jnp.float32)))
    i = jnp.arange(T, dtype=jnp.float32)
    diff = i[:, None] - i[None, :]
    dmat = jnp.where(diff >= 0, jnp.exp(log_g[:, None, None] * jnp.maximum(diff, 0.0)), 0.0)
    s = jnp.einsum('bcihd,bcjhd->bchij', q, k) * dmat
    inner = jnp.einsum('bchij,bcjhe->bcihe', s.astype(v.dtype), v)
    zeta = jnp.exp(log_g[:, None] * (T - 1 - i)[None, :])
    kv = jnp.einsum('bcjhd,hj,bcjhe->bchde', k, zeta, v).astype(jnp.float32)
    chunk_decay = jnp.exp(log_g * T)

    def step(R, kv_c):
        return R * chunk_decay[:, None, None] + kv_c, R

    _, r_prev = lax.scan(step, jnp.zeros((b, H, d, d), jnp.float32), kv.swapaxes(0, 1))
    r_prev = r_prev.swapaxes(0, 1)
    xi = jnp.exp(log_g[:, None] * (i + 1.0)[None, :])
    cross = jnp.einsum('bcihd,hi,bchde->bcihe', q, xi, r_prev)
    o = (inner + cross).reshape(b, L, H, d).astype(jnp.float32)
    mu = jnp.mean(o, axis=-1, keepdims=True)
    var = jnp.mean(jnp.square(o - mu), axis=-1, keepdims=True)
    o = ((o - mu) * lax.rsqrt(var + EPS)).reshape(b, L, H * d) * gn_w.astype(jnp.float32)
    return (jax.nn.silu(z.astype(jnp.float32)) * o).astype(z.dtype)


def setup_inputs(seed: int = 0) -> dict:
    key = jax.random.key(seed)
    kk = jax.random.split(key, 21)
    f32 = jnp.float32

    def nrm(k, shape, fan_in):
        return jax.random.normal(k, shape, f32) * (fan_in ** -0.5)

    def gain(k, shape):
        return 1.0 + 0.02 * jax.random.normal(k, shape, f32)

    dt0 = jnp.exp(jax.random.uniform(kk[7], (DEPTH, A_HEADS), f32, np.log(1e-3), np.log(1e-1)))
    return {
        'x': jax.random.normal(kk[0], (BATCH, SEQ, D_MODEL), f32),
        'p': jax.random.normal(kk[1], (DEPTH, BATCH, SEQ, P_DIM), f32),
        'norm_pre': gain(kk[2], (DEPTH, D_MODEL)),
        'norm_post': gain(kk[3], (DEPTH, D_MODEL)),
        'w_in': nrm(kk[4], (DEPTH, D_MODEL, IN_DIM), D_MODEL),
        'conv_w': nrm(kk[5], (DEPTH, A_CONV, A_CONV_CH), A_CONV),
        'conv_b': 0.01 * jax.random.normal(kk[6], (DEPTH, A_CONV_CH), f32),
        'dt_bias': dt0 + jnp.log(-jnp.expm1(-dt0)),
        'a_log': jnp.log(jax.random.uniform(kk[8], (DEPTH, A_HEADS), f32, 1.0, 16.0)),
        'd_skip': gain(kk[9], (DEPTH, A_HEADS)),
        'ssm_norm': gain(kk[10], (DEPTH, A_INNER)),
        'cmp_pe': 0.02 * jax.random.normal(kk[11], (DEPTH, 2, CMP_LEN, B_HEAD_DIM), f32),
        'cmp_w1': nrm(kk[12], (DEPTH, 2, CMP_LEN * B_HEAD_DIM, CMP_HIDDEN), CMP_LEN * B_HEAD_DIM),
        'cmp_w2': nrm(kk[13], (DEPTH, 2, CMP_HIDDEN, B_HEAD_DIM), CMP_HIDDEN),
        'ret_norm': gain(kk[14], (DEPTH, BRANCH_WIDTH)),
        'w_branch': nrm(kk[15], (DEPTH, N_BRANCH, BRANCH_WIDTH, D_MODEL), BRANCH_WIDTH),
        'w_out': nrm(kk[16], (DEPTH, D_MODEL, D_MODEL), D_MODEL),
        'ple_proj': nrm(kk[17], (DEPTH, P_DIM, D_MODEL), P_DIM),
        'ple_gate': nrm(kk[18], (DEPTH, D_MODEL, D_MODEL), D_MODEL),
        'ple_norm': gain(kk[19], (DEPTH, D_MODEL)),
    }


def reference(x, p, norm_pre, norm_post, w_in, conv_w, conv_b, dt_bias, a_log, d_skip,
              ssm_norm, cmp_pe, cmp_w1, cmp_w2, ret_norm, w_branch, w_out,
              ple_proj, ple_gate, ple_norm):
    b, L, _ = x.shape
    offsets = np.cumsum(IN_SIZES)[:-1].tolist()
    for i in range(DEPTH):
        h = rms_norm(x, norm_pre[i])
        (xa, za, ba, ca, dta, qb, kcb, vcb, ksb, vsb, kwb, vwb, gb, zb,
         qc, kc, vc, zc, gm) = jnp.split(h @ w_in[i], offsets, axis=-1)
        ya = ssd_mixer(xa, za, ba, ca, dta, conv_w[i], conv_b[i], dt_bias[i], a_log[i], d_skip[i], ssm_norm[i])
        yb = nsa_mixer(qb, kcb, vcb, ksb, vsb, kwb, vwb, gb, zb, cmp_pe[i], cmp_w1[i], cmp_w2[i])
        yc = retention_mixer(qc, kc, vc, zc, ret_norm[i])
        u = jnp.einsum('bsjw,jwd->bsjd', jnp.stack([ya, yb, yc], axis=2), w_branch[i])
        gates = jax.nn.sigmoid(gm.astype(jnp.float32)).reshape(b, L, N_BRANCH, D_MODEL)
        merged = jnp.sum(gates * u, axis=2).astype(x.dtype)
        x = x + rms_norm(merged @ w_out[i], norm_post[i])
        e = p[i] @ ple_proj[i]
        g = jax.nn.sigmoid((rms_norm(x) @ ple_gate[i]).astype(jnp.float32)).astype(x.dtype)
        x = x + rms_norm(g * e, ple_norm[i])
    return x
```

```cpp
#include <hip/hip_runtime.h>
#include <cstdio>
#include <cstdint>
namespace pg8 {
#define PG8_LAS __attribute__((address_space(3)))
typedef unsigned short bf16_t;
typedef short bf16x8 __attribute__((ext_vector_type(8)));
typedef float f32x4 __attribute__((ext_vector_type(4)));
typedef unsigned u32x4 __attribute__((ext_vector_type(4)));
constexpr int BM = 256, BK = 64, HALF = 128, HTB = HALF * BK * 2  , STAGE_BYTES = 8 * HTB, NXCD = 8, WGM = 8;

__host__ __device__ __forceinline__ int lds_byte(int r, int c) { const int st = (r >> 4) * 2 + (c >> 5), rr = r & 15, cc = c & 31, ob = rr * 64 + cc * 2; return st * 1024 + (ob ^ (((ob >> 9) & 1) << 5)); }
__host__ __device__ __forceinline__ void stage_rc(int b, int& R, int& C) { const int st = b / 1024, sb = b % 1024, swz = sb ^ (((sb >> 9) & 1) << 5); R = (st >> 1) * 16 + swz / 64; C = (st & 1) * 32 + (swz % 64) / 2; }
__host__ __device__ __forceinline__ int perm32(int rho) { const int n = rho >> 4, i = rho & 15; return 8 * (i >> 2) + 4 * n + (i & 3); }

struct Unit { int pm, pn; };
struct Gemm { const bf16_t* A; const bf16_t* Bt; int M, N, K; };

struct StaticOrder {
    int nM, nN, nwg, G, c;
    __host__ __device__ void init(int M, int N, int G_, int c_) { nM = M / BM; nN = N / BM; nwg = nM * nN; G = G_; c = c_; }
    __host__ __device__ bool next(int i, Unit& u) const {
        const long L = (long)i * G + c; if (L >= nwg) return false;
        int wgid = (int)L; { const int q = nwg / NXCD, r = nwg % NXCD, xcd = wgid % NXCD, off = wgid / NXCD; wgid = (xcd < r ? xcd * (q + 1) : r * (q + 1) + (xcd - r) * q) + off; }
        const int nig = WGM * nN, gid = wgid / nig, fm = gid * WGM, gsz = (nM - fm) < WGM ? (nM - fm) : WGM;
        u.pm = fm + ((wgid % nig) % gsz); u.pn = (wgid % nig) / gsz; return true;
    }
    __device__ __forceinline__ void a_ready(const Unit&) const {}
    __device__ __forceinline__ void done(const Unit&) const {}
};
__device__ __forceinline__ unsigned cvt_pk_bf16(float lo, float hi) { unsigned r; asm volatile("v_cvt_pk_bf16_f32 %0, %1, %2" : "=v"(r) : "v"(lo), "v"(hi)); return r; }
typedef unsigned u32x2 __attribute__((ext_vector_type(2)));
__device__ __forceinline__ float sigmoidf_(float x) { return 1.0f / (1.0f + __expf(-x)); }
__device__ __forceinline__ float bflo(unsigned w) { return __uint_as_float(w << 16); }
__device__ __forceinline__ float bfhi(unsigned w) { return __uint_as_float(w & 0xffff0000u); }

struct EpiF32 {
    static constexpr bool PERM = false, AFTER_DRAIN = false;
    float* C; int ldc;
    __device__ __forceinline__ void operator()(const f32x4 (&acc)[2][2][4][2], const Unit& u, int wr, int wc, int fr, int fq) const {
        const int row0 = u.pm * BM + wr * 64 + fr, col0 = u.pn * BM + wc * 32 + 4 * fq;
#pragma unroll
        for (int ai = 0; ai < 2; ++ai)
#pragma unroll
            for (int m = 0; m < 4; ++m) { float* rowp = C + (size_t)(row0 + ai * HALF + m * 16) * ldc + col0;
#pragma unroll
                for (int bj = 0; bj < 2; ++bj)
#pragma unroll
                    for (int n = 0; n < 2; ++n) *(f32x4*)(rowp + bj * HALF + n * 16) = acc[ai][bj][m][n]; }
    }
};
struct EpiInProj {
    static constexpr bool PERM = true, AFTER_DRAIN = false;
    bf16_t* O; int ldc; float* S; int nbf;
    __device__ __forceinline__ void operator()(const f32x4 (&acc)[2][2][4][2], const Unit& u, int wr, int wc, int fr, int fq) const {
        const int row0 = u.pm * BM + wr * 64 + fr;
        if (u.pn < nbf) {
            const int col0 = u.pn * BM + wc * 32 + 8 * fq;
#pragma unroll
            for (int ai = 0; ai < 2; ++ai)
#pragma unroll
                for (int m = 0; m < 4; ++m) { bf16_t* rowp = O + (size_t)(row0 + ai * HALF + m * 16) * ldc + col0;
#pragma unroll
                    for (int bj = 0; bj < 2; ++bj) { const f32x4 v0 = acc[ai][bj][m][0], v1 = acc[ai][bj][m][1];
                        u32x4 w; w.x = cvt_pk_bf16(v0[0], v0[1]); w.y = cvt_pk_bf16(v0[2], v0[3]); w.z = cvt_pk_bf16(v1[0], v1[1]); w.w = cvt_pk_bf16(v1[2], v1[3]);
                        *(u32x4*)(rowp + bj * HALF) = w; } }
        } else {
            const int col0 = wc * 32 + 8 * fq;
#pragma unroll
            for (int ai = 0; ai < 2; ++ai)
#pragma unroll
                for (int m = 0; m < 4; ++m) { float* rowp = S + (size_t)(row0 + ai * HALF + m * 16) * 256 + col0;
#pragma unroll
                    for (int bj = 0; bj < 2; ++bj)
#pragma unroll
                        for (int n = 0; n < 2; ++n) *(f32x4*)(rowp + bj * HALF + 4 * n) = acc[ai][bj][m][n]; }
        }
    }
};
template <int J> struct EpiBranch {
    static constexpr bool PERM = false, AFTER_DRAIN = false;
    bf16_t* T; bf16_t* MB; const bf16_t* GM; int ldg; const float* rowss; float eps;
    __device__ __forceinline__ void operator()(const f32x4 (&acc)[2][2][4][2], const Unit& u, int wr, int wc, int fr, int fq) const {
        const int row0 = u.pm * BM + wr * 64 + fr, col0 = u.pn * BM + wc * 32 + 4 * fq;
#pragma unroll
        for (int ai = 0; ai < 2; ++ai)
#pragma unroll
            for (int m = 0; m < 4; ++m) { const int row = row0 + ai * HALF + m * 16; float rs = 1.0f;
                if (J == 0) rs = rsqrtf(rowss[row] * (1.0f / 2048.0f) + eps);
#pragma unroll
                for (int bj = 0; bj < 2; ++bj)
#pragma unroll
                    for (int n = 0; n < 2; ++n) { const int col = col0 + bj * HALF + n * 16;
                        const u32x2 gw = *(const u32x2*)(GM + (size_t)row * ldg + col);
                        f32x4 g; g[0] = sigmoidf_(bflo(gw.x)); g[1] = sigmoidf_(bfhi(gw.x)); g[2] = sigmoidf_(bflo(gw.y)); g[3] = sigmoidf_(bfhi(gw.y));
                        f32x4 v = acc[ai][bj][m][n] * g * rs;
                        bf16_t* tp = T + (size_t)row * 2048 + col;
                        if (J > 0) { const u32x2 tw = *(const u32x2*)tp; v[0] += bflo(tw.x); v[1] += bfhi(tw.x); v[2] += bflo(tw.y); v[3] += bfhi(tw.y); }
                        u32x2 w; w.x = cvt_pk_bf16(v[0], v[1]); w.y = cvt_pk_bf16(v[2], v[3]);
                        *(u32x2*)((J < 2 ? tp : MB + (size_t)row * 2048 + col)) = w; } }
    }
};
template <int GATE> struct EpiRowSS {
    static constexpr bool PERM = false, AFTER_DRAIN = false;
    float* C; const float* E; float* rowss;
    __device__ __forceinline__ void operator()(const f32x4 (&acc)[2][2][4][2], const Unit& u, int wr, int wc, int fr, int fq) const {
        const int row0 = u.pm * BM + wr * 64 + fr, col0 = u.pn * BM + wc * 32 + 4 * fq;
#pragma unroll
        for (int ai = 0; ai < 2; ++ai)
#pragma unroll
            for (int m = 0; m < 4; ++m) { const int row = row0 + ai * HALF + m * 16; float ss = 0.f;
#pragma unroll
                for (int bj = 0; bj < 2; ++bj)
#pragma unroll
                    for (int n = 0; n < 2; ++n) { const int col = col0 + bj * HALF + n * 16; f32x4 v = acc[ai][bj][m][n];
                        if (GATE) { const f32x4 e = *(const f32x4*)(E + (size_t)row * 2048 + col);
                            v[0] = sigmoidf_(v[0]) * e[0]; v[1] = sigmoidf_(v[1]) * e[1]; v[2] = sigmoidf_(v[2]) * e[2]; v[3] = sigmoidf_(v[3]) * e[3]; }
                        ss += (v[0] * v[0] + v[1] * v[1]) + (v[2] * v[2] + v[3] * v[3]);
                        *(f32x4*)(C + (size_t)row * 2048 + col) = v; }
                ss += __shfl_xor(ss, 16); ss += __shfl_xor(ss, 32);
                if (fq == 0) atomicAdd(rowss + row, ss); }
    }
};
struct EpiCmp1 {
    static constexpr bool PERM = true, AFTER_DRAIN = false;
    bf16_t* O; const float* hb;
    __device__ __forceinline__ void operator()(const f32x4 (&acc)[2][2][4][2], const Unit& u, int wr, int wc, int fr, int fq) const {
        const int row0 = u.pm * BM + wr * 64 + fr, col0 = wc * 32 + 8 * fq;
#pragma unroll
        for (int ai = 0; ai < 2; ++ai)
#pragma unroll
            for (int m = 0; m < 4; ++m) { bf16_t* rowp = O + (size_t)(row0 + ai * HALF + m * 16) * 256 + col0;
#pragma unroll
                for (int bj = 0; bj < 2; ++bj) { f32x4 v0 = acc[ai][bj][m][0] + *(const f32x4*)(hb + col0 + bj * HALF), v1 = acc[ai][bj][m][1] + *(const f32x4*)(hb + col0 + bj * HALF + 4);
#pragma unroll
                    for (int j = 0; j < 4; ++j) { v0[j] = v0[j] * sigmoidf_(v0[j]); v1[j] = v1[j] * sigmoidf_(v1[j]); }
                    u32x4 w; w.x = cvt_pk_bf16(v0[0], v0[1]); w.y = cvt_pk_bf16(v0[2], v0[3]); w.z = cvt_pk_bf16(v1[0], v1[1]); w.w = cvt_pk_bf16(v1[2], v1[3]);
                    *(u32x4*)(rowp + bj * HALF) = w; } }
    }
};
struct EpiCmp2 {
    static constexpr bool PERM = true, AFTER_DRAIN = false;
    bf16_t* O;
    __device__ __forceinline__ void operator()(const f32x4 (&acc)[2][2][4][2], const Unit& u, int wr, int wc, int fr, int fq) const {
        const int row0 = u.pm * BM + wr * 64 + fr, col0 = wc * 32 + 8 * fq;
#pragma unroll
        for (int ai = 0; ai < 2; ++ai)
#pragma unroll
            for (int m = 0; m < 4; ++m) { bf16_t* rowp = O + (size_t)(row0 + ai * HALF + m * 16) * 128 + col0;
                const f32x4 v0 = acc[ai][0][m][0], v1 = acc[ai][0][m][1];
                u32x4 w; w.x = cvt_pk_bf16(v0[0], v0[1]); w.y = cvt_pk_bf16(v0[2], v0[3]); w.z = cvt_pk_bf16(v1[0], v1[1]); w.w = cvt_pk_bf16(v1[2], v1[3]);
                *(u32x4*)rowp = w; }
    }
};
template <class Epi, class Sched, bool ALIGN_EPI = false, bool SP2 = false>
__device__ __forceinline__ void gemm_phase(PG8_LAS unsigned char* lds, const Gemm g, const Sched& S, const Epi& E) {
    int tid_ = threadIdx.x; asm volatile("" : "+v"(tid_));
    const int tid = tid_, wid = __builtin_amdgcn_readfirstlane(tid >> 6), lane = tid & 63, wr = wid >> 2, wc = wid & 3, fr = lane & 15, fq = lane >> 4;
    const int K = g.K, nt = K / BK;
    unsigned voffA[2], voffB[2];
#pragma unroll
    for (int i = 0; i < 2; ++i) { int R, C; stage_rc(tid * 16 + i * 8192, R, C); const int Rb = Epi::PERM ? ((R & ~31) + perm32(R & 31)) : R;
        voffA[i] = (unsigned)(R * K + C) * 2u; voffB[i] = (unsigned)(Rb * K + C) * 2u; }
    const size_t kstep = (size_t)(BK * 2);
    const size_t hstep = (size_t)HALF * K * 2;
    const size_t tstep = 2 * hstep;
    const unsigned ldsw = (unsigned)wid * 1024u;
    const int aoff = lds_byte(wr * 64 + fr, fq * 8), boff = lds_byte(wc * 32 + fr, fq * 8);
#define PG8_SA(b, h) (((b) * 2 + (h)) * HTB)
#define PG8_SB(b, h) ((4 + (b) * 2 + (h)) * HTB)
#define PG8_STAGE(bufoff, gbase, voff) do { _Pragma("unroll") for (int _i = 0; _i < 2; ++_i) \
        __builtin_amdgcn_global_load_lds((const unsigned*)((const char*)(gbase) + (voff)[_i]), (PG8_LAS unsigned*)(lds + (bufoff) + ldsw + _i * 8192), 16, 0, 0); } while (0)
#define PG8_LDA(dst, b, h) do { _Pragma("unroll") for (int m = 0; m < 4; ++m) _Pragma("unroll") for (int k = 0; k < 2; ++k) dst[m][k] = *(const PG8_LAS bf16x8*)(lds + PG8_SA(b, h) + aoff + m * 2048 + k * 1024); } while (0)
#define PG8_LDB(dst, b, h) do { _Pragma("unroll") for (int n = 0; n < 2; ++n) _Pragma("unroll") for (int k = 0; k < 2; ++k) dst[n][k] = *(const PG8_LAS bf16x8*)(lds + PG8_SB(b, h) + boff + n * 2048 + k * 1024); } while (0)
#define PG8_MMA(ai, bj, At, Bt) do { __builtin_amdgcn_s_setprio(1); _Pragma("unroll") for (int m = 0; m < 4; ++m) _Pragma("unroll") for (int n = 0; n < 2; ++n) _Pragma("unroll") for (int k = 0; k < 2; ++k) \
        acc[ai][bj][m][n] = __builtin_amdgcn_mfma_f32_16x16x32_bf16(Bt[n][k], At[m][k], acc[ai][bj][m][n], 0, 0, 0); __builtin_amdgcn_s_setprio(0); } while (0)
#define PG8_WAIT_V(n) asm volatile("s_waitcnt vmcnt(" #n ")" ::: "memory")
#define PG8_WAIT_L(n) asm volatile("s_waitcnt lgkmcnt(" #n ")" ::: "memory")
#define PG8_BAR __builtin_amdgcn_s_barrier()
#define PG8_SCHED __builtin_amdgcn_sched_barrier(0)
    Unit cur, nxt; int ui = 0;
    if (!S.next(0, cur)) return;
    f32x4 acc[2][2][4][2];
#pragma unroll
    for (int a = 0; a < 2; ++a)
#pragma unroll
        for (int b = 0; b < 2; ++b)
#pragma unroll
            for (int m = 0; m < 4; ++m)
#pragma unroll
                for (int n = 0; n < 2; ++n) acc[a][b][m][n] = (f32x4){0.f, 0.f, 0.f, 0.f};
    bf16x8 At[4][2], B0[2][2], B1[2][2];
    const char* cA = (const char*)g.A + (size_t)cur.pm * tstep; const char* cB = (const char*)g.Bt + (size_t)cur.pn * tstep;
    S.a_ready(cur);
    if constexpr (SP2) {
        PG8_STAGE(PG8_SB(0, 0), cB, voffB); PG8_STAGE(PG8_SB(0, 1), cB + hstep, voffB); PG8_STAGE(PG8_SA(0, 0), cA, voffA); PG8_STAGE(PG8_SA(0, 1), cA + hstep, voffA);
        if (wr == 1) PG8_BAR;
        PG8_WAIT_V(2); PG8_BAR;
        PG8_STAGE(PG8_SB(1, 0), cB + kstep, voffB); PG8_STAGE(PG8_SA(1, 0), cA + kstep, voffA); PG8_STAGE(PG8_SB(1, 1), cB + hstep + kstep, voffB);
        PG8_WAIT_V(6); PG8_BAR;
    } else {
        PG8_STAGE(PG8_SB(0, 0), cB, voffB); PG8_STAGE(PG8_SA(0, 0), cA, voffA); PG8_STAGE(PG8_SB(0, 1), cB + hstep, voffB); PG8_STAGE(PG8_SA(0, 1), cA + hstep, voffA);
        if (wr == 1) PG8_BAR;
        PG8_WAIT_V(4); PG8_BAR;
        PG8_STAGE(PG8_SB(1, 0), cB + kstep, voffB); PG8_STAGE(PG8_SA(1, 0), cA + kstep, voffA); PG8_STAGE(PG8_SB(1, 1), cB + hstep + kstep, voffB);
        PG8_WAIT_V(6); PG8_BAR;
    }
    for (;;) {
        const bool has_next = S.next(ui + 1, nxt);
        const char* nA = has_next ? (const char*)g.A + (size_t)nxt.pm * tstep : cA; const char* nB = has_next ? (const char*)g.Bt + (size_t)nxt.pn * tstep : cB;
        for (int t = 0; t < nt; t += 2) {
            const bool last = (t == nt - 2);
            const char* a1 = cA + (size_t)(t + 1) * kstep;
            const char* a2 = last ? nA : cA + (size_t)(t + 2) * kstep; const char* b2 = last ? nB : cB + (size_t)(t + 2) * kstep;
            const char* a3 = a2 + kstep; const char* b3 = b2 + kstep;
            if (last && has_next) S.a_ready(nxt);
            if constexpr (SP2) {
            PG8_LDB(B0, 0, 0); PG8_LDB(B1, 0, 1); PG8_SCHED; PG8_LDA(At, 0, 0); PG8_STAGE(PG8_SA(1, 1), a1 + hstep, voffA);
            PG8_WAIT_V(8); PG8_WAIT_L(0); PG8_BAR; PG8_MMA(0, 0, At, B0); PG8_MMA(0, 1, At, B1); PG8_BAR; PG8_SCHED;
            PG8_LDA(At, 0, 1); PG8_STAGE(PG8_SB(0, 0), b2, voffB); PG8_STAGE(PG8_SB(0, 1), b2 + hstep, voffB); PG8_STAGE(PG8_SA(0, 0), a2, voffA);
            PG8_WAIT_V(8); PG8_WAIT_L(0); PG8_BAR; PG8_MMA(1, 0, At, B0); PG8_MMA(1, 1, At, B1); PG8_BAR; PG8_SCHED;
            PG8_LDB(B0, 1, 0); PG8_LDB(B1, 1, 1); PG8_SCHED; PG8_LDA(At, 1, 0); PG8_STAGE(PG8_SA(0, 1), a2 + hstep, voffA);
            PG8_WAIT_V(8); PG8_WAIT_L(0); PG8_BAR; PG8_MMA(0, 0, At, B0); PG8_MMA(0, 1, At, B1); PG8_BAR; PG8_SCHED;
            PG8_LDA(At, 1, 1); PG8_STAGE(PG8_SB(1, 0), b3, voffB); PG8_STAGE(PG8_SB(1, 1), b3 + hstep, voffB); PG8_STAGE(PG8_SA(1, 0), a3, voffA);
            PG8_WAIT_V(8); PG8_WAIT_L(0); PG8_BAR; PG8_MMA(1, 0, At, B0); PG8_MMA(1, 1, At, B1); PG8_BAR; PG8_SCHED;
            } else {
            PG8_LDB(B0, 0, 0); PG8_SCHED; PG8_LDA(At, 0, 0); PG8_STAGE(PG8_SA(1, 1), a1 + hstep, voffA);
            PG8_WAIT_L(8); PG8_BAR; PG8_WAIT_L(0); PG8_MMA(0, 0, At, B0); PG8_BAR; PG8_SCHED;
            PG8_LDB(B1, 0, 1); PG8_STAGE(PG8_SB(0, 0), b2, voffB);
            PG8_BAR; PG8_WAIT_L(0); PG8_MMA(0, 1, At, B1); PG8_BAR;
            PG8_LDA(At, 0, 1); PG8_STAGE(PG8_SA(0, 0), a2, voffA);
            PG8_BAR; PG8_WAIT_L(0); PG8_MMA(1, 0, At, B0); PG8_BAR; PG8_SCHED;
            PG8_STAGE(PG8_SB(0, 1), b2 + hstep, voffB);
            PG8_WAIT_V(6); PG8_BAR; PG8_MMA(1, 1, At, B1); PG8_BAR;
            PG8_LDB(B0, 1, 0); PG8_SCHED; PG8_LDA(At, 1, 0); PG8_STAGE(PG8_SA(0, 1), a2 + hstep, voffA);
            PG8_WAIT_L(8); PG8_BAR; PG8_WAIT_L(0); PG8_MMA(0, 0, At, B0); PG8_BAR; PG8_SCHED;
            PG8_LDB(B1, 1, 1); PG8_STAGE(PG8_SB(1, 0), b3, voffB);
            PG8_BAR; PG8_WAIT_L(0); PG8_MMA(0, 1, At, B1); PG8_BAR;
            PG8_LDA(At, 1, 1); PG8_STAGE(PG8_SA(1, 0), a3, voffA);
            PG8_BAR; PG8_WAIT_L(0); PG8_MMA(1, 0, At, B0); PG8_BAR; PG8_SCHED;
            PG8_STAGE(PG8_SB(1, 1), b3 + hstep, voffB);
            PG8_WAIT_V(6); PG8_BAR; PG8_MMA(1, 1, At, B1); PG8_BAR;
            }
        }
        if constexpr (ALIGN_EPI) { if (wr == 0) PG8_BAR; }
        if constexpr (!Epi::AFTER_DRAIN) { E(acc, cur, wr, wc, fr, fq); S.done(cur); }
        if (!has_next) break;
#pragma unroll
        for (int a = 0; a < 2; ++a)
#pragma unroll
            for (int b = 0; b < 2; ++b)
#pragma unroll
                for (int m = 0; m < 4; ++m)
#pragma unroll
                    for (int n = 0; n < 2; ++n) acc[a][b][m][n] = (f32x4){0.f, 0.f, 0.f, 0.f};
        cur = nxt; cA = nA; cB = nB; ++ui;
        if constexpr (ALIGN_EPI) { if (wr == 1) PG8_BAR; }
    }
    PG8_WAIT_V(0);
    if constexpr (!ALIGN_EPI) { if (wr == 0) PG8_BAR; }
    PG8_BAR;
    if constexpr (Epi::AFTER_DRAIN) { E.fused(acc, cur, wr, wc, fr, fq, lds, wid, lane); S.done(cur); }
#undef PG8_SA
#undef PG8_SB
#undef PG8_STAGE
#undef PG8_LDA
#undef PG8_LDB
#undef PG8_MMA
#undef PG8_WAIT_V
#undef PG8_WAIT_L
#undef PG8_BAR
#undef PG8_SCHED
}
}

constexpr int L_SEQ = 8192, DM = 2048, NLAYER = 2, PDIM = 256;
constexpr int IN_DIM = 27728;
constexpr int NPROJ = 27648;
constexpr int NPAD = 27904;
constexpr int C_XA = 0, C_ZA = 2048, C_BA = 4096, C_CA = 5120, C_QB = 6144, C_KCB = 8192, C_VCB = 8704, C_KSB = 9216, C_VSB = 9728, C_KWB = 10240, C_VWB = 10752,
              C_ZB = 11264, C_QC = 13312, C_KC = 15360, C_VC = 17408, C_ZC = 19456, C_GM = 21504;
constexpr int S_XA = 0, S_DTA = 6144, S_QB = 6176, S_GB = 11296, S_ZB = 11344;
constexpr float EPS = 1e-6f;
constexpr int NCMP = 511;

constexpr size_t MiB = 1u << 20;
constexpr size_t WS_CTL = 0, CTL_ZERO_BYTES = 1 * MiB;
constexpr size_t ROWSS_OFF = 512 * 1024;
constexpr size_t SZ_WIN = (size_t)NPAD * DM * 2;
constexpr size_t WS_WIN = 1 * MiB;
constexpr size_t WS_WBR = WS_WIN + 2 * SZ_WIN;
constexpr size_t WS_WOUT = WS_WBR + 6 * 8 * MiB;
constexpr size_t WS_WGATE = WS_WOUT + 2 * 8 * MiB;
constexpr size_t WS_WPP = WS_WGATE + 2 * 8 * MiB;
constexpr size_t WS_WC1 = WS_WPP + 2 * MiB;
constexpr size_t WS_WC2 = WS_WC1 + 8 * MiB;
constexpr size_t WS_HB = WS_WC2 + 512 * 1024;
constexpr size_t WS_PBF = WS_HB + 512 * 1024;
constexpr size_t WS_HBF = WS_PBF + 8 * MiB;
constexpr size_t WS_PROJ = WS_HBF + 32 * MiB;
constexpr size_t WS_SMALL = WS_PROJ + (size_t)L_SEQ * NPROJ * 2;
constexpr size_t WS_EBUF = WS_SMALL + 8 * MiB;
constexpr size_t WS_AIM = WS_EBUF + 64 * MiB;
constexpr size_t WS_HID = WS_AIM + 32 * MiB;
constexpr size_t WS_KVC = WS_HID + 2 * MiB;
constexpr size_t WS_ACS = WS_KVC + 1 * MiB;
constexpr size_t WS_DTV = WS_ACS + 1 * MiB;
constexpr size_t WS_CD = WS_DTV + 1 * MiB;
constexpr size_t WS_ST = WS_CD + 1 * MiB;
constexpr size_t WS_KVT = WS_ST + 64 * MiB;
constexpr size_t WS_YA = WS_KVT + 128 * MiB;
constexpr size_t WS_YB = WS_YA + 32 * MiB;
constexpr size_t WS_YC = WS_YB + 32 * MiB;
constexpr size_t WS_TF = WS_YC + 32 * MiB;
constexpr size_t WS_MB = WS_TF + 64 * MiB;
constexpr size_t WS_X1 = WS_MB + 32 * MiB;
constexpr size_t WS_XL = WS_X1 + 64 * MiB;
constexpr size_t WS_ROT = WS_XL + 64 * MiB;
constexpr size_t WS_HBP = WS_ROT + 8 * MiB;
constexpr size_t WS_END = WS_HBP + 1 * MiB;

constexpr int CW_BAR = 4096;

constexpr int LDS_BYTES = 155648;
constexpr int MISC_OFF = 154624;

#define GAS __attribute__((address_space(1)))
#define LAS __attribute__((address_space(3)))
typedef unsigned short bf16;
typedef short bf16x8 __attribute__((ext_vector_type(8)));
typedef float f32x4 __attribute__((ext_vector_type(4)));
typedef unsigned u32x4 __attribute__((ext_vector_type(4)));
typedef unsigned u32x2 __attribute__((ext_vector_type(2)));

__device__ __forceinline__ unsigned f2bf(float f) { unsigned u = __builtin_bit_cast(unsigned, f); return (u + 0x7fffu + ((u >> 16) & 1u)) >> 16; }
__device__ __forceinline__ unsigned pk2(float lo, float hi) { return f2bf(lo) | (f2bf(hi) << 16); }
__device__ __forceinline__ float bf2f(unsigned short b) { return __uint_as_float(((unsigned)b) << 16); }
__device__ __forceinline__ float blo(unsigned w) { return __uint_as_float(w << 16); }
__device__ __forceinline__ float bhi(unsigned w) { return __uint_as_float(w & 0xffff0000u); }
__device__ __forceinline__ float sigm(float x) { return 1.0f / (1.0f + __expf(-x)); }
__device__ __forceinline__ float siluf(float x) { return x * sigm(x); }
__device__ __forceinline__ float wave_sum(float v) {
#pragma unroll
    for (int o = 1; o < 64; o <<= 1) v += __shfl_xor(v, o);
    return v;
}
__device__ __forceinline__ int fresh(int x) { asm volatile("" : "+v"(x)); return x; }
__device__ __forceinline__ int fresh_s(int x) { asm volatile("" : "+s"(x)); return x; }
#define LDS_WAIT() asm volatile("s_waitcnt lgkmcnt(0)" ::: "memory")

#define XB_TMO      128
#define XB_XCNT(j)  (256  + 64 * (j))
#define XB_XSUB(j)  (1280 + 64 * (j))
#define XB_XGEN(j)  (2304 + 64 * (j))
#define XB_TOP      3328
#define XB_TOPGEN   3392
#define XCD_BAR_WORDS 3456
#define XB_SPIN_CAP (1u << 18)
__device__ __forceinline__ unsigned xb_ld(unsigned* p)              { return __hip_atomic_load(p, __ATOMIC_RELAXED, __HIP_MEMORY_SCOPE_AGENT); }
__device__ __forceinline__ unsigned xb_add(unsigned* p, unsigned v) { return __hip_atomic_fetch_add(p, v, __ATOMIC_RELAXED, __HIP_MEMORY_SCOPE_AGENT); }
__device__ __forceinline__ unsigned xb_xcc_id() { return (unsigned)__builtin_amdgcn_s_getreg((3 << 11) | 20) & 0xFu; }
#define XB_SPIN(cond, bar) do { unsigned _sp = 0; while (cond) { __builtin_amdgcn_s_sleep(1); \
    if ((++_sp & 255u) == 0u) { if (xb_ld(&(bar)[XB_TMO])) break; if (_sp > XB_SPIN_CAP) { atomicAdd(&(bar)[XB_TMO], 1u); break; } } } } while (0)
struct XcdBarrier { unsigned* bar; unsigned x; volatile LAS unsigned* st; };
__device__ __forceinline__ XcdBarrier xcd_barrier_post(unsigned* bar, volatile LAS unsigned* st) {
    XcdBarrier b; b.bar = bar; b.x = xb_xcc_id(); b.st = st;
    if (threadIdx.x == 0) (void)xb_add(&bar[XB_XCNT(b.x)], 1u);
    return b;
}
__device__ __forceinline__ void xcd_barrier_complete(unsigned* bar, unsigned x, unsigned& nloc, unsigned& nx) {
    const unsigned G = gridDim.x * gridDim.y * gridDim.z;
    unsigned sum, cnt, mine, sp = 0u;
    for (;;) {
        sum = 0u; cnt = 0u; mine = 0u;
#pragma unroll
        for (unsigned j = 0; j < 16; ++j) { const unsigned c = xb_ld(&bar[XB_XCNT(j)]); sum += c; cnt += (c > 0u) ? 1u : 0u; mine = (j == x) ? c : mine; }
        if (sum == G) break;
        __builtin_amdgcn_s_sleep(1);
        if ((++sp & 255u) == 0u) { if (xb_ld(&bar[XB_TMO])) break; if (sp > XB_SPIN_CAP) { atomicAdd(&bar[XB_TMO], 1u); break; } }
    }
    nloc = mine > 0u ? mine : 1u; nx = cnt > 0u ? cnt : 1u;
}
__device__ __forceinline__ void xcd_barrier(const XcdBarrier& b) {
    asm volatile("s_waitcnt vmcnt(0)" ::: "memory");
    __syncthreads();
    if (threadIdx.x == 0) {
        unsigned* bar = b.bar;
        __builtin_amdgcn_s_waitcnt(0);
        unsigned nloc = b.st[0], nx = b.st[1];
        if (nloc == 0u) { xcd_barrier_complete(bar, b.x, nloc, nx); b.st[0] = nloc; b.st[1] = nx; }
        const unsigned old = xb_add(&bar[XB_XSUB(b.x)], 1u);
        const unsigned gen = old / nloc;
        if (old + 1u == (gen + 1u) * nloc) {
            __builtin_amdgcn_fence(__ATOMIC_RELEASE, "agent");
            asm volatile("s_waitcnt vmcnt(0)" ::: "memory");
            const unsigned og = xb_add(&bar[XB_TOP], 1u);
            const unsigned tg = og / nx;
            if (og + 1u == (tg + 1u) * nx) xb_add(&bar[XB_TOPGEN], 1u);
            else XB_SPIN(xb_ld(&bar[XB_TOPGEN]) == tg, bar);
            __builtin_amdgcn_fence(__ATOMIC_ACQUIRE, "agent");
            xb_add(&bar[XB_XGEN(b.x)], 1u);
            asm volatile("s_waitcnt vmcnt(0)" ::: "memory");
        } else {
            XB_SPIN(xb_ld(&bar[XB_XGEN(b.x)]) == gen, bar);
            __builtin_amdgcn_fence(__ATOMIC_ACQUIRE, "agent");
            asm volatile("s_waitcnt vmcnt(0)" ::: "memory");
        }
    }
    __syncthreads();
}

struct Args { const float* in[20]; float* out; unsigned char* ws; int ph_lo, ph_hi, use_bar, pad; };
typedef const __attribute__((address_space(4))) Args* ArgsP;
__device__ __forceinline__ ArgsP argp() { ArgsP p = (ArgsP)__builtin_amdgcn_kernarg_segment_ptr(); asm volatile("" : "+s"(p)); return p; }

__device__ __forceinline__ f32x4 mma16(bf16x8 x, bf16x8 y, f32x4 c) { return __builtin_amdgcn_mfma_f32_16x16x32_bf16(x, y, c, 0, 0, 0); }
__device__ __forceinline__ bf16x8 ldfrag(const LAS bf16* base, int stride, int row, int k) { return *(const LAS bf16x8*)(base + row * stride + k); }

struct TItem { const float* W; bf16* WT; int ldw, K, k0, src0, src1, ndst0; };
__device__ __forceinline__ void titem_load(const TItem& T, f32x4 (&v)[16], int lane) {
    const int col = (lane & 15) * 4, src = (col >> 5) ? T.src1 : T.src0;
#pragma unroll
    for (int i = 0; i < 16; ++i) { const int kk = 4 * i + (lane >> 4); v[i] = src >= 0 ? __builtin_nontemporal_load((const f32x4*)(T.W + (size_t)(T.k0 + kk) * T.ldw + src + (col & 31))) : (f32x4){0.f, 0.f, 0.f, 0.f}; }
}
__device__ __forceinline__ void titem_finish(const TItem& T, const f32x4 (&v)[16], LAS float* scr, int lane) {
    const int col = (lane & 15) * 4;
#pragma unroll
    for (int i = 0; i < 16; ++i) { const int kk = 4 * i + (lane >> 4); LAS float* d = scr + kk * 65 + col; d[0] = v[i][0]; d[1] = v[i][1]; d[2] = v[i][2]; d[3] = v[i][3]; }
    LDS_WAIT(); asm volatile("" ::: "memory");
    const int c = lane & 7;
#pragma unroll
    for (int j = 0; j < 8; ++j) { const int n = (lane >> 3) + 8 * j; const LAS float* s = scr + (8 * c) * 65 + n;
        u32x4 o; o.x = pk2(s[0 * 65], s[1 * 65]); o.y = pk2(s[2 * 65], s[3 * 65]); o.z = pk2(s[4 * 65], s[5 * 65]); o.w = pk2(s[6 * 65], s[7 * 65]);
        *(u32x4*)(T.WT + (size_t)(T.ndst0 + n) * T.K + T.k0 + 8 * c) = o; }
    LDS_WAIT(); asm volatile("" ::: "memory");
}
__device__ __forceinline__ TItem titem_plain(const float* W, int K, int N, int Npad, bf16* WT, int item) {
    const int nblk = Npad / 64, kb = item / nblk, nb = item % nblk, n0 = 64 * nb;
    TItem T; T.W = W; T.WT = WT; T.ldw = N; T.K = K; T.k0 = 64 * kb; T.src0 = n0 < N ? n0 : -1; T.src1 = n0 + 32 < N ? n0 + 32 : -1; T.ndst0 = n0; return T;
}
__device__ __forceinline__ int win_src(int n0) {
    if (n0 < 6144) return n0; if (n0 < 11264) return n0 + 32; if (n0 < 27648) return n0 + 80; if (n0 < 27680) return S_DTA; if (n0 < 27744) return S_GB + (n0 - 27680); return -1;
}
__device__ __forceinline__ TItem titem_win(const float* W, bf16* WT, int item) {
    constexpr int nblk = NPAD / 64;
    const int kb = item / nblk, nb = item % nblk, n0 = 64 * nb;
    TItem T; T.W = W; T.WT = WT; T.ldw = IN_DIM; T.K = DM; T.k0 = 64 * kb; T.src0 = win_src(n0); T.src1 = win_src(n0 + 32); T.ndst0 = n0; return T;
}
__device__ __forceinline__ void rms_row_to_bf16(const float* xrow, const float* gain, bf16* orow, int lane) {
    f32x4 v[8]; float s = 0.f;
#pragma unroll
    for (int j = 0; j < 8; ++j) { v[j] = *(const f32x4*)(xrow + 4 * lane + 256 * j); s += (v[j][0] * v[j][0] + v[j][1] * v[j][1]) + (v[j][2] * v[j][2] + v[j][3] * v[j][3]); }
    const float rs = rsqrtf(wave_sum(s) * (1.0f / 2048.0f) + EPS);
#pragma unroll
    for (int j = 0; j < 8; ++j) { f32x4 g = {1.f, 1.f, 1.f, 1.f}; if (gain) g = *(const f32x4*)(gain + 4 * lane + 256 * j);
        u32x2 w; w.x = pk2(v[j][0] * rs * g[0], v[j][1] * rs * g[1]); w.y = pk2(v[j][2] * rs * g[2], v[j][3] * rs * g[3]);
        *(u32x2*)(orow + 4 * lane + 256 * j) = w; }
}

__device__ __forceinline__ TItem prologue_item(ArgsP A, unsigned char* ws, int it) {
    constexpr int I_WIN = (DM / 64) * (NPAD / 64), I_SQ = (DM / 64) * (DM / 64), I_PP = (PDIM / 64) * (DM / 64), I_C1 = (4096 / 64) * (256 / 64), I_C2 = (256 / 64) * (256 / 64);
    constexpr int PER_LAYER = I_WIN + 3 * I_SQ + I_SQ + I_SQ + I_PP + 2 * I_C1 + 2 * I_C2;
    const int l = it / PER_LAYER; int r = it % PER_LAYER;
    if (r < I_WIN) return titem_win(A->in[4] + (size_t)l * DM * IN_DIM, (bf16*)(ws + WS_WIN + (size_t)l * SZ_WIN), r); r -= I_WIN;
    if (r < 3 * I_SQ) { const int j = r / I_SQ; return titem_plain(A->in[15] + (size_t)(l * 3 + j) * DM * DM, DM, DM, DM, (bf16*)(ws + WS_WBR + (size_t)(l * 3 + j) * 8 * MiB), r % I_SQ); } r -= 3 * I_SQ;
    if (r < I_SQ) return titem_plain(A->in[16] + (size_t)l * DM * DM, DM, DM, DM, (bf16*)(ws + WS_WOUT + (size_t)l * 8 * MiB), r); r -= I_SQ;
    if (r < I_SQ) return titem_plain(A->in[18] + (size_t)l * DM * DM, DM, DM, DM, (bf16*)(ws + WS_WGATE + (size_t)l * 8 * MiB), r); r -= I_SQ;
    if (r < I_PP) return titem_plain(A->in[17] + (size_t)l * PDIM * DM, PDIM, DM, DM, (bf16*)(ws + WS_WPP + (size_t)l * 1 * MiB), r); r -= I_PP;
    if (r < 2 * I_C1) { const int s = r / I_C1; return titem_plain(A->in[12] + (size_t)(l * 2 + s) * 4096 * 256, 4096, 256, 256, (bf16*)(ws + WS_WC1 + (size_t)(l * 2 + s) * 2 * MiB), r % I_C1); } r -= 2 * I_C1;
    { const int s = r / I_C2; return titem_plain(A->in[13] + (size_t)(l * 2 + s) * 256 * 128, 256, 128, 256, (bf16*)(ws + WS_WC2 + (size_t)(l * 2 + s) * 131072), r % I_C2); }
}

__device__ __forceinline__ void phase_prologue(ArgsP A, LAS unsigned char* lds, int tid, int lane, int wave, int G, int bid) {
    unsigned char* ws = A->ws;
    LAS float* scr = (LAS float*)(lds + wave * 17408);
    const int gw = bid * 8 + wave, NGW = G * 8;
    constexpr int I_WIN = (DM / 64) * (NPAD / 64);
    constexpr int I_SQ = (DM / 64) * (DM / 64);
    constexpr int I_PP = (PDIM / 64) * (DM / 64);
    constexpr int I_C1 = (4096 / 64) * (256 / 64);
    constexpr int I_C2 = (256 / 64) * (256 / 64);
    constexpr int PER_LAYER = I_WIN + 3 * I_SQ + I_SQ + I_SQ + I_PP + 2 * I_C1 + 2 * I_C2;
    {
        f32x4 va[16], vb[16]; TItem Ta, Tb; Ta.W = nullptr; Tb.W = nullptr;
        int it = gw;
        if (it < NLAYER * PER_LAYER) { Ta = prologue_item(A, ws, it); titem_load(Ta, va, lane); }
        while (it < NLAYER * PER_LAYER) {
            const int itb = it + NGW; const bool hb_ = itb < NLAYER * PER_LAYER;
            if (hb_) { Tb = prologue_item(A, ws, itb); titem_load(Tb, vb, lane); }
            titem_finish(Ta, va, scr, lane);
            const int ita = itb + NGW; const bool ha_ = ita < NLAYER * PER_LAYER;
            if (ha_) { Ta = prologue_item(A, ws, ita); titem_load(Ta, va, lane); }
            if (hb_) titem_finish(Tb, vb, scr, lane);
            it = ita;
        }
    }
    __syncthreads();
    for (int task = bid; task < 256; task += G) {
        const int ls = task >> 6, ck = task & 63, j = tid & 255, hf = tid >> 8;
        const float* pe = A->in[11] + (size_t)ls * 4096 + ck * 64 + hf * 32; const float* w1 = A->in[12] + ((size_t)ls * 4096 + ck * 64 + hf * 32) * 256 + j;
        float s = 0.f;
#pragma unroll 8
        for (int i = 0; i < 32; ++i) s += pe[i] * w1[(size_t)i * 256];
        LAS float* red = (LAS float*)lds;
        red[tid] = s; __syncthreads();
        if (tid < 256) ((float*)(ws + WS_HBP))[(size_t)task * 256 + tid] = red[tid] + red[tid + 256];
        __syncthreads();
    }
    { float* rot = (float*)(ws + WS_ROT); const LAS float* invt = (const LAS float*)(lds + MISC_OFF + 512);
      for (int i = bid * 512 + tid; i < L_SEQ * 128; i += G * 512) { float sn, cs; sincosf((float)(i >> 7) * invt[i & 127], &sn, &cs); rot[2 * i] = cs; rot[2 * i + 1] = sn; } }
    { const size_t n4 = (size_t)NLAYER * L_SEQ * PDIM / 4; const f32x4* src = (const f32x4*)A->in[1]; u32x2* dst = (u32x2*)(ws + WS_PBF);
      for (size_t i = (size_t)bid * 512 + tid; i < n4; i += (size_t)G * 512) { const f32x4 v = src[i]; u32x2 w; w.x = pk2(v[0], v[1]); w.y = pk2(v[2], v[3]); dst[i] = w; } }
    for (int m = gw; m < L_SEQ; m += NGW) rms_row_to_bf16(A->in[0] + (size_t)m * DM, A->in[2], (bf16*)(ws + WS_HBF) + (size_t)m * DM, lane);
}

struct LayerP {
    const float *conv_w, *conv_b, *dt_bias, *a_log, *d_skip, *ssm_norm, *ret_norm;
};
__device__ __forceinline__ void conv8(const bf16* proj, int t, int col0, const float* cw, const float* cb, int cch0, float (&out)[8]) {
    u32x4 v[4]; f32x4 w0[4], w1[4];
#pragma unroll
    for (int k = 0; k < 4; ++k) { const int tt = t - 3 + k, tc = tt < 0 ? 0 : tt; v[k] = *(const u32x4*)(proj + (size_t)tc * NPROJ + col0);
        w0[k] = *(const f32x4*)(cw + k * 4096 + cch0); w1[k] = *(const f32x4*)(cw + k * 4096 + cch0 + 4); }
    const f32x4 b0 = *(const f32x4*)(cb + cch0), b1 = *(const f32x4*)(cb + cch0 + 4);
    float acc[8] = {b0[0], b0[1], b0[2], b0[3], b1[0], b1[1], b1[2], b1[3]};
#pragma unroll
    for (int k = 0; k < 4; ++k) { const float ok = (t - 3 + k) < 0 ? 0.f : 1.f; const f32x4 a0 = w0[k] * ok, a1 = w1[k] * ok;
        acc[0] += a0[0] * blo(v[k].x); acc[1] += a0[1] * bhi(v[k].x); acc[2] += a0[2] * blo(v[k].y); acc[3] += a0[3] * bhi(v[k].y);
        acc[4] += a1[0] * blo(v[k].z); acc[5] += a1[1] * bhi(v[k].z); acc[6] += a1[2] * blo(v[k].w); acc[7] += a1[3] * bhi(v[k].w); }
#pragma unroll
    for (int i = 0; i < 8; ++i) out[i] = siluf(acc[i]);
}

constexpr int SA_XT = 0, SA_BT = 69632, SA_ACS = 104448, SA_DTV = 106496;
__device__ __forceinline__ void ssd_states_unit(ArgsP A, const LayerP& P, LAS unsigned char* lds, int c, int g, int tid, int lane, int wave) {
    tid = fresh(tid); lane = fresh(lane); wave = fresh_s(wave);
    unsigned char* ws = A->ws;
    const bf16* proj = (const bf16*)(ws + WS_PROJ); const float* small = (const float*)(ws + WS_SMALL);
    LAS bf16* XT = (LAS bf16*)(lds + SA_XT); LAS bf16* BT = (LAS bf16*)(lds + SA_BT);
    LAS float* acs = (LAS float*)(lds + SA_ACS); LAS float* dtv = (LAS float*)(lds + SA_DTV);
    const int t0 = c * 128;
    { const int l = tid >> 2, hh = tid & 3, h = g * 4 + hh, t = t0 + l;
      const float raw = small[(size_t)t * 256 + h] + P.dt_bias[h];
      const float dt = raw > 20.f ? raw : log1pf(expf(raw));
      const float a = -expf(P.a_log[h]) * dt;
      dtv[l * 4 + hh] = dt; acs[l * 4 + hh] = a;
      ((float*)(ws + WS_DTV))[(size_t)t * 32 + h] = dt; }
    __syncthreads();
    if (wave < 4) {
        const int hh = wave; const float v0 = acs[(2 * lane) * 4 + hh], v1 = acs[(2 * lane + 1) * 4 + hh]; float s = v0 + v1;
#pragma unroll
        for (int d = 1; d < 64; d <<= 1) { const float t = __shfl_up(s, d); if (lane >= d) s += t; }
        const float ex = s - (v0 + v1);
        acs[(2 * lane) * 4 + hh] = ex + v0; acs[(2 * lane + 1) * 4 + hh] = ex + v0 + v1;
    }
    __syncthreads();
    { const int l = tid >> 2, hh = tid & 3; ((float*)(ws + WS_ACS))[(size_t)(t0 + l) * 32 + g * 4 + hh] = acs[l * 4 + hh];
      if (tid < 4) ((float*)(ws + WS_CD))[c * 32 + g * 4 + tid] = __expf(acs[127 * 4 + tid]); }
#pragma unroll 1
    for (int item = fresh(tid); item < 48 * 128; item += 512) {
        const int l = item & 127, v = item >> 7, t = t0 + l; float o[8];
        if (v < 32) { const int hh = v >> 3, ch = g * 256 + v * 8;
            conv8(proj, t, C_XA + ch, P.conv_w, P.conv_b, ch, o);
            const float sc = dtv[l * 4 + hh] * __expf(acs[127 * 4 + hh] - acs[l * 4 + hh]);
#pragma unroll
            for (int i = 0; i < 8; ++i) XT[(v * 8 + i) * 136 + l] = (bf16)f2bf(o[i] * sc);
        } else { const int n0 = (v - 32) * 8, ch = g * 128 + n0;
            conv8(proj, t, C_BA + ch, P.conv_w, P.conv_b, 2048 + ch, o);
#pragma unroll
            for (int i = 0; i < 8; ++i) BT[(n0 + i) * 136 + l] = (bf16)f2bf(o[i]);
        }
    }
    __syncthreads();
    { f32x4 acc[2][8];
#pragma unroll
      for (int a = 0; a < 2; ++a)
#pragma unroll
          for (int b = 0; b < 8; ++b) acc[a][b] = (f32x4){0.f, 0.f, 0.f, 0.f};
      const int fr = lane & 15, fq = lane >> 4;
#pragma unroll
      for (int ks = 0; ks < 4; ++ks) {
          bf16x8 xf[2];
#pragma unroll
          for (int a = 0; a < 2; ++a) xf[a] = ldfrag(XT, 136, wave * 32 + a * 16 + fr, ks * 32 + fq * 8);
#pragma unroll
          for (int b = 0; b < 8; ++b) { const bf16x8 yf = ldfrag(BT, 136, b * 16 + fr, ks * 32 + fq * 8);
#pragma unroll
              for (int a = 0; a < 2; ++a) acc[a][b] = mma16(xf[a], yf, acc[a][b]); }
      }
      const int hh = wave >> 1, h = g * 4 + hh;
      float* st = (float*)(ws + WS_ST) + ((size_t)(c * 32 + h) * 64) * 128;
#pragma unroll
      for (int a = 0; a < 2; ++a)
#pragma unroll
          for (int b = 0; b < 8; ++b)
#pragma unroll
              for (int r = 0; r < 4; ++r) { const int p = (wave & 1) * 32 + a * 16 + fq * 4 + r, n = b * 16 + fr; st[(size_t)p * 128 + n] = acc[a][b][r]; }
    }
    __syncthreads();
}

__device__ __forceinline__ void ssd_scan(ArgsP A, int tid, int bid, int G) {
    float* st = (float*)(A->ws + WS_ST); const float* cd = (const float*)(A->ws + WS_CD);
    for (int i = bid * 512 + tid; i < 32 * 64 * 128 / 4; i += G * 512) {
        const int h = i / 2048; f32x4 run = {0.f, 0.f, 0.f, 0.f};
#pragma unroll 16
        for (int c = 0; c < 64; ++c) { f32x4* p = (f32x4*)(st + (size_t)c * 32 * 64 * 128) + i; const f32x4 s = *p; const float d = cd[c * 32 + h]; *p = run; run = run * d + s; }
    }
}

constexpr int SC_CM = 0, SC_BM = 34816, SC_MH = 69632, SC_XT = 104448, SC_PV = 121856, SC_ACS = 139264, SC_DTV = 141312;
__device__ __forceinline__ void ssd_out_unit(ArgsP A, const LayerP& P, float* rowss, LAS unsigned char* lds, int c, int g, int tid, int lane, int wave) {
    tid = fresh(tid); lane = fresh(lane); wave = fresh_s(wave);
    unsigned char* ws = A->ws;
    const bf16* proj = (const bf16*)(ws + WS_PROJ);
    LAS bf16* CM = (LAS bf16*)(lds + SC_CM); LAS bf16* BM = (LAS bf16*)(lds + SC_BM); LAS bf16* MH = (LAS bf16*)(lds + SC_MH);
    LAS bf16* XT = (LAS bf16*)(lds + SC_XT); LAS bf16* PV = (LAS bf16*)(lds + SC_PV);
    LAS float* acs = (LAS float*)(lds + SC_ACS); LAS float* dtv = (LAS float*)(lds + SC_DTV);
    const int t0 = c * 128, fr = lane & 15, fq = lane >> 4;
    { const int l = tid >> 2, hh = tid & 3; acs[l * 4 + hh] = ((const float*)(ws + WS_ACS))[(size_t)(t0 + l) * 32 + g * 4 + hh]; dtv[l * 4 + hh] = ((const float*)(ws + WS_DTV))[(size_t)(t0 + l) * 32 + g * 4 + hh]; }
#pragma unroll 1
    for (int item = fresh(tid); item < 32 * 128; item += 512) {
        const int l = item & 127, v = item >> 7, t = t0 + l; float o[8];
        const int n0 = (v & 15) * 8, ch = g * 128 + n0;
        if (v < 16) conv8(proj, t, C_BA + ch, P.conv_w, P.conv_b, 2048 + ch, o); else conv8(proj, t, C_CA + ch, P.conv_w, P.conv_b, 3072 + ch, o);
        u32x4 w; w.x = pk2(o[0], o[1]); w.y = pk2(o[2], o[3]); w.z = pk2(o[4], o[5]); w.w = pk2(o[6], o[7]);
        *(LAS u32x4*)((v < 16 ? BM : CM) + l * 136 + n0) = w;
    }
    __syncthreads();
    f32x4 cb[8];
#pragma unroll
    for (int b = 0; b < 8; ++b) cb[b] = (f32x4){0.f, 0.f, 0.f, 0.f};
#pragma unroll
    for (int ks = 0; ks < 4; ++ks) { const bf16x8 xf = ldfrag(CM, 136, wave * 16 + fr, ks * 32 + fq * 8);
#pragma unroll
        for (int b = 0; b < 8; ++b) cb[b] = mma16(xf, ldfrag(BM, 136, b * 16 + fr, ks * 32 + fq * 8), cb[b]); }
    float ssq[4] = {0.f, 0.f, 0.f, 0.f};
    for (int hh = 0; hh < 4; ++hh) {
        const int h = g * 4 + hh;
#pragma unroll 1
        for (int item = fresh(tid); item < 8 * 128; item += 512) { const int l = item & 127, v = item >> 7, ch = h * 64 + v * 8; float o[8];
            conv8(proj, t0 + l, C_XA + ch, P.conv_w, P.conv_b, ch, o);
#pragma unroll
            for (int i = 0; i < 8; ++i) XT[(v * 8 + i) * 136 + l] = (bf16)f2bf(o[i]); }
        { const float* st = (const float*)(ws + WS_ST) + ((size_t)(c * 32 + h) * 64) * 128;
#pragma unroll 1
          for (int item = fresh(tid); item < 64 * 16; item += 512) { const int p = item >> 4, n0 = (item & 15) * 8;
              const f32x4 a = *(const f32x4*)(st + p * 128 + n0), b = *(const f32x4*)(st + p * 128 + n0 + 4);
              u32x4 w; w.x = pk2(a[0], a[1]); w.y = pk2(a[2], a[3]); w.z = pk2(b[0], b[1]); w.w = pk2(b[2], b[3]);
              *(LAS u32x4*)(PV + p * 136 + n0) = w; } }
#pragma unroll
        for (int b = 0; b < 8; ++b)
#pragma unroll
            for (int r = 0; r < 4; ++r) { const int l = wave * 16 + fq * 4 + r, s = b * 16 + fr;
                const float v = (s <= l) ? cb[b][r] * __expf(acs[l * 4 + hh] - acs[s * 4 + hh]) * dtv[s * 4 + hh] : 0.f;
                MH[l * 136 + s] = (bf16)f2bf(v); }
        __syncthreads();
        f32x4 yd[4], yo[4];
#pragma unroll
        for (int b = 0; b < 4; ++b) { yd[b] = (f32x4){0.f, 0.f, 0.f, 0.f}; yo[b] = (f32x4){0.f, 0.f, 0.f, 0.f}; }
#pragma unroll
        for (int ks = 0; ks < 4; ++ks) { const bf16x8 mf = ldfrag(MH, 136, wave * 16 + fr, ks * 32 + fq * 8), cf = ldfrag(CM, 136, wave * 16 + fr, ks * 32 + fq * 8);
#pragma unroll
            for (int b = 0; b < 4; ++b) { yd[b] = mma16(mf, ldfrag(XT, 136, b * 16 + fr, ks * 32 + fq * 8), yd[b]); yo[b] = mma16(cf, ldfrag(PV, 136, b * 16 + fr, ks * 32 + fq * 8), yo[b]); } }
        const float dsk = P.d_skip[h];
#pragma unroll
        for (int r = 0; r < 4; ++r) { const int l = wave * 16 + fq * 4 + r, t = t0 + l; const float ea = __expf(acs[l * 4 + hh]);
#pragma unroll
            for (int b = 0; b < 4; ++b) { const int p = b * 16 + fr, ch = h * 64 + p;
                const float xs = bf2f(XT[p * 136 + l]);
                const float y = yd[b][r] + yo[b][r] * ea + xs * dsk;
                const float z = bf2f(proj[(size_t)t * NPROJ + C_ZA + ch]);
                const float yg = y * siluf(z);
                ssq[r] += yg * yg;
                ((bf16*)(ws + WS_YA))[(size_t)t * DM + ch] = (bf16)f2bf(yg * P.ssm_norm[ch]); } }
        __syncthreads();
    }
#pragma unroll
    for (int r = 0; r < 4; ++r) { float s = ssq[r]; s += __shfl_xor(s, 1); s += __shfl_xor(s, 2); s += __shfl_xor(s, 4); s += __shfl_xor(s, 8);
        if (fr == 0) atomicAdd(rowss + t0 + wave * 16 + fq * 4 + r, s); }
}

__device__ __forceinline__ float ret_logg(int h) { return log1pf(-exp2f(-5.0f - (float)h)); }
__device__ __forceinline__ void rotary8(const u32x4 v, int t, int d0, float sc, const LAS float* invt, float (&o)[8]) {
    const float x[8] = {blo(v.x), bhi(v.x), blo(v.y), bhi(v.y), blo(v.z), bhi(v.z), blo(v.w), bhi(v.w)};
#pragma unroll
    for (int i = 0; i < 4; ++i) { const int pi = (d0 >> 1) + i;
        const float inv = invt[pi];
        float sn, cs; sincosf((float)t * inv, &sn, &cs);
        o[2 * i] = (x[2 * i] * cs - x[2 * i + 1] * sn) * sc; o[2 * i + 1] = (x[2 * i] * sn + x[2 * i + 1] * cs) * sc; }
}
constexpr int RA_VT = 0, RA_KT = 69632;
__device__ __forceinline__ void ret_kv_unit(ArgsP A, LAS unsigned char* lds, int c, int h, int tid, int lane, int wave) {
    tid = fresh(tid); lane = fresh(lane); wave = fresh_s(wave);
    unsigned char* ws = A->ws; const bf16* proj = (const bf16*)(ws + WS_PROJ);
    LAS bf16* VT = (LAS bf16*)(lds + RA_VT); LAS bf16* KT = (LAS bf16*)(lds + RA_KT);
    const int t0 = c * 128; const float lg = ret_logg(h);
#pragma unroll 1
    for (int item = fresh(tid); item < 64 * 128; item += 512) { const int j = item & 127, v = item >> 7, t = t0 + j;
        if (v < 32) { const u32x4 w = *(const u32x4*)(proj + (size_t)t * NPROJ + C_VC + h * 256 + v * 8);
            VT[(v * 8 + 0) * 136 + j] = (bf16)(w.x & 0xffff); VT[(v * 8 + 1) * 136 + j] = (bf16)(w.x >> 16); VT[(v * 8 + 2) * 136 + j] = (bf16)(w.y & 0xffff); VT[(v * 8 + 3) * 136 + j] = (bf16)(w.y >> 16);
            VT[(v * 8 + 4) * 136 + j] = (bf16)(w.z & 0xffff); VT[(v * 8 + 5) * 136 + j] = (bf16)(w.z >> 16); VT[(v * 8 + 6) * 136 + j] = (bf16)(w.w & 0xffff); VT[(v * 8 + 7) * 136 + j] = (bf16)(w.w >> 16);
        } else { const int d0 = (v - 32) * 8; const u32x4 w = *(const u32x4*)(proj + (size_t)t * NPROJ + C_KC + h * 256 + d0); float o[8];
            rotary8(w, t, d0, 0.0625f * __expf(lg * (float)(127 - j)), (const LAS float*)(lds + MISC_OFF + 512), o);
#pragma unroll
            for (int i = 0; i < 8; ++i) KT[(d0 + i) * 136 + j] = (bf16)f2bf(o[i]); }
    }
    __syncthreads();
    const int fr = lane & 15, fq = lane >> 4;
    float* out = (float*)(ws + WS_KVT) + (size_t)(c * 8 + h) * 65536;
    for (int half = 0; half < 2; ++half) {
        f32x4 acc[2][8];
#pragma unroll
        for (int a = 0; a < 2; ++a)
#pragma unroll
            for (int b = 0; b < 8; ++b) acc[a][b] = (f32x4){0.f, 0.f, 0.f, 0.f};
#pragma unroll
        for (int ks = 0; ks < 4; ++ks) { bf16x8 xf[2];
#pragma unroll
            for (int a = 0; a < 2; ++a) xf[a] = ldfrag(VT, 136, wave * 32 + a * 16 + fr, ks * 32 + fq * 8);
#pragma unroll
            for (int b = 0; b < 8; ++b) { const bf16x8 yf = ldfrag(KT, 136, half * 128 + b * 16 + fr, ks * 32 + fq * 8);
#pragma unroll
                for (int a = 0; a < 2; ++a) acc[a][b] = mma16(xf[a], yf, acc[a][b]); } }
#pragma unroll
        for (int a = 0; a < 2; ++a)
#pragma unroll
            for (int b = 0; b < 8; ++b)
#pragma unroll
                for (int r = 0; r < 4; ++r) { const int e = wave * 32 + a * 16 + fq * 4 + r, d = half * 128 + b * 16 + fr; out[(size_t)e * 256 + d] = acc[a][b][r]; }
    }
    __syncthreads();
}
__device__ __forceinline__ void ret_scan(ArgsP A, int tid, int bid, int G) {
    float* kv = (float*)(A->ws + WS_KVT);
    for (int i = bid * 512 + tid; i < 8 * 65536 / 4; i += G * 512) {
        const int h = i / 16384; const float d = __expf(ret_logg(h) * 128.0f); f32x4 run = {0.f, 0.f, 0.f, 0.f};
#pragma unroll 16
        for (int c = 0; c < 64; ++c) { f32x4* p = (f32x4*)(kv + (size_t)c * 8 * 65536) + i; const f32x4 s = *p; *p = run; run = run * d + s; }
    }
}
constexpr int RC_Q = 0, RC_K = 67584, RC_S = 67584, RC_VT = 102400, RC_RT = 67584;
__device__ __forceinline__ void ret_out_unit(ArgsP A, const LayerP& P, LAS unsigned char* lds, int c, int h, int tid, int lane, int wave) {
    tid = fresh(tid); lane = fresh(lane); wave = fresh_s(wave);
    unsigned char* ws = A->ws; const bf16* proj = (const bf16*)(ws + WS_PROJ);
    LAS bf16* Q = (LAS bf16*)(lds + RC_Q); LAS bf16* K = (LAS bf16*)(lds + RC_K); LAS bf16* S = (LAS bf16*)(lds + RC_S);
    LAS bf16* VT = (LAS bf16*)(lds + RC_VT); LAS bf16* RT = (LAS bf16*)(lds + RC_RT);
    const int t0 = c * 128, fr = lane & 15, fq = lane >> 4; const float lg = ret_logg(h);
#pragma unroll 1
    for (int item = fresh(tid); item < 64 * 128; item += 512) { const int j = item & 127, v = item >> 7, t = t0 + j, d0 = (v & 31) * 8; float o[8];
        const u32x4 w = *(const u32x4*)(proj + (size_t)t * NPROJ + (v < 32 ? C_QC : C_KC) + h * 256 + d0);
        rotary8(w, t, d0, v < 32 ? 1.0f : 0.0625f, (const LAS float*)(lds + MISC_OFF + 512), o);
        u32x4 pw; pw.x = pk2(o[0], o[1]); pw.y = pk2(o[2], o[3]); pw.z = pk2(o[4], o[5]); pw.w = pk2(o[6], o[7]);
        *(LAS u32x4*)((v < 32 ? Q : K) + j * 264 + d0) = pw; }
    __syncthreads();
    f32x4 sc[8];
#pragma unroll
    for (int b = 0; b < 8; ++b) sc[b] = (f32x4){0.f, 0.f, 0.f, 0.f};
#pragma unroll
    for (int ks = 0; ks < 8; ++ks) { const bf16x8 xf = ldfrag(Q, 264, wave * 16 + fr, ks * 32 + fq * 8);
#pragma unroll
        for (int b = 0; b < 8; ++b) sc[b] = mma16(xf, ldfrag(K, 264, b * 16 + fr, ks * 32 + fq * 8), sc[b]); }
    __syncthreads();
#pragma unroll
    for (int b = 0; b < 8; ++b)
#pragma unroll
        for (int r = 0; r < 4; ++r) { const int i = wave * 16 + fq * 4 + r, j = b * 16 + fr;
            S[i * 136 + j] = (bf16)f2bf(i >= j ? sc[b][r] * __expf(lg * (float)(i - j)) : 0.f); }
    f32x4 o[16];
#pragma unroll
    for (int b = 0; b < 16; ++b) o[b] = (f32x4){0.f, 0.f, 0.f, 0.f};
#pragma unroll
    for (int eh = 0; eh < 2; ++eh) {
#pragma unroll 1
        for (int item = fresh(tid); item < 16 * 128; item += 512) { const int j = item & 127, v = item >> 7;
            const u32x4 w = *(const u32x4*)(proj + (size_t)(t0 + j) * NPROJ + C_VC + h * 256 + eh * 128 + v * 8);
            VT[(v * 8 + 0) * 136 + j] = (bf16)(w.x & 0xffff); VT[(v * 8 + 1) * 136 + j] = (bf16)(w.x >> 16); VT[(v * 8 + 2) * 136 + j] = (bf16)(w.y & 0xffff); VT[(v * 8 + 3) * 136 + j] = (bf16)(w.y >> 16);
            VT[(v * 8 + 4) * 136 + j] = (bf16)(w.z & 0xffff); VT[(v * 8 + 5) * 136 + j] = (bf16)(w.z >> 16); VT[(v * 8 + 6) * 136 + j] = (bf16)(w.w & 0xffff); VT[(v * 8 + 7) * 136 + j] = (bf16)(w.w >> 16); }
        __syncthreads();
#pragma unroll
        for (int ks = 0; ks < 4; ++ks) { const bf16x8 xf = ldfrag(S, 136, wave * 16 + fr, ks * 32 + fq * 8);
#pragma unroll
            for (int b = 0; b < 8; ++b) o[eh * 8 + b] = mma16(xf, ldfrag(VT, 136, b * 16 + fr, ks * 32 + fq * 8), o[eh * 8 + b]); }
        __syncthreads();
    }
    const float* kvt = (const float*)(ws + WS_KVT) + (size_t)(c * 8 + h) * 65536;
    float xi[4];
#pragma unroll
    for (int r = 0; r < 4; ++r) xi[r] = __expf(lg * (float)(wave * 16 + fq * 4 + r + 1));
#pragma unroll
    for (int eq = 0; eq < 4; ++eq) {
#pragma unroll 1
        for (int item = fresh(tid); item < 64 * 32; item += 512) { const int e = item >> 5, d0 = (item & 31) * 8;
            const f32x4 a = *(const f32x4*)(kvt + (size_t)(eq * 64 + e) * 256 + d0), b = *(const f32x4*)(kvt + (size_t)(eq * 64 + e) * 256 + d0 + 4);
            u32x4 w; w.x = pk2(a[0], a[1]); w.y = pk2(a[2], a[3]); w.z = pk2(b[0], b[1]); w.w = pk2(b[2], b[3]);
            *(LAS u32x4*)(RT + e * 264 + d0) = w; }
        __syncthreads();
        f32x4 cr[4];
#pragma unroll
        for (int b = 0; b < 4; ++b) cr[b] = (f32x4){0.f, 0.f, 0.f, 0.f};
#pragma unroll
        for (int ks = 0; ks < 8; ++ks) { const bf16x8 xf = ldfrag(Q, 264, wave * 16 + fr, ks * 32 + fq * 8);
#pragma unroll
            for (int b = 0; b < 4; ++b) cr[b] = mma16(xf, ldfrag(RT, 264, b * 16 + fr, ks * 32 + fq * 8), cr[b]); }
#pragma unroll
        for (int b = 0; b < 4; ++b)
#pragma unroll
            for (int r = 0; r < 4; ++r) o[eq * 4 + b][r] += cr[b][r] * xi[r];
        __syncthreads();
    }
#pragma unroll
    for (int r = 0; r < 4; ++r) {
        float s = 0.f;
#pragma unroll
        for (int b = 0; b < 16; ++b) s += o[b][r];
        s += __shfl_xor(s, 1); s += __shfl_xor(s, 2); s += __shfl_xor(s, 4); s += __shfl_xor(s, 8);
        const float mu = s * (1.0f / 256.0f); float q = 0.f;
#pragma unroll
        for (int b = 0; b < 16; ++b) { const float d = o[b][r] - mu; q += d * d; }
        q += __shfl_xor(q, 1); q += __shfl_xor(q, 2); q += __shfl_xor(q, 4); q += __shfl_xor(q, 8);
        const float rs = rsqrtf(q * (1.0f / 256.0f) + EPS);
        const int t = t0 + wave * 16 + fq * 4 + r;
#pragma unroll
        for (int b = 0; b < 16; ++b) { const int ch = h * 256 + b * 16 + fr;
            const float z = bf2f(proj[(size_t)t * NPROJ + C_ZC + ch]);
            ((bf16*)(ws + WS_YC))[(size_t)t * DM + ch] = (bf16)f2bf((o[b][r] - mu) * rs * P.ret_norm[ch] * siluf(z)); }
    }
    __syncthreads();
}

__device__ __forceinline__ void nsa_im2col(ArgsP A, int tid, int bid, int G) {
    const bf16* proj = (const bf16*)(A->ws + WS_PROJ); u32x4* aim = (u32x4*)(A->ws + WS_AIM);
    const size_t nvec = (size_t)2 * 2048 * 512;
    for (size_t i = (size_t)bid * 512 + tid; i < nvec; i += (size_t)G * 512) {
        const int s = (int)(i >> 20), row = (int)((i >> 9) & 2047), kv = (int)(i & 511), l = kv >> 4, d0 = (kv & 15) * 8, n = row >> 2, hk = row & 3;
        u32x4 v = {0u, 0u, 0u, 0u};
        if (row < NCMP * 4) v = *(const u32x4*)(proj + (size_t)(n * 16 + l) * NPROJ + (s ? C_VCB : C_KCB) + hk * 128 + d0);
        aim[i] = v;
    }
}

constexpr int NA_Q = 0, NA_K = 34816, NA_VT = 52224, NA_S = 70656, NA_P = 105472, NA_M = 123904, NA_L = 124416, NA_AL = 124928, NA_IMP = 125440, NA_SEL = 141824, NA_ANY = 142336;
__device__ __forceinline__ void na_stage_kv(const bf16* kbase, const bf16* vbase, size_t rstride, int row0, int rowstep, int maxrow, LAS bf16* Kt, LAS bf16* Vt, int tid, bool with_v) {
#pragma unroll 1
    for (int item = fresh(tid); item < 1024; item += 512) { const int kk = item >> 4, d0 = (item & 15) * 8; int row = row0 + kk * rowstep; row = row < 0 ? 0 : (row > maxrow ? maxrow : row);
        *(LAS u32x4*)(Kt + kk * 136 + d0) = *(const u32x4*)(kbase + (size_t)row * rstride + d0); }
    if (with_v) {
#pragma unroll 1
    for (int item = fresh(tid); item < 1024; item += 512) { const int kk = item & 63, d0 = (item >> 6) * 8; int row = row0 + kk * rowstep; row = row < 0 ? 0 : (row > maxrow ? maxrow : row);
        const u32x4 w = *(const u32x4*)(vbase + (size_t)row * rstride + d0);
        Vt[(d0 + 0) * 72 + kk] = (bf16)(w.x & 0xffff); Vt[(d0 + 1) * 72 + kk] = (bf16)(w.x >> 16); Vt[(d0 + 2) * 72 + kk] = (bf16)(w.y & 0xffff); Vt[(d0 + 3) * 72 + kk] = (bf16)(w.y >> 16);
        Vt[(d0 + 4) * 72 + kk] = (bf16)(w.z & 0xffff); Vt[(d0 + 5) * 72 + kk] = (bf16)(w.z >> 16); Vt[(d0 + 6) * 72 + kk] = (bf16)(w.w & 0xffff); Vt[(d0 + 7) * 72 + kk] = (bf16)(w.w >> 16); } }
}
__device__ __forceinline__ void na_scores(const LAS bf16* Q, const LAS bf16* Kt, LAS float* S, int lane, int wave) {
    const int fr = lane & 15, fq = lane >> 4; f32x4 acc[4];
#pragma unroll
    for (int b = 0; b < 4; ++b) acc[b] = (f32x4){0.f, 0.f, 0.f, 0.f};
#pragma unroll
    for (int ks = 0; ks < 4; ++ks) { const bf16x8 xf = ldfrag(Q, 136, wave * 16 + fr, ks * 32 + fq * 8);
#pragma unroll
        for (int b = 0; b < 4; ++b) acc[b] = mma16(xf, ldfrag(Kt, 136, b * 16 + fr, ks * 32 + fq * 8), acc[b]); }
#pragma unroll
    for (int b = 0; b < 4; ++b)
#pragma unroll
        for (int r = 0; r < 4; ++r) S[(wave * 16 + fq * 4 + r) * 68 + b * 16 + fr] = acc[b][r] * 0.08838834764831845f;
}
template <int KIND> __device__ __forceinline__ bool na_valid(int t, int kidx, const LAS unsigned* selrow, int j) {
    if (KIND == 0) return kidx < NCMP && kidx * 16 + 31 <= t;
    if (KIND == 1) return ((selrow[j >> 5] >> (j & 31)) & 1u) && kidx <= t;
    return kidx <= t && kidx > t - 512 && kidx >= 0;
}
template <int KIND> __device__ __forceinline__ void na_softmax_online(LAS float* S, LAS bf16* Pm, LAS float* M, LAS float* Ls, LAS float* AL, const LAS unsigned* SEL, int t0, int kidx0, int j, int tid) {
    const int row = tid >> 2, q = tid & 3, tt = row >> 2, t = t0 + tt; const LAS unsigned* selrow = SEL + tt * 4;
    float sv[16]; float mx = -1e30f;
#pragma unroll
    for (int i = 0; i < 16; ++i) { const int col = q * 16 + i; const bool ok = na_valid<KIND>(t, kidx0 + col, selrow, j); sv[i] = ok ? S[row * 68 + col] : -1e30f; mx = fmaxf(mx, sv[i]); }
    mx = fmaxf(mx, __shfl_xor(mx, 1)); mx = fmaxf(mx, __shfl_xor(mx, 2));
    const float mo = M[row], mn = fmaxf(mo, mx); float ps = 0.f;
#pragma unroll
    for (int i = 0; i < 16; i += 2) { const float p0 = sv[i] > -1e29f ? __expf(sv[i] - mn) : 0.f, p1 = sv[i + 1] > -1e29f ? __expf(sv[i + 1] - mn) : 0.f; ps += p0 + p1;
        *(LAS unsigned*)(Pm + row * 72 + q * 16 + i) = pk2(p0, p1); }
    ps += __shfl_xor(ps, 1); ps += __shfl_xor(ps, 2);
    if (q == 0) { const float al = __expf(mo - mn); AL[row] = al; Ls[row] = Ls[row] * al + ps; M[row] = mn; }
}
__device__ __forceinline__ void na_pv(f32x4 (&O)[8], const LAS bf16* Pm, const LAS bf16* Vt, const LAS float* AL, bool rescale, int lane, int wave) {
    const int fr = lane & 15, fq = lane >> 4;
    if (rescale) {
#pragma unroll
        for (int r = 0; r < 4; ++r) { const float al = AL[wave * 16 + fq * 4 + r];
#pragma unroll
            for (int b = 0; b < 8; ++b) O[b][r] *= al; } }
#pragma unroll
    for (int ks = 0; ks < 2; ++ks) { const bf16x8 xf = ldfrag(Pm, 72, wave * 16 + fr, ks * 32 + fq * 8);
#pragma unroll
        for (int b = 0; b < 8; ++b) O[b] = mma16(xf, ldfrag(Vt, 72, b * 16 + fr, ks * 32 + fq * 8), O[b]); }
}
__device__ __forceinline__ void na_reset_stats(LAS float* M, LAS float* Ls, int tid) { if (tid < 128) { M[tid] = -1e30f; Ls[tid] = 0.f; } }
__device__ __forceinline__ void na_combine(f32x4 (&comb)[8], f32x4 (&O)[8], const LAS float* Ls, const float* small, int t0, int g, int branch, int lane, int wave) {
    const int fq = lane >> 4;
#pragma unroll
    for (int r = 0; r < 4; ++r) { const int row = wave * 16 + fq * 4 + r, tt = row >> 2, hr = row & 3; const float l = Ls[row];
        const float gate = sigm(small[(size_t)(t0 + tt) * 256 + 32 + (g * 4 + hr) * 3 + branch]);
        const float f = l > 0.f ? gate / l : 0.f;
#pragma unroll
        for (int b = 0; b < 8; ++b) { comb[b][r] += O[b][r] * f; O[b][r] = 0.f; } }
}

__device__ __forceinline__ void nsa_attn_unit(ArgsP A, LAS unsigned char* lds, int qt, int g, int tid, int lane, int wave) {
    tid = fresh(tid); lane = fresh(lane); wave = fresh_s(wave);
    unsigned char* ws = A->ws; const bf16* proj = (const bf16*)(ws + WS_PROJ); const float* small = (const float*)(ws + WS_SMALL);
    LAS bf16* Q = (LAS bf16*)(lds + NA_Q); LAS bf16* Kt = (LAS bf16*)(lds + NA_K); LAS bf16* Vt = (LAS bf16*)(lds + NA_VT);
    LAS float* S = (LAS float*)(lds + NA_S); LAS bf16* Pm = (LAS bf16*)(lds + NA_P);
    LAS float* M = (LAS float*)(lds + NA_M); LAS float* Ls = (LAS float*)(lds + NA_L); LAS float* AL = (LAS float*)(lds + NA_AL);
    LAS float* IMP = (LAS float*)(lds + NA_IMP); LAS unsigned* SEL = (LAS unsigned*)(lds + NA_SEL); LAS unsigned* ANY = (LAS unsigned*)(lds + NA_ANY);
    const int t0 = qt * 32, tlast = t0 + 31, fr = lane & 15, fq = lane >> 4;
#pragma unroll 1
    for (int item = fresh(tid); item < 128 * 16; item += 512) { const int row = item >> 4, d0 = (item & 15) * 8, tt = row >> 2, hr = row & 3;
        *(LAS u32x4*)(Q + row * 136 + d0) = *(const u32x4*)(proj + (size_t)(t0 + tt) * NPROJ + C_QB + (g * 4 + hr) * 128 + d0); }
    for (int i = tid; i < 32 * 128; i += 512) IMP[i] = 0.f;
    if (tid < 128) { SEL[tid] = 0u; ANY[tid] = 0u; }
    na_reset_stats(M, Ls, tid);
    f32x4 O[8], comb[8];
#pragma unroll
    for (int b = 0; b < 8; ++b) { O[b] = (f32x4){0.f, 0.f, 0.f, 0.f}; comb[b] = (f32x4){0.f, 0.f, 0.f, 0.f}; }
    __syncthreads();
    const bf16* kcmp = (const bf16*)(ws + WS_KVC) + g * 128; const bf16* vcmp = (const bf16*)(ws + WS_KVC + 524288) + g * 128;
    const int ncmp_tiles = tlast >= 31 ? ((tlast - 31) / 16) / 64 + 1 : 0;
    for (int kt = 0; kt < ncmp_tiles; ++kt) {
        na_stage_kv(kcmp, vcmp, 512, kt * 64, 1, NCMP - 1, Kt, Vt, tid, false);
        __syncthreads();
        na_scores(Q, Kt, S, lane, wave);
        __syncthreads();
        na_softmax_online<0>(S, Pm, M, Ls, AL, SEL, t0, kt * 64, 0, tid);
        __syncthreads();
    }
    for (int kt = 0; kt < ncmp_tiles; ++kt) {
        na_stage_kv(kcmp, vcmp, 512, kt * 64, 1, NCMP - 1, Kt, Vt, tid, true);
        __syncthreads();
        na_scores(Q, Kt, S, lane, wave);
        __syncthreads();
        { const int row = tid >> 2, q = tid & 3, t = t0 + (row >> 2); const float m = M[row], l = Ls[row], il = l > 0.f ? 1.0f / l : 0.f;
#pragma unroll
          for (int i = 0; i < 16; i += 2) { const int col = q * 16 + i;
              const float p0 = na_valid<0>(t, kt * 64 + col, SEL, 0) ? __expf(S[row * 68 + col] - m) * il : 0.f, p1 = na_valid<0>(t, kt * 64 + col + 1, SEL, 0) ? __expf(S[row * 68 + col + 1] - m) * il : 0.f;
              S[row * 68 + col] = p0; S[row * 68 + col + 1] = p1; *(LAS unsigned*)(Pm + row * 72 + col) = pk2(p0, p1); } }
        __syncthreads();
        na_pv(O, Pm, Vt, AL, false, lane, wave);
#pragma unroll 1
        for (int item = fresh(tid); item < 32 * 17; item += 512) { const int tt = item / 17, jj = item % 17, j = kt * 16 + jj;
            if (j < 128) { float s = 0.f;
#pragma unroll
                for (int dn = -1; dn < 4; ++dn) { const int col = 4 * jj + dn; if (col >= 0 && col < 64 && !(jj == 16 && dn >= 0)) {
#pragma unroll
                        for (int hr = 0; hr < 4; ++hr) s += S[(tt * 4 + hr) * 68 + col]; } }
                IMP[tt * 128 + j] += s; } }
        __syncthreads();
    }
    { const int fq2 = lane >> 4;
#pragma unroll
      for (int r = 0; r < 4; ++r) { const int row = wave * 16 + fq2 * 4 + r, tt = row >> 2, hr = row & 3;
          const float gate = sigm(small[(size_t)(t0 + tt) * 256 + 32 + (g * 4 + hr) * 3 + 0]);
#pragma unroll
          for (int b = 0; b < 8; ++b) { comb[b][r] += O[b][r] * gate; O[b][r] = 0.f; } } }
#pragma unroll 1
    for (int item = fresh(tid); item < 32 * 128; item += 512) { const int tt = item >> 7, j = item & 127, t = t0 + tt, cur = t >> 6;
        const bool forced = (j == 0) || (j == cur) || (j + 1 == cur); const bool elig = j <= cur;
        const float v = IMP[item]; IMP[item] = forced ? __builtin_inff() : (elig ? v : -__builtin_inff()); }
    __syncthreads();
#pragma unroll 1
    for (int item = fresh(tid); item < 32 * 128; item += 512) { const int tt = item >> 7, j = item & 127; const float v = IMP[item]; int rank = 0;
        for (int k = 0; k < 128; ++k) { const float u = IMP[tt * 128 + k]; rank += (u > v || (u == v && k < j)) ? 1 : 0; }
        if (rank < 16 && v > -__builtin_inff()) { __hip_atomic_fetch_or(SEL + tt * 4 + (j >> 5), 1u << (j & 31), __ATOMIC_RELAXED, __HIP_MEMORY_SCOPE_WORKGROUP); ANY[j] = 1u; } }
    na_reset_stats(M, Ls, tid);
    __syncthreads();
    const int curlast = tlast >> 6;
    for (int j = 0; j <= curlast; ++j) {
        if (ANY[j] == 0u) continue;
        na_stage_kv(proj + C_KSB + g * 128, proj + C_VSB + g * 128, NPROJ, j * 64, 1, L_SEQ - 1, Kt, Vt, tid, true);
        __syncthreads();
        na_scores(Q, Kt, S, lane, wave);
        __syncthreads();
        na_softmax_online<1>(S, Pm, M, Ls, AL, SEL, t0, j * 64, j, tid);
        __syncthreads();
        na_pv(O, Pm, Vt, AL, true, lane, wave);
        __syncthreads();
    }
    na_combine(comb, O, Ls, small, t0, g, 1, lane, wave);
    __syncthreads();
    na_reset_stats(M, Ls, tid);
    __syncthreads();
    { const int kmin = t0 - 511 > 0 ? t0 - 511 : 0;
      for (int jb = kmin >> 6; jb <= curlast; ++jb) {
        na_stage_kv(proj + C_KWB + g * 128, proj + C_VWB + g * 128, NPROJ, jb * 64, 1, L_SEQ - 1, Kt, Vt, tid, true);
        __syncthreads();
        na_scores(Q, Kt, S, lane, wave);
        __syncthreads();
        na_softmax_online<2>(S, Pm, M, Ls, AL, SEL, t0, jb * 64, 0, tid);
        __syncthreads();
        na_pv(O, Pm, Vt, AL, true, lane, wave);
        __syncthreads();
      } }
    na_combine(comb, O, Ls, small, t0, g, 2, lane, wave);
#pragma unroll
    for (int r = 0; r < 4; ++r) { const int row = wave * 16 + fq * 4 + r, tt = row >> 2, hr = row & 3, t = t0 + tt;
#pragma unroll
        for (int b = 0; b < 8; ++b) { const int ch = (g * 4 + hr) * 128 + b * 16 + fr;
            const float z = bf2f(proj[(size_t)t * NPROJ + C_ZB + ch]);
            ((bf16*)(ws + WS_YB))[(size_t)t * DM + ch] = (bf16)f2bf(comb[b][r] * siluf(z)); } }
    __syncthreads();
}

constexpr int NB_K = 0, NB_V = 17408, NB_STAGE = 35840, NB_IMP = 71680, NB_SEL = 104448;
typedef short s16x4 __attribute__((ext_vector_type(4)));
struct KVSrc { const bf16* k; const bf16* v; size_t rstride; int maxrow; };
__device__ __forceinline__ void kv_load(const KVSrc& s, int row0, int tid, u32x4 (&r)[4]) {
#pragma unroll
    for (int i = 0; i < 2; ++i) { const int idx = tid + 512 * i, key = idx >> 4, vec = idx & 15; int row = row0 + key; row = row < 0 ? 0 : (row > s.maxrow ? s.maxrow : row);
        r[i] = *(const u32x4*)(s.k + (size_t)row * s.rstride + vec * 8); r[2 + i] = *(const u32x4*)(s.v + (size_t)row * s.rstride + vec * 8); }
}
__device__ __forceinline__ void kv_store(LAS unsigned char* stage, int tid, const u32x4 (&r)[4]) {
#pragma unroll
    for (int i = 0; i < 2; ++i) { const int idx = tid + 512 * i, key = idx >> 4, vec = idx & 15;
        *(LAS u32x4*)(stage + NB_K + (key * 136 + vec * 8) * 2) = r[i]; *(LAS u32x4*)(stage + NB_V + (key * 144 + vec * 8) * 2) = r[2 + i]; }
}
template <int KIND> __device__ __forceinline__ bool nb_valid(int t, int kidx) {
    if (KIND == 0) return kidx < NCMP && kidx * 16 + 31 <= t;
    if (KIND == 1) return kidx <= t;
    return kidx <= t && kidx > t - 512 && kidx >= 0;
}
constexpr float NB_SC = 0.12751743082459868f;
template <int KIND, int MODE>
__device__ __forceinline__ void flash_block(const LAS unsigned char* stage, const bf16x8 (&Q)[2][4], f32x4 (&O)[2][8], float (&m)[2], float (&l)[2], const float (&il)[2],
                                            int kidx0, const int (&trow)[2], const bool (&lane_ok)[2], const bool (&act)[2], bool full, LAS float* IMP, int tokl0, int lane) {
    const int fr = lane & 15, fq = lane >> 4;
    const LAS bf16* Kt = (const LAS bf16*)(stage + NB_K); const LAS bf16* Vt = (const LAS bf16*)(stage + NB_V);
    f32x4 S[2][4];
#pragma unroll
    for (int rg = 0; rg < 2; ++rg)
#pragma unroll
        for (int t = 0; t < 4; ++t) S[rg][t] = (f32x4){0.f, 0.f, 0.f, 0.f};
    if (act[0] && act[1]) {
#pragma unroll
        for (int ks = 0; ks < 4; ++ks)
#pragma unroll
            for (int t = 0; t < 4; ++t) { const bf16x8 kf = ldfrag(Kt, 136, 16 * t + fr, 32 * ks + 8 * fq); S[0][t] = mma16(kf, Q[0][ks], S[0][t]); S[1][t] = mma16(kf, Q[1][ks], S[1][t]); }
    } else if (act[0]) {
#pragma unroll
        for (int ks = 0; ks < 4; ++ks)
#pragma unroll
            for (int t = 0; t < 4; ++t) S[0][t] = mma16(ldfrag(Kt, 136, 16 * t + fr, 32 * ks + 8 * fq), Q[0][ks], S[0][t]);
    } else if (act[1]) {
#pragma unroll
        for (int ks = 0; ks < 4; ++ks)
#pragma unroll
            for (int t = 0; t < 4; ++t) S[1][t] = mma16(ldfrag(Kt, 136, 16 * t + fr, 32 * ks + 8 * fq), Q[1][ks], S[1][t]);
    }
    __builtin_amdgcn_sched_barrier(0);
    bf16x8 P[2][2];
    const float NINF = -__builtin_inff();
#pragma unroll
    for (int rg = 0; rg < 2; ++rg) {
        if (!act[rg]) continue;
        float mx = NINF;
        if (full) {
#pragma unroll
            for (int t = 0; t < 4; ++t)
#pragma unroll
                for (int r = 0; r < 4; ++r) { const float sv = S[rg][t][r] * NB_SC; S[rg][t][r] = sv; mx = fmaxf(mx, sv); }
        } else {
#pragma unroll
            for (int t = 0; t < 4; ++t)
#pragma unroll
                for (int r = 0; r < 4; ++r) { const bool ok = nb_valid<KIND>(trow[rg], kidx0 + 16 * t + 4 * fq + r); const float sv = ok ? S[rg][t][r] * NB_SC : NINF; S[rg][t][r] = sv; mx = fmaxf(mx, sv); }
        }
        if (KIND == 1) mx = lane_ok[rg] ? mx : NINF;
        float mn, scale_l = 1.0f;
        if (MODE == 2) { mn = m[rg]; scale_l = il[rg]; }
        else { mx = fmaxf(mx, __shfl_xor(mx, 16)); mx = fmaxf(mx, __shfl_xor(mx, 32)); mn = fmaxf(m[rg], mx); }
        const float mne = (KIND == 1) ? (lane_ok[rg] ? mn : 1e30f) : mn;
        float ps = 0.f;
#pragma unroll
        for (int t = 0; t < 4; ++t)
#pragma unroll
            for (int r = 0; r < 4; ++r) { float p = __builtin_amdgcn_exp2f(S[rg][t][r] - mne); if (MODE == 2) p *= scale_l; ps += p; S[rg][t][r] = p; }
        if (MODE != 2) { const float al = __builtin_amdgcn_exp2f(m[rg] - mn); m[rg] = mn; l[rg] = l[rg] * al + ps;
            if (MODE == 0 && !__all(al == 1.0f)) {
#pragma unroll
                for (int dt = 0; dt < 8; ++dt) O[rg][dt] *= al; } }
        if (MODE == 2) {
#pragma unroll
            for (int t = 0; t < 4; ++t) { float G = (S[rg][t][0] + S[rg][t][1]) + (S[rg][t][2] + S[rg][t][3]), last = S[rg][t][3];
                G += __shfl_xor(G, 1); G += __shfl_xor(G, 2); last += __shfl_xor(last, 1); last += __shfl_xor(last, 2);
                const int j = (kidx0 >> 2) + 4 * t + fq, tok = tokl0 + rg * 4 + (fr >> 2);
                if ((fr & 3) == 0 && j < 128) { IMP[tok * 128 + j] += G; if (j + 1 < 128) IMP[tok * 128 + j + 1] += last; } } }
        if (MODE != 1) {
#pragma unroll
            for (int s = 0; s < 2; ++s) { u32x4 w; w.x = pg8::cvt_pk_bf16(S[rg][2 * s][0], S[rg][2 * s][1]); w.y = pg8::cvt_pk_bf16(S[rg][2 * s][2], S[rg][2 * s][3]); w.z = pg8::cvt_pk_bf16(S[rg][2 * s + 1][0], S[rg][2 * s + 1][1]); w.w = pg8::cvt_pk_bf16(S[rg][2 * s + 1][2], S[rg][2 * s + 1][3]);
                P[rg][s] = __builtin_bit_cast(bf16x8, w); } }
    }
    __builtin_amdgcn_sched_barrier(0);
    if (MODE != 1) {
        const int a = fr >> 2, p4 = fr & 3;
#define NB_VFRAG(s, dt) const s16x4 v0 = __builtin_amdgcn_ds_read_tr16_b64_v4i16((LAS s16x4*)(Vt + (32 * (s) + 4 * fq + a) * 144 + 16 * (dt) + 4 * p4)); \
                const s16x4 v1 = __builtin_amdgcn_ds_read_tr16_b64_v4i16((LAS s16x4*)(Vt + (32 * (s) + 16 + 4 * fq + a) * 144 + 16 * (dt) + 4 * p4)); \
                const bf16x8 vf = {v0[0], v0[1], v0[2], v0[3], v1[0], v1[1], v1[2], v1[3]};
        if (act[0] && act[1]) {
#pragma unroll
            for (int s = 0; s < 2; ++s)
#pragma unroll
                for (int dt = 0; dt < 8; ++dt) { NB_VFRAG(s, dt) O[0][dt] = mma16(vf, P[0][s], O[0][dt]); O[1][dt] = mma16(vf, P[1][s], O[1][dt]); }
        } else if (act[0]) {
#pragma unroll
            for (int s = 0; s < 2; ++s)
#pragma unroll
                for (int dt = 0; dt < 8; ++dt) { NB_VFRAG(s, dt) O[0][dt] = mma16(vf, P[0][s], O[0][dt]); }
        } else if (act[1]) {
#pragma unroll
            for (int s = 0; s < 2; ++s)
#pragma unroll
                for (int dt = 0; dt < 8; ++dt) { NB_VFRAG(s, dt) O[1][dt] = mma16(vf, P[1][s], O[1][dt]); }
        }
#undef NB_VFRAG
    }
}
template <int KIND, int MODE>
__device__ __forceinline__ void flash_pass(LAS unsigned char* lds, const KVSrc& src, int b0, int b1, const bf16x8 (&Q)[2][4], f32x4 (&O)[2][8], float (&m)[2], float (&l)[2], const float (&il)[2],
                                           const int (&trow)[2], int tokl0, int tmin, int tid, int lane) {
    LAS float* IMP = (LAS float*)(lds + NB_IMP); const LAS unsigned* SEL = (const LAS unsigned*)(lds + NB_SEL);
    if (b1 <= b0) return;
    u32x4 pre[4];
    kv_load(src, b0 * 64, tid, pre); kv_store(lds, tid, pre);
    __syncthreads();
    for (int b = b0; b < b1; ++b) {
        LAS unsigned char* cur = lds + ((b - b0) & 1) * NB_STAGE; LAS unsigned char* nxt = lds + (((b - b0) & 1) ^ 1) * NB_STAGE;
        const bool more = b + 1 < b1;
        if (more) kv_load(src, (b + 1) * 64, tid, pre);
        bool lane_ok[2] = {true, true}, act[2] = {true, true};
        if (KIND == 1) {
#pragma unroll
            for (int rg = 0; rg < 2; ++rg) { const int tok = tokl0 + rg * 4 + ((lane & 15) >> 2); lane_ok[rg] = (SEL[tok * 4 + (b >> 5)] >> (b & 31)) & 1u; act[rg] = __any(lane_ok[rg]); } }
        bool full;
        if (KIND == 0) full = (b * 64 + 63 < NCMP) && ((b * 64 + 63) * 16 + 31 <= tmin);
        else if (KIND == 1) full = b * 64 + 63 <= tmin;
        else full = (b * 64 + 63 <= tmin) && (b * 64 > tmin + 7 - 512);
        flash_block<KIND, MODE>(cur, Q, O, m, l, il, b * 64, trow, lane_ok, act, full, IMP, tokl0, lane);
        if (more) kv_store(nxt, tid, pre);
        __syncthreads();
    }
}
__device__ __forceinline__ void nb_emit(unsigned char* ws, f32x4 (&O)[2][8], const float (&f)[2], const int (&trow)[2], int g, int mode, int lane) {
    const int fr = lane & 15, fq = lane >> 4; const bf16* proj = (const bf16*)(ws + WS_PROJ);
#pragma unroll
    for (int rg = 0; rg < 2; ++rg) { const int t = trow[rg], head = g * 4 + (fr & 3);
#pragma unroll
        for (int dt = 0; dt < 8; ++dt) { const int ch = head * 128 + 16 * dt + 4 * fq; float* tp = (float*)(ws + WS_TF) + (size_t)t * DM + ch;
            f32x4 v = O[rg][dt] * f[rg];
            if (mode > 0) v += *(const f32x4*)tp;
            if (mode < 2) *(f32x4*)tp = v;
            else { const u32x2 zw = *(const u32x2*)(proj + (size_t)t * NPROJ + C_ZB + ch);
                u32x2 w; w.x = pk2(v[0] * siluf(blo(zw.x)), v[1] * siluf(bhi(zw.x))); w.y = pk2(v[2] * siluf(blo(zw.y)), v[3] * siluf(bhi(zw.y)));
                *(u32x2*)((bf16*)(ws + WS_YB) + (size_t)t * DM + ch) = w; }
            O[rg][dt] = (f32x4){0.f, 0.f, 0.f, 0.f}; } }
}
__device__ __forceinline__ float nb_rowsum(float l) { l += __shfl_xor(l, 16); l += __shfl_xor(l, 32); return l; }

__device__ __forceinline__ void nsa_attn2_unit(ArgsP A, LAS unsigned char* lds, int qt, int g, int tid, int lane, int wave) {
    tid = fresh(tid); lane = fresh(lane); wave = fresh_s(wave);
    unsigned char* ws = A->ws; const bf16* proj = (const bf16*)(ws + WS_PROJ); const float* small = (const float*)(ws + WS_SMALL);
    LAS float* IMP = (LAS float*)(lds + NB_IMP); LAS unsigned* SEL = (LAS unsigned*)(lds + NB_SEL);
    const int t0 = qt * 64, tlast = t0 + 63, fr = lane & 15, fq = lane >> 4, tokl0 = wave * 8;
    int trow[2]; trow[0] = t0 + tokl0 + (fr >> 2); trow[1] = trow[0] + 4;
    bf16x8 Q[2][4];
#pragma unroll
    for (int rg = 0; rg < 2; ++rg)
#pragma unroll
        for (int ks = 0; ks < 4; ++ks) Q[rg][ks] = *(const bf16x8*)(proj + (size_t)trow[rg] * NPROJ + C_QB + (g * 4 + (fr & 3)) * 128 + 32 * ks + 8 * fq);
    for (int i = tid; i < 64 * 128; i += 512) IMP[i] = 0.f;
    if (tid < 256) SEL[tid] = 0u;
    f32x4 O[2][8];
#pragma unroll
    for (int rg = 0; rg < 2; ++rg)
#pragma unroll
        for (int dt = 0; dt < 8; ++dt) O[rg][dt] = (f32x4){0.f, 0.f, 0.f, 0.f};
    float m[2], l[2], il[2] = {0.f, 0.f}, gate[2], f[2];
    const int curlast = tlast >> 6;
    { m[0] = m[1] = -1e30f; l[0] = l[1] = 0.f;
      KVSrc src{proj + C_KWB + g * 128, proj + C_VWB + g * 128, (size_t)NPROJ, L_SEQ - 1};
      const int kmin = t0 - 511 > 0 ? t0 - 511 : 0;
      flash_pass<2, 0>(lds, src, kmin >> 6, curlast + 1, Q, O, m, l, il, trow, tokl0, t0 + tokl0, tid, lane);
#pragma unroll
      for (int rg = 0; rg < 2; ++rg) { const float lr = nb_rowsum(l[rg]); gate[rg] = sigm(small[(size_t)trow[rg] * 256 + 32 + (g * 4 + (fr & 3)) * 3 + 2]); f[rg] = lr > 0.f ? gate[rg] / lr : 0.f; }
      nb_emit(ws, O, f, trow, g, 0, lane); }
    { m[0] = m[1] = -1e30f; l[0] = l[1] = 0.f;
      KVSrc src{(const bf16*)(ws + WS_KVC) + g * 128, (const bf16*)(ws + WS_KVC + 524288) + g * 128, (size_t)512, NCMP - 1};
      const int nt = ((tlast - 31) / 16) / 64 + 1;
      flash_pass<0, 1>(lds, src, 0, nt, Q, O, m, l, il, trow, tokl0, t0 + tokl0, tid, lane);
#pragma unroll
      for (int rg = 0; rg < 2; ++rg) { const float lr = nb_rowsum(l[rg]); il[rg] = lr > 0.f ? 1.0f / lr : 0.f; }
      flash_pass<0, 2>(lds, src, 0, nt, Q, O, m, l, il, trow, tokl0, t0 + tokl0, tid, lane);
#pragma unroll
      for (int rg = 0; rg < 2; ++rg) f[rg] = sigm(small[(size_t)trow[rg] * 256 + 32 + (g * 4 + (fr & 3)) * 3 + 0]);
      nb_emit(ws, O, f, trow, g, 1, lane); }
    __syncthreads();
#pragma unroll 1
    for (int tk = 0; tk < 8; ++tk) { const int tt = tokl0 + tk, t = t0 + tt, cur = t >> 6;
        unsigned u0, u1;
        { const int j0 = lane, j1 = lane + 64;
          const bool f0 = (j0 == 0) || (j0 == cur) || (j0 + 1 == cur), f1 = (j1 == cur) || (j1 + 1 == cur);
          u0 = f0 ? 0x7f800001u : (j0 <= cur ? __float_as_uint(IMP[tt * 128 + j0]) + 1u : 0u);
          u1 = f1 ? 0x7f800001u : (j1 <= cur ? __float_as_uint(IMP[tt * 128 + j1]) + 1u : 0u); }
        unsigned T = 0u;
#pragma unroll
        for (int bit = 31; bit >= 0; --bit) { const unsigned cand = T | (1u << bit);
            const int cnt = __popcll(__ballot(u0 >= cand)) + __popcll(__ballot(u1 >= cand));
            if (cnt >= 16) T = cand; }
        const unsigned long long g0 = __ballot(u0 > T), g1 = __ballot(u1 > T), e0 = __ballot(u0 == T), e1 = __ballot(u1 == T);
        const int need = 16 - (__popcll(g0) + __popcll(g1));
        const unsigned long long lt = (1ull << lane) - 1ull;
        const bool s0 = (u0 > T) || (u0 == T && __popcll(e0 & lt) < need);
        const bool s1 = (u1 > T) || (u1 == T && __popcll(e0) + __popcll(e1 & lt) < need);
        const unsigned long long m0 = __ballot(s0 && u0 != 0u), m1 = __ballot(s1 && u1 != 0u);
        if (lane == 0) { SEL[tt * 4 + 0] = (unsigned)m0; SEL[tt * 4 + 1] = (unsigned)(m0 >> 32); SEL[tt * 4 + 2] = (unsigned)m1; SEL[tt * 4 + 3] = (unsigned)(m1 >> 32); }
    }
    __syncthreads();
    { m[0] = m[1] = -1e30f; l[0] = l[1] = 0.f;
      KVSrc src{proj + C_KSB + g * 128, proj + C_VSB + g * 128, (size_t)NPROJ, L_SEQ - 1};
      flash_pass<1, 0>(lds, src, 0, curlast + 1, Q, O, m, l, il, trow, tokl0, t0 + tokl0, tid, lane);
#pragma unroll
      for (int rg = 0; rg < 2; ++rg) { const float lr = nb_rowsum(l[rg]); gate[rg] = sigm(small[(size_t)trow[rg] * 256 + 32 + (g * 4 + (fr & 3)) * 3 + 1]); f[rg] = lr > 0.f ? gate[rg] / lr : 0.f; }
      nb_emit(ws, O, f, trow, g, 2, lane); }
    __syncthreads();
}

__device__ __forceinline__ bf16x8 ldfrag_trN(const LAS bf16* img, int stride, int row0, int k0, int fr, int fq) {
    const int a = fr >> 2, p4 = fr & 3;
    const s16x4 v0 = __builtin_amdgcn_ds_read_tr16_b64_v4i16((LAS s16x4*)(img + (k0 + 8 * fq + a) * stride + row0 + 4 * p4));
    const s16x4 v1 = __builtin_amdgcn_ds_read_tr16_b64_v4i16((LAS s16x4*)(img + (k0 + 8 * fq + 4 + a) * stride + row0 + 4 * p4));
    return (bf16x8){v0[0], v0[1], v0[2], v0[3], v1[0], v1[1], v1[2], v1[3]};
}
__device__ __forceinline__ bf16x8 ldfrag_trP(const LAS bf16* img, int stride, int row0, int k0, int fr, int fq) {
    const int a = fr >> 2, p4 = fr & 3;
    const s16x4 v0 = __builtin_amdgcn_ds_read_tr16_b64_v4i16((LAS s16x4*)(img + (k0 + 4 * fq + a) * stride + row0 + 4 * p4));
    const s16x4 v1 = __builtin_amdgcn_ds_read_tr16_b64_v4i16((LAS s16x4*)(img + (k0 + 16 + 4 * fq + a) * stride + row0 + 4 * p4));
    return (bf16x8){v0[0], v0[1], v0[2], v0[3], v1[0], v1[1], v1[2], v1[3]};
}
__device__ __forceinline__ u32x4 pack8(const float (&o)[8]) { u32x4 w; w.x = pg8::cvt_pk_bf16(o[0], o[1]); w.y = pg8::cvt_pk_bf16(o[2], o[3]); w.z = pg8::cvt_pk_bf16(o[4], o[5]); w.w = pg8::cvt_pk_bf16(o[6], o[7]); return w; }
__device__ __forceinline__ void rotary8t(const u32x4 v, const float* rot, int t, int d0, float sc, float (&o)[8]) {
    const f32x4 r0 = *(const f32x4*)(rot + ((size_t)t * 128 + (d0 >> 1)) * 2), r1 = *(const f32x4*)(rot + ((size_t)t * 128 + (d0 >> 1)) * 2 + 4);
    const float x0 = blo(v.x), x1 = bhi(v.x), x2 = blo(v.y), x3 = bhi(v.y), x4 = blo(v.z), x5 = bhi(v.z), x6 = blo(v.w), x7 = bhi(v.w);
    o[0] = (x0 * r0[0] - x1 * r0[1]) * sc; o[1] = (x0 * r0[1] + x1 * r0[0]) * sc; o[2] = (x2 * r0[2] - x3 * r0[3]) * sc; o[3] = (x2 * r0[3] + x3 * r0[2]) * sc;
    o[4] = (x4 * r1[0] - x5 * r1[1]) * sc; o[5] = (x4 * r1[1] + x5 * r1[0]) * sc; o[6] = (x6 * r1[2] - x7 * r1[3]) * sc; o[7] = (x6 * r1[3] + x7 * r1[2]) * sc;
}

constexpr int SA2_XS = 0, SA2_BS = 69632, SA2_ACS = 106496, SA2_DTV = 108544;
__device__ __forceinline__ void ssd_states_unit2(ArgsP A, const LayerP& P, LAS unsigned char* lds, int c, int g, int tid, int lane, int wave) {
    tid = fresh(tid); lane = fresh(lane); wave = fresh_s(wave);
    unsigned char* ws = A->ws;
    const bf16* proj = (const bf16*)(ws + WS_PROJ); const float* small = (const float*)(ws + WS_SMALL);
    LAS bf16* XS = (LAS bf16*)(lds + SA2_XS); LAS bf16* BS = (LAS bf16*)(lds + SA2_BS);
    LAS float* acs = (LAS float*)(lds + SA2_ACS); LAS float* dtv = (LAS float*)(lds + SA2_DTV);
    const int t0 = c * 128;
    { const int l = tid >> 2, hh = tid & 3, h = g * 4 + hh, t = t0 + l;
      const float raw = small[(size_t)t * 256 + h] + P.dt_bias[h];
      const float dt = raw > 20.f ? raw : log1pf(expf(raw));
      const float a = -expf(P.a_log[h]) * dt;
      dtv[l * 4 + hh] = dt; acs[l * 4 + hh] = a;
      ((float*)(ws + WS_DTV))[(size_t)t * 32 + h] = dt; }
    __syncthreads();
    if (wave < 4) {
        const int hh = wave; const float v0 = acs[(2 * lane) * 4 + hh], v1 = acs[(2 * lane + 1) * 4 + hh]; float s = v0 + v1;
#pragma unroll
        for (int d = 1; d < 64; d <<= 1) { const float t = __shfl_up(s, d); if (lane >= d) s += t; }
        const float ex = s - (v0 + v1);
        acs[(2 * lane) * 4 + hh] = ex + v0; acs[(2 * lane + 1) * 4 + hh] = ex + v0 + v1;
    }
    __syncthreads();
    { const int l = tid >> 2, hh = tid & 3; ((float*)(ws + WS_ACS))[(size_t)(t0 + l) * 32 + g * 4 + hh] = acs[l * 4 + hh];
      if (tid < 4) ((float*)(ws + WS_CD))[c * 32 + g * 4 + tid] = __expf(acs[127 * 4 + tid]); }
#pragma unroll 4
    for (int item = fresh(tid); item < 48 * 128; item += 512) {
        const int l = item / 48, v = item % 48, t = t0 + l; float o[8];
        const bool isx = v < 32; const int hh = isx ? (v >> 3) : 0, n0 = (v - 32) * 8;
        const int col0 = isx ? C_XA + g * 256 + v * 8 : C_BA + g * 128 + n0, cch0 = isx ? g * 256 + v * 8 : 2048 + g * 128 + n0;
        conv8(proj, t, col0, P.conv_w, P.conv_b, cch0, o);
        const float sc = isx ? dtv[l * 4 + hh] * __expf(acs[127 * 4 + hh] - acs[l * 4 + hh]) : 1.0f;
#pragma unroll
        for (int i = 0; i < 8; ++i) o[i] *= sc;
        *(LAS u32x4*)(isx ? XS + l * 272 + v * 8 : BS + l * 144 + n0) = pack8(o);
    }
    __syncthreads();
    { f32x4 acc[2][8];
#pragma unroll
      for (int a = 0; a < 2; ++a)
#pragma unroll
          for (int b = 0; b < 8; ++b) acc[a][b] = (f32x4){0.f, 0.f, 0.f, 0.f};
      const int fr = lane & 15, fq = lane >> 4;
#pragma unroll
      for (int ks = 0; ks < 4; ++ks) {
          bf16x8 xf[2];
#pragma unroll
          for (int a = 0; a < 2; ++a) xf[a] = ldfrag_trP(XS, 272, wave * 32 + a * 16, ks * 32, fr, fq);
#pragma unroll
          for (int b = 0; b < 8; ++b) { const bf16x8 yf = ldfrag_trP(BS, 144, b * 16, ks * 32, fr, fq);
#pragma unroll
              for (int a = 0; a < 2; ++a) acc[a][b] = mma16(xf[a], yf, acc[a][b]); }
      }
      const int hh = wave >> 1, h = g * 4 + hh;
      float* st = (float*)(ws + WS_ST) + ((size_t)(c * 32 + h) * 64) * 128;
#pragma unroll
      for (int a = 0; a < 2; ++a)
#pragma unroll
          for (int b = 0; b < 8; ++b)
#pragma unroll
              for (int r = 0; r < 4; ++r) { const int p = (wave & 1) * 32 + a * 16 + fq * 4 + r, n = b * 16 + fr; st[(size_t)p * 128 + n] = acc[a][b][r]; }
    }
    __syncthreads();
}

constexpr int SC2_CM = 0, SC2_BM = 34816, SC2_MH = 69632, SC2_XS = 104448, SC2_PV = 122880, SC2_ACS = 140288, SC2_DTV = 142336;
__device__ __forceinline__ void ssd_out_unit2(ArgsP A, const LayerP& P, float* rowss, LAS unsigned char* lds, int c, int g, int tid, int lane, int wave) {
    tid = fresh(tid); lane = fresh(lane); wave = fresh_s(wave);
    unsigned char* ws = A->ws;
    const bf16* proj = (const bf16*)(ws + WS_PROJ);
    LAS bf16* CM = (LAS bf16*)(lds + SC2_CM); LAS bf16* BM = (LAS bf16*)(lds + SC2_BM); LAS bf16* MH = (LAS bf16*)(lds + SC2_MH);
    LAS bf16* XS = (LAS bf16*)(lds + SC2_XS); LAS bf16* PV = (LAS bf16*)(lds + SC2_PV);
    LAS float* acs = (LAS float*)(lds + SC2_ACS); LAS float* dtv = (LAS float*)(lds + SC2_DTV);
    const int t0 = c * 128, fr = lane & 15, fq = lane >> 4;
    { const int l = tid >> 2, hh = tid & 3; acs[l * 4 + hh] = ((const float*)(ws + WS_ACS))[(size_t)(t0 + l) * 32 + g * 4 + hh]; dtv[l * 4 + hh] = ((const float*)(ws + WS_DTV))[(size_t)(t0 + l) * 32 + g * 4 + hh]; }
#pragma unroll 4
    for (int item = fresh(tid); item < 32 * 128; item += 512) {
        const int l = item >> 5, v = item & 31, t = t0 + l; float o[8];
        const int n0 = (v & 15) * 8, ch = g * 128 + n0;
        conv8(proj, t, (v < 16 ? C_BA : C_CA) + ch, P.conv_w, P.conv_b, (v < 16 ? 2048 : 3072) + ch, o);
        *(LAS u32x4*)((v < 16 ? BM : CM) + l * 136 + n0) = pack8(o);
    }
    __syncthreads();
    f32x4 cb[8];
#pragma unroll
    for (int b = 0; b < 8; ++b) cb[b] = (f32x4){0.f, 0.f, 0.f, 0.f};
#pragma unroll
    for (int ks = 0; ks < 4; ++ks) { const bf16x8 xf = ldfrag(CM, 136, wave * 16 + fr, ks * 32 + fq * 8);
#pragma unroll
        for (int b = 0; b < 8; ++b) cb[b] = mma16(xf, ldfrag(BM, 136, b * 16 + fr, ks * 32 + fq * 8), cb[b]); }
    float ssq[4] = {0.f, 0.f, 0.f, 0.f};
    for (int hh = 0; hh < 4; ++hh) {
        const int h = g * 4 + hh;
#pragma unroll 2
        for (int item = fresh(tid); item < 8 * 128; item += 512) { const int l = item >> 3, v = item & 7, ch = h * 64 + v * 8; float o[8];
            conv8(proj, t0 + l, C_XA + ch, P.conv_w, P.conv_b, ch, o);
            *(LAS u32x4*)(XS + l * 72 + v * 8) = pack8(o); }
        { const float* st = (const float*)(ws + WS_ST) + ((size_t)(c * 32 + h) * 64) * 128;
#pragma unroll 2
          for (int item = fresh(tid); item < 64 * 16; item += 512) { const int p = item >> 4, n0 = (item & 15) * 8;
              const f32x4 a = *(const f32x4*)(st + p * 128 + n0), b = *(const f32x4*)(st + p * 128 + n0 + 4);
              u32x4 w; w.x = pg8::cvt_pk_bf16(a[0], a[1]); w.y = pg8::cvt_pk_bf16(a[2], a[3]); w.z = pg8::cvt_pk_bf16(b[0], b[1]); w.w = pg8::cvt_pk_bf16(b[2], b[3]);
              *(LAS u32x4*)(PV + p * 136 + n0) = w; } }
#pragma unroll
        for (int b = 0; b < 8; ++b)
#pragma unroll
            for (int r = 0; r < 4; ++r) { const int l = wave * 16 + fq * 4 + r, s = b * 16 + fr;
                const float v = (s <= l) ? cb[b][r] * __expf(acs[l * 4 + hh] - acs[s * 4 + hh]) * dtv[s * 4 + hh] : 0.f;
                MH[l * 136 + s] = (bf16)f2bf(v); }
        unsigned short zr[4][4];
#pragma unroll
        for (int r = 0; r < 4; ++r)
#pragma unroll
            for (int b = 0; b < 4; ++b) zr[r][b] = proj[(size_t)(t0 + wave * 16 + fq * 4 + r) * NPROJ + C_ZA + h * 64 + b * 16 + fr];
        __syncthreads();
        f32x4 yd[4], yo[4];
#pragma unroll
        for (int b = 0; b < 4; ++b) { yd[b] = (f32x4){0.f, 0.f, 0.f, 0.f}; yo[b] = (f32x4){0.f, 0.f, 0.f, 0.f}; }
#pragma unroll
        for (int ks = 0; ks < 4; ++ks) { const bf16x8 mf = ldfrag(MH, 136, wave * 16 + fr, ks * 32 + fq * 8), cf = ldfrag(CM, 136, wave * 16 + fr, ks * 32 + fq * 8);
#pragma unroll
            for (int b = 0; b < 4; ++b) { yd[b] = mma16(mf, ldfrag_trN(XS, 72, b * 16, ks * 32, fr, fq), yd[b]); yo[b] = mma16(cf, ldfrag(PV, 136, b * 16 + fr, ks * 32 + fq * 8), yo[b]); } }
        const float dsk = P.d_skip[h];
#pragma unroll
        for (int r = 0; r < 4; ++r) { const int l = wave * 16 + fq * 4 + r, t = t0 + l; const float ea = __expf(acs[l * 4 + hh]);
#pragma unroll
            for (int b = 0; b < 4; ++b) { const int p = b * 16 + fr, ch = h * 64 + p;
                const float xs = bf2f(XS[l * 72 + p]);
                const float y = yd[b][r] + yo[b][r] * ea + xs * dsk;
                const float z = bf2f(zr[r][b]);
                const float yg = y * siluf(z);
                ssq[r] += yg * yg;
                ((bf16*)(ws + WS_YA))[(size_t)t * DM + ch] = (bf16)f2bf(yg * P.ssm_norm[ch]); } }
        __syncthreads();
    }
#pragma unroll
    for (int r = 0; r < 4; ++r) { float s = ssq[r]; s += __shfl_xor(s, 1); s += __shfl_xor(s, 2); s += __shfl_xor(s, 4); s += __shfl_xor(s, 8);
        if (fr == 0) atomicAdd(rowss + t0 + wave * 16 + fq * 4 + r, s); }
}

constexpr int RA2_VS = 0, RA2_KS = 69632;
__device__ __forceinline__ void ret_kv_unit2(ArgsP A, LAS unsigned char* lds, int c, int h, int tid, int lane, int wave) {
    tid = fresh(tid); lane = fresh(lane); wave = fresh_s(wave);
    unsigned char* ws = A->ws; const bf16* proj = (const bf16*)(ws + WS_PROJ); const float* rot = (const float*)(ws + WS_ROT);
    LAS bf16* VS = (LAS bf16*)(lds + RA2_VS); LAS bf16* KS = (LAS bf16*)(lds + RA2_KS);
    const int t0 = c * 128; const float lg = ret_logg(h);
#pragma unroll 4
    for (int item = fresh(tid); item < 32 * 128; item += 512) { const int j = item >> 5, v = item & 31;
        *(LAS u32x4*)(VS + j * 272 + v * 8) = *(const u32x4*)(proj + (size_t)(t0 + j) * NPROJ + C_VC + h * 256 + v * 8); }
#pragma unroll 4
    for (int item = fresh(tid); item < 32 * 128; item += 512) { const int j = item >> 5, d0 = (item & 31) * 8, t = t0 + j; float o[8];
        const u32x4 w = *(const u32x4*)(proj + (size_t)t * NPROJ + C_KC + h * 256 + d0);
        rotary8t(w, rot, t, d0, 0.0625f * __expf(lg * (float)(127 - j)), o);
        *(LAS u32x4*)(KS + j * 272 + d0) = pack8(o); }
    __syncthreads();
    const int fr = lane & 15, fq = lane >> 4;
    float* out = (float*)(ws + WS_KVT) + (size_t)(c * 8 + h) * 65536;
    for (int half = 0; half < 2; ++half) {
        f32x4 acc[2][8];
#pragma unroll
        for (int a = 0; a < 2; ++a)
#pragma unroll
            for (int b = 0; b < 8; ++b) acc[a][b] = (f32x4){0.f, 0.f, 0.f, 0.f};
#pragma unroll
        for (int ks = 0; ks < 4; ++ks) { bf16x8 xf[2];
#pragma unroll
            for (int a = 0; a < 2; ++a) xf[a] = ldfrag_trP(VS, 272, wave * 32 + a * 16, ks * 32, fr, fq);
#pragma unroll
            for (int b = 0; b < 8; ++b) { const bf16x8 yf = ldfrag_trP(KS, 272, half * 128 + b * 16, ks * 32, fr, fq);
#pragma unroll
                for (int a = 0; a < 2; ++a) acc[a][b] = mma16(xf[a], yf, acc[a][b]); } }
#pragma unroll
        for (int a = 0; a < 2; ++a)
#pragma unroll
            for (int b = 0; b < 8; ++b)
#pragma unroll
                for (int r = 0; r < 4; ++r) { const int e = wave * 32 + a * 16 + fq * 4 + r, d = half * 128 + b * 16 + fr; out[(size_t)e * 256 + d] = acc[a][b][r]; }
    }
    __syncthreads();
}

constexpr int RC2_Q = 0, RC2_K = 67584, RC2_S = 67584, RC2_VS = 102400, RC2_RT = 67584;
__device__ __forceinline__ void ret_out_unit2(ArgsP A, const LayerP& P, LAS unsigned char* lds, int c, int h, int tid, int lane, int wave) {
    tid = fresh(tid); lane = fresh(lane); wave = fresh_s(wave);
    unsigned char* ws = A->ws; const bf16* proj = (const bf16*)(ws + WS_PROJ); const float* rot = (const float*)(ws + WS_ROT);
    LAS bf16* Q = (LAS bf16*)(lds + RC2_Q); LAS bf16* K = (LAS bf16*)(lds + RC2_K); LAS bf16* S = (LAS bf16*)(lds + RC2_S);
    LAS bf16* VS = (LAS bf16*)(lds + RC2_VS); LAS bf16* RT = (LAS bf16*)(lds + RC2_RT);
    const int t0 = c * 128, fr = lane & 15, fq = lane >> 4; const float lg = ret_logg(h);
#pragma unroll 8
    for (int item = fresh(tid); item < 64 * 128; item += 512) { const int j = item >> 6, v = item & 63, t = t0 + j, d0 = (v & 31) * 8; float o[8];
        const u32x4 w = *(const u32x4*)(proj + (size_t)t * NPROJ + (v < 32 ? C_QC : C_KC) + h * 256 + d0);
        rotary8t(w, rot, t, d0, v < 32 ? 1.0f : 0.0625f, o);
        *(LAS u32x4*)((v < 32 ? Q : K) + j * 264 + d0) = pack8(o); }
    __syncthreads();
    f32x4 sc[8];
#pragma unroll
    for (int b = 0; b < 8; ++b) sc[b] = (f32x4){0.f, 0.f, 0.f, 0.f};
#pragma unroll
    for (int ks = 0; ks < 8; ++ks) { const bf16x8 xf = ldfrag(Q, 264, wave * 16 + fr, ks * 32 + fq * 8);
#pragma unroll
        for (int b = 0; b < 8; ++b) sc[b] = mma16(xf, ldfrag(K, 264, b * 16 + fr, ks * 32 + fq * 8), sc[b]); }
    __syncthreads();
#pragma unroll
    for (int b = 0; b < 8; ++b)
#pragma unroll
        for (int r = 0; r < 4; ++r) { const int i = wave * 16 + fq * 4 + r, j = b * 16 + fr;
            S[i * 136 + j] = (bf16)f2bf(i >= j ? sc[b][r] * __expf(lg * (float)(i - j)) : 0.f); }
    f32x4 o[16];
#pragma unroll
    for (int b = 0; b < 16; ++b) o[b] = (f32x4){0.f, 0.f, 0.f, 0.f};
#pragma unroll
    for (int eh = 0; eh < 2; ++eh) {
#pragma unroll 4
        for (int item = fresh(tid); item < 16 * 128; item += 512) { const int j = item >> 4, v = item & 15;
            *(LAS u32x4*)(VS + j * 136 + v * 8) = *(const u32x4*)(proj + (size_t)(t0 + j) * NPROJ + C_VC + h * 256 + eh * 128 + v * 8); }
        __syncthreads();
#pragma unroll
        for (int ks = 0; ks < 4; ++ks) { const bf16x8 xf = ldfrag(S, 136, wave * 16 + fr, ks * 32 + fq * 8);
#pragma unroll
            for (int b = 0; b < 8; ++b) o[eh * 8 + b] = mma16(xf, ldfrag_trN(VS, 136, b * 16, ks * 32, fr, fq), o[eh * 8 + b]); }
        __syncthreads();
    }
    const float* kvt = (const float*)(ws + WS_KVT) + (size_t)(c * 8 + h) * 65536;
    float xi[4];
#pragma unroll
    for (int r = 0; r < 4; ++r) xi[r] = __expf(lg * (float)(wave * 16 + fq * 4 + r + 1));
#pragma unroll
    for (int eq = 0; eq < 4; ++eq) {
#pragma unroll 4
        for (int item = fresh(tid); item < 64 * 32; item += 512) { const int e = item >> 5, d0 = (item & 31) * 8;
            const f32x4 a = *(const f32x4*)(kvt + (size_t)(eq * 64 + e) * 256 + d0), b = *(const f32x4*)(kvt + (size_t)(eq * 64 + e) * 256 + d0 + 4);
            u32x4 w; w.x = pg8::cvt_pk_bf16(a[0], a[1]); w.y = pg8::cvt_pk_bf16(a[2], a[3]); w.z = pg8::cvt_pk_bf16(b[0], b[1]); w.w = pg8::cvt_pk_bf16(b[2], b[3]);
            *(LAS u32x4*)(RT + e * 264 + d0) = w; }
        __syncthreads();
        f32x4 cr[4];
#pragma unroll
        for (int b = 0; b < 4; ++b) cr[b] = (f32x4){0.f, 0.f, 0.f, 0.f};
#pragma unroll
        for (int ks = 0; ks < 8; ++ks) { const bf16x8 xf = ldfrag(Q, 264, wave * 16 + fr, ks * 32 + fq * 8);
#pragma unroll
            for (int b = 0; b < 4; ++b) cr[b] = mma16(xf, ldfrag(RT, 264, b * 16 + fr, ks * 32 + fq * 8), cr[b]); }
#pragma unroll
        for (int b = 0; b < 4; ++b)
#pragma unroll
            for (int r = 0; r < 4; ++r) o[eq * 4 + b][r] += cr[b][r] * xi[r];
        __syncthreads();
    }
#pragma unroll
    for (int r = 0; r < 4; ++r) {
        float s = 0.f;
#pragma unroll
        for (int b = 0; b < 16; ++b) s += o[b][r];
        s += __shfl_xor(s, 1); s += __shfl_xor(s, 2); s += __shfl_xor(s, 4); s += __shfl_xor(s, 8);
        const float mu = s * (1.0f / 256.0f); float q = 0.f;
#pragma unroll
        for (int b = 0; b < 16; ++b) { const float d = o[b][r] - mu; q += d * d; }
        q += __shfl_xor(q, 1); q += __shfl_xor(q, 2); q += __shfl_xor(q, 4); q += __shfl_xor(q, 8);
        const float rs = rsqrtf(q * (1.0f / 256.0f) + EPS);
        const int t = t0 + wave * 16 + fq * 4 + r;
#pragma unroll
        for (int b = 0; b < 16; ++b) { const int ch = h * 256 + b * 16 + fr;
            const float z = bf2f(proj[(size_t)t * NPROJ + C_ZC + ch]);
            ((bf16*)(ws + WS_YC))[(size_t)t * DM + ch] = (bf16)f2bf((o[b][r] - mu) * rs * P.ret_norm[ch] * siluf(z)); }
    }
    __syncthreads();
}

__device__ __forceinline__ void norm_pass1(const float* xin, const float* o, const float* rowss, const float* gain, float* x1, bf16* h2, int gw, int NGW, int lane) {
    for (int m = gw; m < L_SEQ; m += NGW) {
        const float rs = rsqrtf(rowss[m] * (1.0f / 2048.0f) + EPS); f32x4 v[8]; float s = 0.f;
#pragma unroll
        for (int j = 0; j < 8; ++j) { const size_t off = (size_t)m * DM + 4 * lane + 256 * j; const f32x4 xo = *(const f32x4*)(xin + off), oo = *(const f32x4*)(o + off), g = *(const f32x4*)(gain + 4 * lane + 256 * j);
            v[j] = xo + oo * rs * g; *(f32x4*)(x1 + off) = v[j]; s += (v[j][0] * v[j][0] + v[j][1] * v[j][1]) + (v[j][2] * v[j][2] + v[j][3] * v[j][3]); }
        const float r2 = rsqrtf(wave_sum(s) * (1.0f / 2048.0f) + EPS);
#pragma unroll
        for (int j = 0; j < 8; ++j) { u32x2 w; w.x = pk2(v[j][0] * r2, v[j][1] * r2); w.y = pk2(v[j][2] * r2, v[j][3] * r2); *(u32x2*)(h2 + (size_t)m * DM + 4 * lane + 256 * j) = w; }
    }
}
__device__ __forceinline__ void norm_pass2(const float* x1, const float* vv, const float* rowss, const float* gain, float* xout, bf16* hn, const float* gain_next, int gw, int NGW, int lane) {
    for (int m = gw; m < L_SEQ; m += NGW) {
        const float rs = rsqrtf(rowss[m] * (1.0f / 2048.0f) + EPS); f32x4 v[8]; float s = 0.f;
#pragma unroll
        for (int j = 0; j < 8; ++j) { const size_t off = (size_t)m * DM + 4 * lane + 256 * j; const f32x4 xo = *(const f32x4*)(x1 + off), oo = *(const f32x4*)(vv + off), g = *(const f32x4*)(gain + 4 * lane + 256 * j);
            v[j] = xo + oo * rs * g; *(f32x4*)(xout + off) = v[j]; s += (v[j][0] * v[j][0] + v[j][1] * v[j][1]) + (v[j][2] * v[j][2] + v[j][3] * v[j][3]); }
        if (hn) { const float r2 = rsqrtf(wave_sum(s) * (1.0f / 2048.0f) + EPS);
#pragma unroll
            for (int j = 0; j < 8; ++j) { const f32x4 g = *(const f32x4*)(gain_next + 4 * lane + 256 * j);
                u32x2 w; w.x = pk2(v[j][0] * r2 * g[0], v[j][1] * r2 * g[1]); w.y = pk2(v[j][2] * r2 * g[2], v[j][3] * r2 * g[3]); *(u32x2*)(hn + (size_t)m * DM + 4 * lane + 256 * j) = w; } }
    }
}

#ifndef PHMASK
#define PHMASK 0xFFFF
#endif
#define PHEN(k) ((PHMASK >> (k)) & 1)
#ifndef REP_PHASE
#define REP_PHASE -1
#endif
#define REP(k) ((REP_PHASE == (k)) ? 2 : 1)
#define JUNKSS ((float*)(ws + 768 * 1024))
#ifndef SUBMASK
#define SUBMASK 0xFFFF
#endif
#define SUBEN(k) ((SUBMASK >> (k)) & 1)
constexpr int PH_PER_LAYER = 10, N_PHASES = 1 + NLAYER * PH_PER_LAYER;
__global__ void __launch_bounds__(512, 2) hyb_fwd(Args Aval) {
    extern __shared__ __attribute__((aligned(16))) unsigned char lds_raw[];
    LAS unsigned char* lds = (LAS unsigned char*)lds_raw;
    const int tid = threadIdx.x, lane = tid & 63, wave = __builtin_amdgcn_readfirstlane(tid >> 6);
    const int G = gridDim.x, bid = blockIdx.x;
    for (int u = tid; u < 128; u += 512) ((LAS unsigned*)(lds + MISC_OFF))[u] = 0u;
    if (tid < 128) ((LAS float*)(lds + MISC_OFF + 512))[tid] = (float)exp2(-(double)(2 * tid) * (13.287712379549449 / 256.0));
    __syncthreads();
    int lo, hi, use_bar; XcdBarrier bar;
    { ArgsP A = argp(); lo = A->ph_lo; hi = A->ph_hi; use_bar = A->use_bar;
      bar.bar = (unsigned*)(A->ws + WS_CTL) + CW_BAR; bar.x = 0; bar.st = (volatile LAS unsigned*)(lds + MISC_OFF) + 8;
      if (use_bar) bar = xcd_barrier_post((unsigned*)(A->ws + WS_CTL) + CW_BAR, (volatile LAS unsigned*)(lds + MISC_OFF) + 8); }
#define IN(k) (lo <= (k) && (k) < hi)
#define SEAM(k) do { if (use_bar && IN(k) && IN((k) + 1)) xcd_barrier(bar); } while (0)
#define LAYERP(P) LayerP P; P.conv_w = A->in[5] + (size_t)l * 4 * 4096; P.conv_b = A->in[6] + (size_t)l * 4096; P.dt_bias = A->in[7] + l * 32; P.a_log = A->in[8] + l * 32; P.d_skip = A->in[9] + l * 32; \
        P.ssm_norm = A->in[10] + l * 2048; P.ret_norm = A->in[14] + l * 2048
#define ROWSS(k) ((float*)(ws + ROWSS_OFF) + (l * 3 + (k)) * L_SEQ)

    if (PHEN(0) && IN(0)) for (int rep = 0; rep < REP(0); ++rep) { ArgsP A = argp(); phase_prologue(A, lds, fresh(tid), fresh(lane), fresh_s(wave), G, bid); }
    SEAM(0);

    for (int l = 0; l < NLAYER; ++l) {
        const int pb = 1 + l * PH_PER_LAYER;
        if (PHEN(1) && IN(pb + 0)) for (int rep = 0; rep < REP(1); ++rep) { ArgsP A = argp(); unsigned char* ws = A->ws;
            pg8::Gemm g{(const bf16*)(ws + WS_HBF), (const bf16*)(ws + WS_WIN + (size_t)l * SZ_WIN), L_SEQ, NPAD, DM}; pg8::StaticOrder S; S.init(L_SEQ, NPAD, G, bid);
            pg8::EpiInProj E{(bf16*)(ws + WS_PROJ), NPROJ, (float*)(ws + WS_SMALL), NPROJ / 256};
            pg8::gemm_phase<pg8::EpiInProj, pg8::StaticOrder, true, true>(lds, g, S, E);
        }
        SEAM(pb + 0);
        if (PHEN(2) && IN(pb + 1)) for (int rep = 0; rep < REP(2); ++rep) {
            if (SUBEN(1)) { ArgsP A = argp(); LAYERP(P);
              for (int u = bid; u < 512; u += G) ssd_states_unit2(A, P, lds, u >> 3, u & 7, tid, lane, wave); }
            if (SUBEN(2)) { ArgsP A = argp();
              for (int u = bid; u < 512; u += G) ret_kv_unit2(A, lds, u >> 3, u & 7, tid, lane, wave); }
            if (SUBEN(3)) { ArgsP A = argp(); nsa_im2col(A, fresh(tid), bid, G);
              if (l == 0 && bid == G - 1) { unsigned char* ws = A->ws;
                  for (int o = fresh(tid); o < 1024; o += 512) { const float* pp = (const float*)(ws + WS_HBP) + (size_t)(o >> 8) * 64 * 256 + (o & 255); float s = 0.f;
                      for (int ck = 0; ck < 64; ++ck) s += pp[ck * 256];
                      ((float*)(ws + WS_HB))[o] = s; } } }
        }
        SEAM(pb + 1);
        if (PHEN(3) && IN(pb + 2)) {
#pragma unroll
            for (int s = 0; s < 2; ++s) { ArgsP A = argp(); unsigned char* ws = A->ws;
                pg8::Gemm g{(const bf16*)(ws + WS_AIM + (size_t)s * 16 * MiB), (const bf16*)(ws + WS_WC1 + (size_t)(l * 2 + s) * 2 * MiB), 2048, 256, 4096}; pg8::StaticOrder S; S.init(2048, 256, G, (bid + G - 8 * s) % G);
                pg8::EpiCmp1 E{(bf16*)(ws + WS_HID + (size_t)s * MiB), (const float*)(ws + WS_HB) + (l * 2 + s) * 256};
                pg8::gemm_phase<pg8::EpiCmp1, pg8::StaticOrder, true, true>(lds, g, S, E);
                __syncthreads();
            }
            if (bid >= 16) { ArgsP A = argp(); ssd_scan(A, fresh(tid), bid - 16, G - 16); ret_scan(A, fresh(tid), bid - 16, G - 16); }
        }
        SEAM(pb + 2);
        if (PHEN(4) && IN(pb + 3)) for (int rep = 0; rep < REP(4); ++rep) {
#pragma unroll
            for (int s = 0; s < 2; ++s) { ArgsP A = argp(); unsigned char* ws = A->ws;
                pg8::Gemm g{(const bf16*)(ws + WS_HID + (size_t)s * MiB), (const bf16*)(ws + WS_WC2 + (size_t)(l * 2 + s) * 131072), 2048, 256, 256}; pg8::StaticOrder S; S.init(2048, 256, G, (bid + G - 8 * s) % G);
                pg8::EpiCmp2 E{(bf16*)(ws + WS_KVC + (size_t)s * 524288)};
                pg8::gemm_phase<pg8::EpiCmp2, pg8::StaticOrder, true, true>(lds, g, S, E);
                __syncthreads();
            }
            if (SUBEN(5)) { ArgsP A = argp(); unsigned char* ws = A->ws; LAYERP(P);
              for (int u = bid; u < 512; u += G) ssd_out_unit2(A, P, rep ? JUNKSS : ROWSS(0), lds, u >> 3, u & 7, tid, lane, wave); }
            if (SUBEN(6)) { ArgsP A = argp(); LAYERP(P);
              for (int u = bid; u < 512; u += G) ret_out_unit2(A, P, lds, u >> 3, u & 7, tid, lane, wave); }
        }
        SEAM(pb + 3);
        if (PHEN(5) && IN(pb + 4)) for (int rep = 0; rep < REP(5); ++rep) { ArgsP A = argp();
            for (int u = bid; u < 512; u += G) { const int idx = u >> 2, g = u & 3; const int qt = idx < 64 ? idx : 191 - idx;
                nsa_attn2_unit(A, lds, qt, g, tid, lane, wave); }
        }
        SEAM(pb + 4);
        if (PHEN(6) && IN(pb + 5)) for (int rep = 0; rep < REP(6); ++rep) {
            { ArgsP A = argp(); unsigned char* ws = A->ws;
              pg8::Gemm g{(const bf16*)(ws + WS_YA), (const bf16*)(ws + WS_WBR + (size_t)(l * 3 + 0) * 8 * MiB), L_SEQ, DM, DM}; pg8::StaticOrder S; S.init(L_SEQ, DM, G, bid);
              pg8::EpiBranch<0> E{(bf16*)(ws + WS_TF), (bf16*)(ws + WS_MB), (const bf16*)(ws + WS_PROJ) + C_GM, NPROJ, ROWSS(0), EPS};
              pg8::gemm_phase<pg8::EpiBranch<0>, pg8::StaticOrder, true, true>(lds, g, S, E); }
            __syncthreads();
            { ArgsP A = argp(); unsigned char* ws = A->ws;
              pg8::Gemm g{(const bf16*)(ws + WS_YB), (const bf16*)(ws + WS_WBR + (size_t)(l * 3 + 1) * 8 * MiB), L_SEQ, DM, DM}; pg8::StaticOrder S; S.init(L_SEQ, DM, G, bid);
              pg8::EpiBranch<1> E{(bf16*)(ws + WS_TF), (bf16*)(ws + WS_MB), (const bf16*)(ws + WS_PROJ) + C_GM + 2048, NPROJ, ROWSS(0), EPS};
              pg8::gemm_phase<pg8::EpiBranch<1>, pg8::StaticOrder, true, true>(lds, g, S, E); }
            __syncthreads();
            { ArgsP A = argp(); unsigned char* ws = A->ws;
              pg8::Gemm g{(const bf16*)(ws + WS_YC), (const bf16*)(ws + WS_WBR + (size_t)(l * 3 + 2) * 8 * MiB), L_SEQ, DM, DM}; pg8::StaticOrder S; S.init(L_SEQ, DM, G, bid);
              pg8::EpiBranch<2> E{(bf16*)(ws + WS_TF), (bf16*)(ws + WS_MB), (const bf16*)(ws + WS_PROJ) + C_GM + 4096, NPROJ, ROWSS(0), EPS};
              pg8::gemm_phase<pg8::EpiBranch<2>, pg8::StaticOrder, true, true>(lds, g, S, E); }
        }
        SEAM(pb + 5);
        if (PHEN(7) && IN(pb + 6)) for (int rep = 0; rep < REP(7); ++rep) { ArgsP A = argp(); unsigned char* ws = A->ws;
            pg8::Gemm g{(const bf16*)(ws + WS_MB), (const bf16*)(ws + WS_WOUT + (size_t)l * 8 * MiB), L_SEQ, DM, DM}; pg8::StaticOrder S; S.init(L_SEQ, DM, G, bid);
            pg8::EpiRowSS<0> E{(float*)(ws + WS_TF), nullptr, rep ? JUNKSS : ROWSS(1)};
            pg8::gemm_phase<pg8::EpiRowSS<0>, pg8::StaticOrder, true, true>(lds, g, S, E);
        }
        SEAM(pb + 6);
        if (PHEN(8) && IN(pb + 7)) for (int rep = 0; rep < REP(8); ++rep) {
            if (SUBEN(0)) { ArgsP A = argp(); unsigned char* ws = A->ws;
              pg8::Gemm g{(const bf16*)(ws + WS_PBF) + (size_t)l * L_SEQ * PDIM, (const bf16*)(ws + WS_WPP + (size_t)l * MiB), L_SEQ, DM, fresh_s(PDIM)}; pg8::StaticOrder S; S.init(L_SEQ, DM, G, bid);
              pg8::EpiF32 E{(float*)(ws + WS_EBUF), DM};
              pg8::gemm_phase<pg8::EpiF32, pg8::StaticOrder, true, true>(lds, g, S, E); }
            __syncthreads();
          { ArgsP A = argp(); unsigned char* ws = A->ws;
            norm_pass1(l == 0 ? A->in[0] : (const float*)(ws + WS_XL), (const float*)(ws + WS_TF), ROWSS(1), A->in[3] + l * 2048, (float*)(ws + WS_X1), (bf16*)(ws + WS_HBF), bid * 8 + fresh_s(wave), G * 8, fresh(lane)); } }
        SEAM(pb + 7);
        if (PHEN(9) && IN(pb + 8)) for (int rep = 0; rep < REP(7); ++rep) { ArgsP A = argp(); unsigned char* ws = A->ws;
            pg8::Gemm g{(const bf16*)(ws + WS_HBF), (const bf16*)(ws + WS_WGATE + (size_t)l * 8 * MiB), L_SEQ, DM, DM}; pg8::StaticOrder S; S.init(L_SEQ, DM, G, bid);
            pg8::EpiRowSS<1> E{(float*)(ws + WS_TF), (const float*)(ws + WS_EBUF), rep ? JUNKSS : ROWSS(2)};
            pg8::gemm_phase<pg8::EpiRowSS<1>, pg8::StaticOrder, true, true>(lds, g, S, E);
        }
        SEAM(pb + 8);
        if (PHEN(10) && IN(pb + 9)) for (int rep = 0; rep < REP(8); ++rep) { ArgsP A = argp(); unsigned char* ws = A->ws;
            norm_pass2((const float*)(ws + WS_X1), (const float*)(ws + WS_TF), ROWSS(2), A->in[19] + l * 2048, l == NLAYER - 1 ? A->out : (float*)(ws + WS_XL),
                       l + 1 < NLAYER ? (bf16*)(ws + WS_HBF) : nullptr, l + 1 < NLAYER ? A->in[2] + (l + 1) * 2048 : nullptr, bid * 8 + fresh_s(wave), G * 8, fresh(lane)); }
        SEAM(pb + 9);
    }
#undef IN
#undef SEAM
}

#ifndef MK_ONE_LAUNCH
#define MK_ONE_LAUNCH 1
#endif
extern "C" void kernel_launch(void* const* d_in, const int* in_sizes, int n_in, void* d_out, int out_size, void* d_ws, size_t ws_size, hipStream_t stream) {
    static int grid = 0;
    if (grid == 0) {
        if (n_in != 20 || out_size != L_SEQ * DM || ws_size < WS_END) { fprintf(stderr, "kernel_launch: unexpected shapes (n_in %d, out %d, ws %zu < %zu)\n", n_in, out_size, ws_size, (size_t)WS_END); grid = -1; return; }
        int dev = 0, cus = 0, per_cu = 0;
        if (hipGetDevice(&dev) != hipSuccess || hipDeviceGetAttribute(&cus, hipDeviceAttributeMultiprocessorCount, dev) != hipSuccess) { grid = -1; return; }
        if (hipFuncSetAttribute((const void*)hyb_fwd, hipFuncAttributeMaxDynamicSharedMemorySize, LDS_BYTES) != hipSuccess) { fprintf(stderr, "kernel_launch: hipFuncSetAttribute failed\n"); grid = -1; return; }
        if (hipOccupancyMaxActiveBlocksPerMultiprocessor(&per_cu, (const void*)hyb_fwd, 512, LDS_BYTES) != hipSuccess || per_cu < 1) { fprintf(stderr, "kernel_launch: occupancy query says %d\n", per_cu); (void)hipGetLastError(); grid = -1; return; }
        grid = cus;
    }
    if (grid < 0) return;
    if (hipMemsetAsync((char*)d_ws + WS_CTL, 0, CTL_ZERO_BYTES, stream) != hipSuccess) return;
    Args a{};
    for (int i = 0; i < 20; ++i) a.in[i] = (const float*)d_in[i];
    a.out = (float*)d_out; a.ws = (unsigned char*)d_ws; a.pad = 0;
#if MK_ONE_LAUNCH
    a.ph_lo = 0; a.ph_hi = N_PHASES; a.use_bar = 1;
    hipLaunchKernelGGL(hyb_fwd, dim3(grid), dim3(512), LDS_BYTES, stream, a);
#else
    for (int ph = 0; ph < N_PHASES; ++ph) { a.ph_lo = ph; a.ph_hi = ph + 1; a.use_bar = 0; hipLaunchKernelGGL(hyb_fwd, dim3(grid), dim3(512), LDS_BYTES, stream, a); }
#endif
}
```

```cpp
#include <hip/hip_runtime.h>
#include <cstdio>
#include <cstdint>
namespace pg8 {
#define PG8_LAS __attribute__((address_space(3)))
typedef unsigned short bf16_t;
typedef short bf16x8 __attribute__((ext_vector_type(8)));
typedef float f32x4 __attribute__((ext_vector_type(4)));
typedef unsigned u32x4 __attribute__((ext_vector_type(4)));
constexpr int BM = 256, BK = 64, HALF = 128, HTB = HALF * BK * 2  , STAGE_BYTES = 8 * HTB, NXCD = 8, WGM = 8;

__host__ __device__ __forceinline__ int lds_byte(int r, int c) { const int st = (r >> 4) * 2 + (c >> 5), rr = r & 15, cc = c & 31, ob = rr * 64 + cc * 2; return st * 1024 + (ob ^ (((ob >> 9) & 1) << 5)); }
__host__ __device__ __forceinline__ void stage_rc(int b, int& R, int& C) { const int st = b / 1024, sb = b % 1024, swz = sb ^ (((sb >> 9) & 1) << 5); R = (st >> 1) * 16 + swz / 64; C = (st & 1) * 32 + (swz % 64) / 2; }
__host__ __device__ __forceinline__ int perm32(int rho) { const int n = rho >> 4, i = rho & 15; return 8 * (i >> 2) + 4 * n + (i & 3); }

struct Unit { int pm, pn; };
struct Gemm { const bf16_t* A; const bf16_t* Bt; int M, N, K; };

struct StaticOrder {
    int nM, nN, nwg, G, c;
    __host__ __device__ void init(int M, int N, int G_, int c_) { nM = M / BM; nN = N / BM; nwg = nM * nN; G = G_; c = c_; }
    __host__ __device__ bool next(int i, Unit& u) const {
        const long L = (long)i * G + c; if (L >= nwg) return false;
        int wgid = (int)L; { const int q = nwg / NXCD, r = nwg % NXCD, xcd = wgid % NXCD, off = wgid / NXCD; wgid = (xcd < r ? xcd * (q + 1) : r * (q + 1) + (xcd - r) * q) + off; }
        const int nig = WGM * nN, gid = wgid / nig, fm = gid * WGM, gsz = (nM - fm) < WGM ? (nM - fm) : WGM;
        u.pm = fm + ((wgid % nig) % gsz); u.pn = (wgid % nig) / gsz; return true;
    }
    __device__ __forceinline__ void a_ready(const Unit&) const {}
    __device__ __forceinline__ void done(const Unit&) const {}
};
__device__ __forceinline__ unsigned cvt_pk_bf16(float lo, float hi) { unsigned r; asm volatile("v_cvt_pk_bf16_f32 %0, %1, %2" : "=v"(r) : "v"(lo), "v"(hi)); return r; }
typedef unsigned u32x2 __attribute__((ext_vector_type(2)));
__device__ __forceinline__ float sigmoidf_(float x) { return 1.0f / (1.0f + __expf(-x)); }
__device__ __forceinline__ float bflo(unsigned w) { return __uint_as_float(w << 16); }
__device__ __forceinline__ float bfhi(unsigned w) { return __uint_as_float(w & 0xffff0000u); }

struct EpiF32 {
    static constexpr bool PERM = false, AFTER_DRAIN = false;
    float* C; int ldc;
    __device__ __forceinline__ void operator()(const f32x4 (&acc)[2][2][4][2], const Unit& u, int wr, int wc, int fr, int fq) const {
        const int row0 = u.pm * BM + wr * 64 + fr, col0 = u.pn * BM + wc * 32 + 4 * fq;
#pragma unroll
        for (int ai = 0; ai < 2; ++ai)
#pragma unroll
            for (int m = 0; m < 4; ++m) { float* rowp = C + (size_t)(row0 + ai * HALF + m * 16) * ldc + col0;
#pragma unroll
                for (int bj = 0; bj < 2; ++bj)
#pragma unroll
                    for (int n = 0; n < 2; ++n) *(f32x4*)(rowp + bj * HALF + n * 16) = acc[ai][bj][m][n]; }
    }
};
struct EpiInProj {
    static constexpr bool PERM = true, AFTER_DRAIN = false;
    bf16_t* O; int ldc; float* S; int nbf;
    __device__ __forceinline__ void operator()(const f32x4 (&acc)[2][2][4][2], const Unit& u, int wr, int wc, int fr, int fq) const {
        const int row0 = u.pm * BM + wr * 64 + fr;
        if (u.pn < nbf) {
            const int col0 = u.pn * BM + wc * 32 + 8 * fq;
#pragma unroll
            for (int ai = 0; ai < 2; ++ai)
#pragma unroll
                for (int m = 0; m < 4; ++m) { bf16_t* rowp = O + (size_t)(row0 + ai * HALF + m * 16) * ldc + col0;
#pragma unroll
                    for (int bj = 0; bj < 2; ++bj) { const f32x4 v0 = acc[ai][bj][m][0], v1 = acc[ai][bj][m][1];
                        u32x4 w; w.x = cvt_pk_bf16(v0[0], v0[1]); w.y = cvt_pk_bf16(v0[2], v0[3]); w.z = cvt_pk_bf16(v1[0], v1[1]); w.w = cvt_pk_bf16(v1[2], v1[3]);
                        *(u32x4*)(rowp + bj * HALF) = w; } }
        } else {
            const int col0 = wc * 32 + 8 * fq;
#pragma unroll
            for (int ai = 0; ai < 2; ++ai)
#pragma unroll
                for (int m = 0; m < 4; ++m) { float* rowp = S + (size_t)(row0 + ai * HALF + m * 16) * 256 + col0;
#pragma unroll
                    for (int bj = 0; bj < 2; ++bj)
#pragma unroll
                        for (int n = 0; n < 2; ++n) *(f32x4*)(rowp + bj * HALF + 4 * n) = acc[ai][bj][m][n]; }
        }
    }
};
template <int J> struct EpiBranch {
    static constexpr bool PERM = false, AFTER_DRAIN = false;
    bf16_t* T; bf16_t* MB; const bf16_t* GM; int ldg; const float* rowss; float eps;
    __device__ __forceinline__ void operator()(const f32x4 (&acc)[2][2][4][2], const Unit& u, int wr, int wc, int fr, int fq) const {
        const int row0 = u.pm * BM + wr * 64 + fr, col0 = u.pn * BM + wc * 32 + 4 * fq;
#pragma unroll
        for (int ai = 0; ai < 2; ++ai)
#pragma unroll
            for (int mp = 0; mp < 4; mp += 2) {
                u32x2 gw[2][4], tw[2][4]; float rs[2];
#pragma unroll
                for (int mm = 0; mm < 2; ++mm) { const int row = row0 + ai * HALF + (mp + mm) * 16; rs[mm] = J == 0 ? rsqrtf(rowss[row] * (1.0f / 2048.0f) + eps) : 1.0f;
#pragma unroll
                    for (int q = 0; q < 4; ++q) { const int col = col0 + (q >> 1) * HALF + (q & 1) * 16;
                        gw[mm][q] = *(const u32x2*)(GM + (size_t)row * ldg + col);
                        tw[mm][q] = J > 0 ? *(const u32x2*)(T + (size_t)row * 2048 + col) : (u32x2){0u, 0u}; } }
#pragma unroll
                for (int mm = 0; mm < 2; ++mm) { const int row = row0 + ai * HALF + (mp + mm) * 16;
#pragma unroll
                    for (int q = 0; q < 4; ++q) { const int col = col0 + (q >> 1) * HALF + (q & 1) * 16;
                        f32x4 g; g[0] = sigmoidf_(bflo(gw[mm][q].x)); g[1] = sigmoidf_(bfhi(gw[mm][q].x)); g[2] = sigmoidf_(bflo(gw[mm][q].y)); g[3] = sigmoidf_(bfhi(gw[mm][q].y));
                        f32x4 v = acc[ai][q >> 1][mp + mm][q & 1] * g * rs[mm];
                        v[0] += bflo(tw[mm][q].x); v[1] += bfhi(tw[mm][q].x); v[2] += bflo(tw[mm][q].y); v[3] += bfhi(tw[mm][q].y);
                        u32x2 w; w.x = cvt_pk_bf16(v[0], v[1]); w.y = cvt_pk_bf16(v[2], v[3]);
                        *(u32x2*)((J < 2 ? T : MB) + (size_t)row * 2048 + col) = w; } } }
    }
};
template <int GATE> struct EpiRowSS {
    static constexpr bool PERM = false, AFTER_DRAIN = false;
    float* C; const float* E; float* rowss;
    __device__ __forceinline__ void operator()(const f32x4 (&acc)[2][2][4][2], const Unit& u, int wr, int wc, int fr, int fq) const {
        const int row0 = u.pm * BM + wr * 64 + fr, col0 = u.pn * BM + wc * 32 + 4 * fq;
#pragma unroll
        for (int ai = 0; ai < 2; ++ai)
#pragma unroll
            for (int mp = 0; mp < 4; mp += 2) {
                f32x4 ev[2][4];
                if (GATE) {
#pragma unroll
                    for (int mm = 0; mm < 2; ++mm)
#pragma unroll
                        for (int q = 0; q < 4; ++q) ev[mm][q] = *(const f32x4*)(E + (size_t)(row0 + ai * HALF + (mp + mm) * 16) * 2048 + col0 + (q >> 1) * HALF + (q & 1) * 16); }
#pragma unroll
                for (int mm = 0; mm < 2; ++mm) { const int row = row0 + ai * HALF + (mp + mm) * 16; float ss = 0.f;
#pragma unroll
                    for (int q = 0; q < 4; ++q) { const int col = col0 + (q >> 1) * HALF + (q & 1) * 16; f32x4 v = acc[ai][q >> 1][mp + mm][q & 1];
                        if (GATE) { v[0] = sigmoidf_(v[0]) * ev[mm][q][0]; v[1] = sigmoidf_(v[1]) * ev[mm][q][1]; v[2] = sigmoidf_(v[2]) * ev[mm][q][2]; v[3] = sigmoidf_(v[3]) * ev[mm][q][3]; }
                        ss += (v[0] * v[0] + v[1] * v[1]) + (v[2] * v[2] + v[3] * v[3]);
                        *(f32x4*)(C + (size_t)row * 2048 + col) = v; }
                    ss += __shfl_xor(ss, 16); ss += __shfl_xor(ss, 32);
                    if (fq == 0) atomicAdd(rowss + row, ss); } }
    }
};
struct EpiCmp1 {
    static constexpr bool PERM = true, AFTER_DRAIN = false;
    bf16_t* O; const float* hb;
    __device__ __forceinline__ void operator()(const f32x4 (&acc)[2][2][4][2], const Unit& u, int wr, int wc, int fr, int fq) const {
        const int row0 = u.pm * BM + wr * 64 + fr, col0 = wc * 32 + 8 * fq;
#pragma unroll
        for (int ai = 0; ai < 2; ++ai)
#pragma unroll
            for (int m = 0; m < 4; ++m) { bf16_t* rowp = O + (size_t)(row0 + ai * HALF + m * 16) * 256 + col0;
#pragma unroll
                for (int bj = 0; bj < 2; ++bj) { f32x4 v0 = acc[ai][bj][m][0] + *(const f32x4*)(hb + col0 + bj * HALF), v1 = acc[ai][bj][m][1] + *(const f32x4*)(hb + col0 + bj * HALF + 4);
#pragma unroll
                    for (int j = 0; j < 4; ++j) { v0[j] = v0[j] * sigmoidf_(v0[j]); v1[j] = v1[j] * sigmoidf_(v1[j]); }
                    u32x4 w; w.x = cvt_pk_bf16(v0[0], v0[1]); w.y = cvt_pk_bf16(v0[2], v0[3]); w.z = cvt_pk_bf16(v1[0], v1[1]); w.w = cvt_pk_bf16(v1[2], v1[3]);
                    *(u32x4*)(rowp + bj * HALF) = w; } }
    }
};
struct EpiCmp2 {
    static constexpr bool PERM = true, AFTER_DRAIN = false;
    bf16_t* O;
    __device__ __forceinline__ void operator()(const f32x4 (&acc)[2][2][4][2], const Unit& u, int wr, int wc, int fr, int fq) const {
        const int row0 = u.pm * BM + wr * 64 + fr, col0 = wc * 32 + 8 * fq;
#pragma unroll
        for (int ai = 0; ai < 2; ++ai)
#pragma unroll
            for (int m = 0; m < 4; ++m) { bf16_t* rowp = O + (size_t)(row0 + ai * HALF + m * 16) * 128 + col0;
                const f32x4 v0 = acc[ai][0][m][0], v1 = acc[ai][0][m][1];
                u32x4 w; w.x = cvt_pk_bf16(v0[0], v0[1]); w.y = cvt_pk_bf16(v0[2], v0[3]); w.z = cvt_pk_bf16(v1[0], v1[1]); w.w = cvt_pk_bf16(v1[2], v1[3]);
                *(u32x4*)rowp = w; }
    }
};
template <class Epi, class Sched, bool ALIGN_EPI = false, bool SP2 = false>
__device__ __forceinline__ void gemm_phase(PG8_LAS unsigned char* lds, const Gemm g, const Sched& S, const Epi& E, int wave_in) {
    int tid_ = wave_in * 64 + (int)__builtin_amdgcn_mbcnt_hi(~0u, __builtin_amdgcn_mbcnt_lo(~0u, 0u)); asm volatile("" : "+v"(tid_));
    const int tid = tid_, wid = __builtin_amdgcn_readfirstlane(tid >> 6), lane = tid & 63, wr = wid >> 2, wc = wid & 3, fr = lane & 15, fq = lane >> 4;
    const int K = g.K, nt = K / BK;
    unsigned voffA[2], voffB[2];
#pragma unroll
    for (int i = 0; i < 2; ++i) { int R, C; stage_rc(tid * 16 + i * 8192, R, C); const int Rb = Epi::PERM ? ((R & ~31) + perm32(R & 31)) : R;
        voffA[i] = (unsigned)(R * K + C) * 2u; voffB[i] = (unsigned)(Rb * K + C) * 2u; }
    const size_t kstep = (size_t)(BK * 2);
    const size_t hstep = (size_t)HALF * K * 2;
    const size_t tstep = 2 * hstep;
    const unsigned ldsw = (unsigned)wid * 1024u;
    const int aoff = lds_byte(wr * 64 + fr, fq * 8), boff = lds_byte(wc * 32 + fr, fq * 8);
#define PG8_SA(b, h) (((b) * 2 + (h)) * HTB)
#define PG8_SB(b, h) ((4 + (b) * 2 + (h)) * HTB)
#define PG8_STAGE(bufoff, gbase, voff) do { _Pragma("unroll") for (int _i = 0; _i < 2; ++_i) \
        __builtin_amdgcn_global_load_lds((const unsigned*)((const char*)(gbase) + (voff)[_i]), (PG8_LAS unsigned*)(lds + (bufoff) + ldsw + _i * 8192), 16, 0, 0); } while (0)
#define PG8_LDA(dst, b, h) do { _Pragma("unroll") for (int m = 0; m < 4; ++m) _Pragma("unroll") for (int k = 0; k < 2; ++k) dst[m][k] = *(const PG8_LAS bf16x8*)(lds + PG8_SA(b, h) + aoff + m * 2048 + k * 1024); } while (0)
#define PG8_LDB(dst, b, h) do { _Pragma("unroll") for (int n = 0; n < 2; ++n) _Pragma("unroll") for (int k = 0; k < 2; ++k) dst[n][k] = *(const PG8_LAS bf16x8*)(lds + PG8_SB(b, h) + boff + n * 2048 + k * 1024); } while (0)
#define PG8_MMA(ai, bj, At, Bt) do { __builtin_amdgcn_s_setprio(1); _Pragma("unroll") for (int m = 0; m < 4; ++m) _Pragma("unroll") for (int n = 0; n < 2; ++n) _Pragma("unroll") for (int k = 0; k < 2; ++k) \
        acc[ai][bj][m][n] = __builtin_amdgcn_mfma_f32_16x16x32_bf16(Bt[n][k], At[m][k], acc[ai][bj][m][n], 0, 0, 0); __builtin_amdgcn_s_setprio(0); } while (0)
#define PG8_WAIT_V(n) asm volatile("s_waitcnt vmcnt(" #n ")" ::: "memory")
#define PG8_WAIT_L(n) asm volatile("s_waitcnt lgkmcnt(" #n ")" ::: "memory")
#define PG8_BAR __builtin_amdgcn_s_barrier()
#define PG8_SCHED __builtin_amdgcn_sched_barrier(0)
    Unit cur, nxt; int ui = 0;
    if (!S.next(0, cur)) return;
    f32x4 acc[2][2][4][2];
#pragma unroll
    for (int a = 0; a < 2; ++a)
#pragma unroll
        for (int b = 0; b < 2; ++b)
#pragma unroll
            for (int m = 0; m < 4; ++m)
#pragma unroll
                for (int n = 0; n < 2; ++n) acc[a][b][m][n] = (f32x4){0.f, 0.f, 0.f, 0.f};
    bf16x8 At[4][2], B0[2][2], B1[2][2];
    const char* cA = (const char*)g.A + (size_t)cur.pm * tstep; const char* cB = (const char*)g.Bt + (size_t)cur.pn * tstep;
    S.a_ready(cur);
    if constexpr (SP2) {
        PG8_STAGE(PG8_SB(0, 0), cB, voffB); PG8_STAGE(PG8_SB(0, 1), cB + hstep, voffB); PG8_STAGE(PG8_SA(0, 0), cA, voffA); PG8_STAGE(PG8_SA(0, 1), cA + hstep, voffA);
        if (wr == 1) PG8_BAR;
        PG8_WAIT_V(2); PG8_BAR;
        PG8_STAGE(PG8_SB(1, 0), cB + kstep, voffB); PG8_STAGE(PG8_SA(1, 0), cA + kstep, voffA); PG8_STAGE(PG8_SB(1, 1), cB + hstep + kstep, voffB);
        PG8_WAIT_V(6); PG8_BAR;
    } else {
        PG8_STAGE(PG8_SB(0, 0), cB, voffB); PG8_STAGE(PG8_SA(0, 0), cA, voffA); PG8_STAGE(PG8_SB(0, 1), cB + hstep, voffB); PG8_STAGE(PG8_SA(0, 1), cA + hstep, voffA);
        if (wr == 1) PG8_BAR;
        PG8_WAIT_V(4); PG8_BAR;
        PG8_STAGE(PG8_SB(1, 0), cB + kstep, voffB); PG8_STAGE(PG8_SA(1, 0), cA + kstep, voffA); PG8_STAGE(PG8_SB(1, 1), cB + hstep + kstep, voffB);
        PG8_WAIT_V(6); PG8_BAR;
    }
    for (;;) {
        const bool has_next = S.next(ui + 1, nxt);
        const char* nA = has_next ? (const char*)g.A + (size_t)nxt.pm * tstep : cA; const char* nB = has_next ? (const char*)g.Bt + (size_t)nxt.pn * tstep : cB;
        for (int t = 0; t < nt; t += 2) {
            const bool last = (t == nt - 2);
            const char* a1 = cA + (size_t)(t + 1) * kstep;
            const char* a2 = last ? nA : cA + (size_t)(t + 2) * kstep; const char* b2 = last ? nB : cB + (size_t)(t + 2) * kstep;
            const char* a3 = a2 + kstep; const char* b3 = b2 + kstep;
            if (last && has_next) S.a_ready(nxt);
            if constexpr (SP2) {
            PG8_LDB(B0, 0, 0); PG8_LDB(B1, 0, 1); PG8_SCHED; PG8_LDA(At, 0, 0); PG8_STAGE(PG8_SA(1, 1), a1 + hstep, voffA);
            PG8_WAIT_V(8); PG8_WAIT_L(0); PG8_BAR; PG8_MMA(0, 0, At, B0); PG8_MMA(0, 1, At, B1); PG8_BAR; PG8_SCHED;
            PG8_LDA(At, 0, 1); PG8_STAGE(PG8_SB(0, 0), b2, voffB); PG8_STAGE(PG8_SB(0, 1), b2 + hstep, voffB); PG8_STAGE(PG8_SA(0, 0), a2, voffA);
            PG8_WAIT_V(8); PG8_WAIT_L(0); PG8_BAR; PG8_MMA(1, 0, At, B0); PG8_MMA(1, 1, At, B1); PG8_BAR; PG8_SCHED;
            PG8_LDB(B0, 1, 0); PG8_LDB(B1, 1, 1); PG8_SCHED; PG8_LDA(At, 1, 0); PG8_STAGE(PG8_SA(0, 1), a2 + hstep, voffA);
            PG8_WAIT_V(8); PG8_WAIT_L(0); PG8_BAR; PG8_MMA(0, 0, At, B0); PG8_MMA(0, 1, At, B1); PG8_BAR; PG8_SCHED;
            PG8_LDA(At, 1, 1); PG8_STAGE(PG8_SB(1, 0), b3, voffB); PG8_STAGE(PG8_SB(1, 1), b3 + hstep, voffB); PG8_STAGE(PG8_SA(1, 0), a3, voffA);
            PG8_WAIT_V(8); PG8_WAIT_L(0); PG8_BAR; PG8_MMA(1, 0, At, B0); PG8_MMA(1, 1, At, B1); PG8_BAR; PG8_SCHED;
            } else {
            PG8_LDB(B0, 0, 0); PG8_SCHED; PG8_LDA(At, 0, 0); PG8_STAGE(PG8_SA(1, 1), a1 + hstep, voffA);
            PG8_WAIT_L(8); PG8_BAR; PG8_WAIT_L(0); PG8_MMA(0, 0, At, B0); PG8_BAR; PG8_SCHED;
            PG8_LDB(B1, 0, 1); PG8_STAGE(PG8_SB(0, 0), b2, voffB);
            PG8_BAR; PG8_WAIT_L(0); PG8_MMA(0, 1, At, B1); PG8_BAR;
            PG8_LDA(At, 0, 1); PG8_STAGE(PG8_SA(0, 0), a2, voffA);
            PG8_BAR; PG8_WAIT_L(0); PG8_MMA(1, 0, At, B0); PG8_BAR; PG8_SCHED;
            PG8_STAGE(PG8_SB(0, 1), b2 + hstep, voffB);
            PG8_WAIT_V(6); PG8_BAR; PG8_MMA(1, 1, At, B1); PG8_BAR;
            PG8_LDB(B0, 1, 0); PG8_SCHED; PG8_LDA(At, 1, 0); PG8_STAGE(PG8_SA(0, 1), a2 + hstep, voffA);
            PG8_WAIT_L(8); PG8_BAR; PG8_WAIT_L(0); PG8_MMA(0, 0, At, B0); PG8_BAR; PG8_SCHED;
            PG8_LDB(B1, 1, 1); PG8_STAGE(PG8_SB(1, 0), b3, voffB);
            PG8_BAR; PG8_WAIT_L(0); PG8_MMA(0, 1, At, B1); PG8_BAR;
            PG8_LDA(At, 1, 1); PG8_STAGE(PG8_SA(1, 0), a3, voffA);
            PG8_BAR; PG8_WAIT_L(0); PG8_MMA(1, 0, At, B0); PG8_BAR; PG8_SCHED;
            PG8_STAGE(PG8_SB(1, 1), b3 + hstep, voffB);
            PG8_WAIT_V(6); PG8_BAR; PG8_MMA(1, 1, At, B1); PG8_BAR;
            }
        }
        if constexpr (ALIGN_EPI) { if (wr == 0) PG8_BAR; }
        if constexpr (!Epi::AFTER_DRAIN) { E(acc, cur, wr, wc, fr, fq); S.done(cur); }
        if (!has_next) break;
#pragma unroll
        for (int a = 0; a < 2; ++a)
#pragma unroll
            for (int b = 0; b < 2; ++b)
#pragma unroll
                for (int m = 0; m < 4; ++m)
#pragma unroll
                    for (int n = 0; n < 2; ++n) acc[a][b][m][n] = (f32x4){0.f, 0.f, 0.f, 0.f};
        cur = nxt; cA = nA; cB = nB; ++ui;
        if constexpr (ALIGN_EPI) { if (wr == 1) PG8_BAR; }
    }
    PG8_WAIT_V(0);
    if constexpr (!ALIGN_EPI) { if (wr == 0) PG8_BAR; }
    PG8_BAR;
    if constexpr (Epi::AFTER_DRAIN) { E.fused(acc, cur, wr, wc, fr, fq, lds, wid, lane); S.done(cur); }
#undef PG8_SA
#undef PG8_SB
#undef PG8_STAGE
#undef PG8_LDA
#undef PG8_LDB
#undef PG8_MMA
#undef PG8_WAIT_V
#undef PG8_WAIT_L
#undef PG8_BAR
#undef PG8_SCHED
}
}

constexpr int L_SEQ = 8192, DM = 2048, NLAYER = 2, PDIM = 256;
constexpr int IN_DIM = 27728;
constexpr int NPROJ = 27648;
constexpr int NPAD = 27904;
constexpr int C_XA = 0, C_ZA = 2048, C_BA = 4096, C_CA = 5120, C_QB = 6144, C_KCB = 8192, C_VCB = 8704, C_KSB = 9216, C_VSB = 9728, C_KWB = 10240, C_VWB = 10752,
              C_ZB = 11264, C_QC = 13312, C_KC = 15360, C_VC = 17408, C_ZC = 19456, C_GM = 21504;
constexpr int S_XA = 0, S_DTA = 6144, S_QB = 6176, S_GB = 11296, S_ZB = 11344;
constexpr float EPS = 1e-6f;
constexpr int NCMP = 511;

constexpr size_t MiB = 1u << 20;
constexpr size_t WS_CTL = 0, CTL_ZERO_BYTES = 1 * MiB;
constexpr size_t ROWSS_OFF = 512 * 1024;
constexpr size_t SZ_WIN = (size_t)NPAD * DM * 2;
constexpr size_t WS_WIN = 1 * MiB;
constexpr size_t WS_WBR = WS_WIN + 2 * SZ_WIN;
constexpr size_t WS_WOUT = WS_WBR + 6 * 8 * MiB;
constexpr size_t WS_WGATE = WS_WOUT + 2 * 8 * MiB;
constexpr size_t WS_WPP = WS_WGATE + 2 * 8 * MiB;
constexpr size_t WS_WC1 = WS_WPP + 2 * MiB;
constexpr size_t WS_WC2 = WS_WC1 + 8 * MiB;
constexpr size_t WS_HB = WS_WC2 + 512 * 1024;
constexpr size_t WS_PBF = WS_HB + 512 * 1024;
constexpr size_t WS_HBF = WS_PBF + 8 * MiB;
constexpr size_t WS_PROJ = WS_HBF + 32 * MiB;
constexpr size_t WS_SMALL = WS_PROJ + (size_t)L_SEQ * NPROJ * 2;
constexpr size_t WS_EBUF = WS_SMALL + 8 * MiB;
constexpr size_t WS_AIM = WS_EBUF + 64 * MiB;
constexpr size_t WS_HID = WS_AIM + 32 * MiB;
constexpr size_t WS_KVC = WS_HID + 2 * MiB;
constexpr size_t WS_ACS = WS_KVC + 1 * MiB;
constexpr size_t WS_DTV = WS_ACS + 1 * MiB;
constexpr size_t WS_CD = WS_DTV + 1 * MiB;
constexpr size_t WS_ST = WS_CD + 1 * MiB;
constexpr size_t WS_KVT = WS_ST + 64 * MiB;
constexpr size_t WS_YA = WS_KVT + 128 * MiB;
constexpr size_t WS_YB = WS_YA + 32 * MiB;
constexpr size_t WS_YC = WS_YB + 32 * MiB;
constexpr size_t WS_TF = WS_YC + 32 * MiB;
constexpr size_t WS_MB = WS_TF + 64 * MiB;
constexpr size_t WS_X1 = WS_MB + 32 * MiB;
constexpr size_t WS_XL = WS_X1 + 64 * MiB;
constexpr size_t WS_ROT = WS_XL + 64 * MiB;
constexpr size_t WS_HBP = WS_ROT + 8 * MiB;
constexpr size_t WS_END = WS_HBP + 1 * MiB;

constexpr int CW_BAR = 4096;

constexpr int LDS_BYTES = 155648;
constexpr int MISC_OFF = 154624;

#define GAS __attribute__((address_space(1)))
#define LAS __attribute__((address_space(3)))
typedef unsigned short bf16;
typedef short bf16x8 __attribute__((ext_vector_type(8)));
typedef float f32x4 __attribute__((ext_vector_type(4)));
typedef unsigned u32x4 __attribute__((ext_vector_type(4)));
typedef unsigned u32x2 __attribute__((ext_vector_type(2)));

__device__ __forceinline__ unsigned f2bf(float f) { unsigned u = __builtin_bit_cast(unsigned, f); return (u + 0x7fffu + ((u >> 16) & 1u)) >> 16; }
__device__ __forceinline__ unsigned pk2(float lo, float hi) { return f2bf(lo) | (f2bf(hi) << 16); }
__device__ __forceinline__ float bf2f(unsigned short b) { return __uint_as_float(((unsigned)b) << 16); }
__device__ __forceinline__ float blo(unsigned w) { return __uint_as_float(w << 16); }
__device__ __forceinline__ float bhi(unsigned w) { return __uint_as_float(w & 0xffff0000u); }
__device__ __forceinline__ float sigm(float x) { return 1.0f / (1.0f + __expf(-x)); }
__device__ __forceinline__ float siluf(float x) { return x * sigm(x); }
__device__ __forceinline__ float wave_sum(float v) {
#pragma unroll
    for (int o = 1; o < 64; o <<= 1) v += __shfl_xor(v, o);
    return v;
}
__device__ __forceinline__ int fresh(int x) { asm volatile("" : "+v"(x)); return x; }
__device__ __forceinline__ int fresh_s(int x) { asm volatile("" : "+s"(x)); return x; }
#define LDS_WAIT() asm volatile("s_waitcnt lgkmcnt(0)" ::: "memory")

#define XB_TMO      128
#define XB_XCNT(j)  (256  + 64 * (j))
#define XB_XSUB(j)  (1280 + 64 * (j))
#define XB_XGEN(j)  (2304 + 64 * (j))
#define XB_TOP      3328
#define XB_TOPGEN   3392
#define XCD_BAR_WORDS 3456
#define XB_SPIN_CAP (1u << 18)
__device__ __forceinline__ unsigned xb_ld(unsigned* p)              { return __hip_atomic_load(p, __ATOMIC_RELAXED, __HIP_MEMORY_SCOPE_AGENT); }
__device__ __forceinline__ unsigned xb_add(unsigned* p, unsigned v) { return __hip_atomic_fetch_add(p, v, __ATOMIC_RELAXED, __HIP_MEMORY_SCOPE_AGENT); }
__device__ __forceinline__ unsigned xb_xcc_id() { return (unsigned)__builtin_amdgcn_s_getreg((3 << 11) | 20) & 0xFu; }
#define XB_SPIN(cond, bar) do { unsigned _sp = 0; while (cond) { __builtin_amdgcn_s_sleep(1); \
    if ((++_sp & 255u) == 0u) { if (xb_ld(&(bar)[XB_TMO])) break; if (_sp > XB_SPIN_CAP) { atomicAdd(&(bar)[XB_TMO], 1u); break; } } } } while (0)
struct XcdBarrier { unsigned* bar; unsigned x; volatile LAS unsigned* st; };
__device__ __forceinline__ XcdBarrier xcd_barrier_post(unsigned* bar, volatile LAS unsigned* st) {
    XcdBarrier b; b.bar = bar; b.x = xb_xcc_id(); b.st = st;
    if (threadIdx.x == 0) (void)xb_add(&bar[XB_XCNT(b.x)], 1u);
    return b;
}
__device__ __forceinline__ void xcd_barrier_complete(unsigned* bar, unsigned x, unsigned& nloc, unsigned& nx) {
    const unsigned G = gridDim.x * gridDim.y * gridDim.z;
    unsigned sum, cnt, mine, sp = 0u;
    for (;;) {
        sum = 0u; cnt = 0u; mine = 0u;
#pragma unroll
        for (unsigned j = 0; j < 16; ++j) { const unsigned c = xb_ld(&bar[XB_XCNT(j)]); sum += c; cnt += (c > 0u) ? 1u : 0u; mine = (j == x) ? c : mine; }
        if (sum == G) break;
        __builtin_amdgcn_s_sleep(1);
        if ((++sp & 255u) == 0u) { if (xb_ld(&bar[XB_TMO])) break; if (sp > XB_SPIN_CAP) { atomicAdd(&bar[XB_TMO], 1u); break; } }
    }
    nloc = mine > 0u ? mine : 1u; nx = cnt > 0u ? cnt : 1u;
}
__device__ __forceinline__ void xcd_barrier(const XcdBarrier& b) {
    asm volatile("s_waitcnt vmcnt(0)" ::: "memory");
    __syncthreads();
    if (threadIdx.x == 0) {
        unsigned* bar = b.bar;
        __builtin_amdgcn_s_waitcnt(0);
        unsigned nloc = b.st[0], nx = b.st[1];
        if (nloc == 0u) { xcd_barrier_complete(bar, b.x, nloc, nx); b.st[0] = nloc; b.st[1] = nx; }
        const unsigned old = xb_add(&bar[XB_XSUB(b.x)], 1u);
        const unsigned gen = old / nloc;
        if (old + 1u == (gen + 1u) * nloc) {
            __builtin_amdgcn_fence(__ATOMIC_RELEASE, "agent");
            asm volatile("s_waitcnt vmcnt(0)" ::: "memory");
            const unsigned og = xb_add(&bar[XB_TOP], 1u);
            const unsigned tg = og / nx;
            if (og + 1u == (tg + 1u) * nx) xb_add(&bar[XB_TOPGEN], 1u);
            else XB_SPIN(xb_ld(&bar[XB_TOPGEN]) == tg, bar);
            __builtin_amdgcn_fence(__ATOMIC_ACQUIRE, "agent");
            xb_add(&bar[XB_XGEN(b.x)], 1u);
            asm volatile("s_waitcnt vmcnt(0)" ::: "memory");
        } else {
            XB_SPIN(xb_ld(&bar[XB_XGEN(b.x)]) == gen, bar);
            __builtin_amdgcn_fence(__ATOMIC_ACQUIRE, "agent");
            asm volatile("s_waitcnt vmcnt(0)" ::: "memory");
        }
    }
    __syncthreads();
}

struct Args { const float* in[20]; float* out; unsigned char* ws; int ph_lo, ph_hi, use_bar, pad; };
typedef const __attribute__((address_space(4))) Args* ArgsP;
__device__ __forceinline__ ArgsP argp() { ArgsP p = (ArgsP)__builtin_amdgcn_kernarg_segment_ptr(); asm volatile("" : "+s"(p)); return p; }

__device__ __forceinline__ f32x4 mma16(bf16x8 x, bf16x8 y, f32x4 c) { return __builtin_amdgcn_mfma_f32_16x16x32_bf16(x, y, c, 0, 0, 0); }
__device__ __forceinline__ bf16x8 ldfrag(const LAS bf16* base, int stride, int row, int k) { return *(const LAS bf16x8*)(base + row * stride + k); }

struct TItem { const float* W; bf16* WT; int ldw, K, k0, src0, src1, ndst0; };
__device__ __forceinline__ void titem_load(const TItem& T, f32x4 (&v)[16], int lane) {
    const int col = (lane & 15) * 4, src = (col >> 5) ? T.src1 : T.src0;
#pragma unroll
    for (int i = 0; i < 16; ++i) { const int kk = 4 * i + (lane >> 4); v[i] = src >= 0 ? __builtin_nontemporal_load((const f32x4*)(T.W + (size_t)(T.k0 + kk) * T.ldw + src + (col & 31))) : (f32x4){0.f, 0.f, 0.f, 0.f}; }
}
__device__ __forceinline__ void titem_finish(const TItem& T, const f32x4 (&v)[16], LAS float* scr, int lane) {
    const int col = (lane & 15) * 4;
#pragma unroll
    for (int i = 0; i < 16; ++i) { const int kk = 4 * i + (lane >> 4); LAS float* d = scr + kk * 65 + col; d[0] = v[i][0]; d[1] = v[i][1]; d[2] = v[i][2]; d[3] = v[i][3]; }
    LDS_WAIT(); asm volatile("" ::: "memory");
    const int c = lane & 7;
#pragma unroll
    for (int j = 0; j < 8; ++j) { const int n = (lane >> 3) + 8 * j; const LAS float* s = scr + (8 * c) * 65 + n;
        u32x4 o; o.x = pk2(s[0 * 65], s[1 * 65]); o.y = pk2(s[2 * 65], s[3 * 65]); o.z = pk2(s[4 * 65], s[5 * 65]); o.w = pk2(s[6 * 65], s[7 * 65]);
        *(u32x4*)(T.WT + (size_t)(T.ndst0 + n) * T.K + T.k0 + 8 * c) = o; }
    LDS_WAIT(); asm volatile("" ::: "memory");
}
__device__ __forceinline__ TItem titem_plain(const float* W, int K, int N, int Npad, bf16* WT, int item) {
    const int nblk = Npad / 64, kb = item / nblk, nb = item % nblk, n0 = 64 * nb;
    TItem T; T.W = W; T.WT = WT; T.ldw = N; T.K = K; T.k0 = 64 * kb; T.src0 = n0 < N ? n0 : -1; T.src1 = n0 + 32 < N ? n0 + 32 : -1; T.ndst0 = n0; return T;
}
__device__ __forceinline__ int win_src(int n0) {
    if (n0 < 6144) return n0; if (n0 < 11264) return n0 + 32; if (n0 < 27648) return n0 + 80; if (n0 < 27680) return S_DTA; if (n0 < 27744) return S_GB + (n0 - 27680); return -1;
}
__device__ __forceinline__ TItem titem_win(const float* W, bf16* WT, int item) {
    constexpr int nblk = NPAD / 64;
    const int kb = item / nblk, nb = item % nblk, n0 = 64 * nb;
    TItem T; T.W = W; T.WT = WT; T.ldw = IN_DIM; T.K = DM; T.k0 = 64 * kb; T.src0 = win_src(n0); T.src1 = win_src(n0 + 32); T.ndst0 = n0; return T;
}
__device__ __forceinline__ void rms_row_to_bf16(const float* xrow, const float* gain, bf16* orow, int lane) {
    f32x4 v[8]; float s = 0.f;
#pragma unroll
    for (int j = 0; j < 8; ++j) { v[j] = *(const f32x4*)(xrow + 4 * lane + 256 * j); s += (v[j][0] * v[j][0] + v[j][1] * v[j][1]) + (v[j][2] * v[j][2] + v[j][3] * v[j][3]); }
    const float rs = rsqrtf(wave_sum(s) * (1.0f / 2048.0f) + EPS);
#pragma unroll
    for (int j = 0; j < 8; ++j) { f32x4 g = {1.f, 1.f, 1.f, 1.f}; if (gain) g = *(const f32x4*)(gain + 4 * lane + 256 * j);
        u32x2 w; w.x = pk2(v[j][0] * rs * g[0], v[j][1] * rs * g[1]); w.y = pk2(v[j][2] * rs * g[2], v[j][3] * rs * g[3]);
        *(u32x2*)(orow + 4 * lane + 256 * j) = w; }
}

__device__ __forceinline__ TItem prologue_item(ArgsP A, unsigned char* ws, int it) {
    constexpr int I_WIN = (DM / 64) * (NPAD / 64), I_SQ = (DM / 64) * (DM / 64), I_PP = (PDIM / 64) * (DM / 64), I_C1 = (4096 / 64) * (256 / 64), I_C2 = (256 / 64) * (256 / 64);
    constexpr int PER_LAYER = I_WIN + 3 * I_SQ + I_SQ + I_SQ + I_PP + 2 * I_C1 + 2 * I_C2;
    const int l = it / PER_LAYER; int r = it % PER_LAYER;
    if (r < I_WIN) return titem_win(A->in[4] + (size_t)l * DM * IN_DIM, (bf16*)(ws + WS_WIN + (size_t)l * SZ_WIN), r); r -= I_WIN;
    if (r < 3 * I_SQ) { const int j = r / I_SQ; return titem_plain(A->in[15] + (size_t)(l * 3 + j) * DM * DM, DM, DM, DM, (bf16*)(ws + WS_WBR + (size_t)(l * 3 + j) * 8 * MiB), r % I_SQ); } r -= 3 * I_SQ;
    if (r < I_SQ) return titem_plain(A->in[16] + (size_t)l * DM * DM, DM, DM, DM, (bf16*)(ws + WS_WOUT + (size_t)l * 8 * MiB), r); r -= I_SQ;
    if (r < I_SQ) return titem_plain(A->in[18] + (size_t)l * DM * DM, DM, DM, DM, (bf16*)(ws + WS_WGATE + (size_t)l * 8 * MiB), r); r -= I_SQ;
    if (r < I_PP) return titem_plain(A->in[17] + (size_t)l * PDIM * DM, PDIM, DM, DM, (bf16*)(ws + WS_WPP + (size_t)l * 1 * MiB), r); r -= I_PP;
    if (r < 2 * I_C1) { const int s = r / I_C1; return titem_plain(A->in[12] + (size_t)(l * 2 + s) * 4096 * 256, 4096, 256, 256, (bf16*)(ws + WS_WC1 + (size_t)(l * 2 + s) * 2 * MiB), r % I_C1); } r -= 2 * I_C1;
    { const int s = r / I_C2; return titem_plain(A->in[13] + (size_t)(l * 2 + s) * 256 * 128, 256, 128, 256, (bf16*)(ws + WS_WC2 + (size_t)(l * 2 + s) * 131072), r % I_C2); }
}

__device__ __forceinline__ void phase_prologue(ArgsP A, LAS unsigned char* lds, int tid, int lane, int wave, int G, int bid) {
    unsigned char* ws = A->ws;
    LAS float* scr = (LAS float*)(lds + wave * 17408);
    const int gw = bid * 8 + wave, NGW = G * 8;
    constexpr int I_WIN = (DM / 64) * (NPAD / 64);
    constexpr int I_SQ = (DM / 64) * (DM / 64);
    constexpr int I_PP = (PDIM / 64) * (DM / 64);
    constexpr int I_C1 = (4096 / 64) * (256 / 64);
    constexpr int I_C2 = (256 / 64) * (256 / 64);
    constexpr int PER_LAYER = I_WIN + 3 * I_SQ + I_SQ + I_SQ + I_PP + 2 * I_C1 + 2 * I_C2;
    {
        f32x4 va[16], vb[16]; TItem Ta, Tb; Ta.W = nullptr; Tb.W = nullptr;
        int it = gw;
        if (it < NLAYER * PER_LAYER) { Ta = prologue_item(A, ws, it); titem_load(Ta, va, lane); }
        while (it < NLAYER * PER_LAYER) {
            const int itb = it + NGW; const bool hb_ = itb < NLAYER * PER_LAYER;
            if (hb_) { Tb = prologue_item(A, ws, itb); titem_load(Tb, vb, lane); }
            titem_finish(Ta, va, scr, lane);
            const int ita = itb + NGW; const bool ha_ = ita < NLAYER * PER_LAYER;
            if (ha_) { Ta = prologue_item(A, ws, ita); titem_load(Ta, va, lane); }
            if (hb_) titem_finish(Tb, vb, scr, lane);
            it = ita;
        }
    }
    __syncthreads();
    for (int task = bid; task < 256; task += G) {
        const int ls = task >> 6, ck = task & 63, j = tid & 255, hf = tid >> 8;
        const float* pe = A->in[11] + (size_t)ls * 4096 + ck * 64 + hf * 32; const float* w1 = A->in[12] + ((size_t)ls * 4096 + ck * 64 + hf * 32) * 256 + j;
        float s = 0.f;
#pragma unroll 8
        for (int i = 0; i < 32; ++i) s += pe[i] * w1[(size_t)i * 256];
        LAS float* red = (LAS float*)lds;
        red[tid] = s; __syncthreads();
        if (tid < 256) ((float*)(ws + WS_HBP))[(size_t)task * 256 + tid] = red[tid] + red[tid + 256];
        __syncthreads();
    }
    { float* rot = (float*)(ws + WS_ROT); const LAS float* invt = (const LAS float*)(lds + MISC_OFF + 512);
      for (int i = bid * 512 + tid; i < L_SEQ * 128; i += G * 512) { float sn, cs; sincosf((float)(i >> 7) * invt[i & 127], &sn, &cs); rot[2 * i] = cs; rot[2 * i + 1] = sn; } }
    { const size_t n4 = (size_t)NLAYER * L_SEQ * PDIM / 4; const f32x4* src = (const f32x4*)A->in[1]; u32x2* dst = (u32x2*)(ws + WS_PBF);
      for (size_t i = (size_t)bid * 512 + tid; i < n4; i += (size_t)G * 512) { const f32x4 v = src[i]; u32x2 w; w.x = pk2(v[0], v[1]); w.y = pk2(v[2], v[3]); dst[i] = w; } }
    for (int m = gw; m < L_SEQ; m += NGW) rms_row_to_bf16(A->in[0] + (size_t)m * DM, A->in[2], (bf16*)(ws + WS_HBF) + (size_t)m * DM, lane);
}

struct LayerP {
    const float *conv_w, *conv_b, *dt_bias, *a_log, *d_skip, *ssm_norm, *ret_norm;
};
__device__ __forceinline__ void conv8(const bf16* proj, int t, int col0, const float* cw, const float* cb, int cch0, float (&out)[8]) {
    u32x4 v[4]; f32x4 w0[4], w1[4];
#pragma unroll
    for (int k = 0; k < 4; ++k) { const int tt = t - 3 + k, tc = tt < 0 ? 0 : tt; v[k] = *(const u32x4*)(proj + (size_t)tc * NPROJ + col0);
        w0[k] = *(const f32x4*)(cw + k * 4096 + cch0); w1[k] = *(const f32x4*)(cw + k * 4096 + cch0 + 4); }
    const f32x4 b0 = *(const f32x4*)(cb + cch0), b1 = *(const f32x4*)(cb + cch0 + 4);
    float acc[8] = {b0[0], b0[1], b0[2], b0[3], b1[0], b1[1], b1[2], b1[3]};
#pragma unroll
    for (int k = 0; k < 4; ++k) { const float ok = (t - 3 + k) < 0 ? 0.f : 1.f; const f32x4 a0 = w0[k] * ok, a1 = w1[k] * ok;
        acc[0] += a0[0] * blo(v[k].x); acc[1] += a0[1] * bhi(v[k].x); acc[2] += a0[2] * blo(v[k].y); acc[3] += a0[3] * bhi(v[k].y);
        acc[4] += a1[0] * blo(v[k].z); acc[5] += a1[1] * bhi(v[k].z); acc[6] += a1[2] * blo(v[k].w); acc[7] += a1[3] * bhi(v[k].w); }
#pragma unroll
    for (int i = 0; i < 8; ++i) out[i] = siluf(acc[i]);
}

constexpr int SA_XT = 0, SA_BT = 69632, SA_ACS = 104448, SA_DTV = 106496;
__device__ __forceinline__ void ssd_states_unit(ArgsP A, const LayerP& P, LAS unsigned char* lds, int c, int g, int tid, int lane, int wave) {
    tid = fresh(tid); lane = fresh(lane); wave = fresh_s(wave);
    unsigned char* ws = A->ws;
    const bf16* proj = (const bf16*)(ws + WS_PROJ); const float* small = (const float*)(ws + WS_SMALL);
    LAS bf16* XT = (LAS bf16*)(lds + SA_XT); LAS bf16* BT = (LAS bf16*)(lds + SA_BT);
    LAS float* acs = (LAS float*)(lds + SA_ACS); LAS float* dtv = (LAS float*)(lds + SA_DTV);
    const int t0 = c * 128;
    { const int l = tid >> 2, hh = tid & 3, h = g * 4 + hh, t = t0 + l;
      const float raw = small[(size_t)t * 256 + h] + P.dt_bias[h];
      const float dt = raw > 20.f ? raw : log1pf(expf(raw));
      const float a = -expf(P.a_log[h]) * dt;
      dtv[l * 4 + hh] = dt; acs[l * 4 + hh] = a;
      ((float*)(ws + WS_DTV))[(size_t)t * 32 + h] = dt; }
    __syncthreads();
    if (wave < 4) {
        const int hh = wave; const float v0 = acs[(2 * lane) * 4 + hh], v1 = acs[(2 * lane + 1) * 4 + hh]; float s = v0 + v1;
#pragma unroll
        for (int d = 1; d < 64; d <<= 1) { const float t = __shfl_up(s, d); if (lane >= d) s += t; }
        const float ex = s - (v0 + v1);
        acs[(2 * lane) * 4 + hh] = ex + v0; acs[(2 * lane + 1) * 4 + hh] = ex + v0 + v1;
    }
    __syncthreads();
    { const int l = tid >> 2, hh = tid & 3; ((float*)(ws + WS_ACS))[(size_t)(t0 + l) * 32 + g * 4 + hh] = acs[l * 4 + hh];
      if (tid < 4) ((float*)(ws + WS_CD))[c * 32 + g * 4 + tid] = __expf(acs[127 * 4 + tid]); }
#pragma unroll 1
    for (int item = fresh(tid); item < 48 * 128; item += 512) {
        const int l = item & 127, v = item >> 7, t = t0 + l; float o[8];
        if (v < 32) { const int hh = v >> 3, ch = g * 256 + v * 8;
            conv8(proj, t, C_XA + ch, P.conv_w, P.conv_b, ch, o);
            const float sc = dtv[l * 4 + hh] * __expf(acs[127 * 4 + hh] - acs[l * 4 + hh]);
#pragma unroll
            for (int i = 0; i < 8; ++i) XT[(v * 8 + i) * 136 + l] = (bf16)f2bf(o[i] * sc);
        } else { const int n0 = (v - 32) * 8, ch = g * 128 + n0;
            conv8(proj, t, C_BA + ch, P.conv_w, P.conv_b, 2048 + ch, o);
#pragma unroll
            for (int i = 0; i < 8; ++i) BT[(n0 + i) * 136 + l] = (bf16)f2bf(o[i]);
        }
    }
    __syncthreads();
    { f32x4 acc[2][8];
#pragma unroll
      for (int a = 0; a < 2; ++a)
#pragma unroll
          for (int b = 0; b < 8; ++b) acc[a][b] = (f32x4){0.f, 0.f, 0.f, 0.f};
      const int fr = lane & 15, fq = lane >> 4;
#pragma unroll
      for (int ks = 0; ks < 4; ++ks) {
          bf16x8 xf[2];
#pragma unroll
          for (int a = 0; a < 2; ++a) xf[a] = ldfrag(XT, 136, wave * 32 + a * 16 + fr, ks * 32 + fq * 8);
#pragma unroll
          for (int b = 0; b < 8; ++b) { const bf16x8 yf = ldfrag(BT, 136, b * 16 + fr, ks * 32 + fq * 8);
#pragma unroll
              for (int a = 0; a < 2; ++a) acc[a][b] = mma16(xf[a], yf, acc[a][b]); }
      }
      const int hh = wave >> 1, h = g * 4 + hh;
      float* st = (float*)(ws + WS_ST) + ((size_t)(c * 32 + h) * 64) * 128;
#pragma unroll
      for (int a = 0; a < 2; ++a)
#pragma unroll
          for (int b = 0; b < 8; ++b)
#pragma unroll
              for (int r = 0; r < 4; ++r) { const int p = (wave & 1) * 32 + a * 16 + fq * 4 + r, n = b * 16 + fr; st[(size_t)p * 128 + n] = acc[a][b][r]; }
    }
    __syncthreads();
}

__device__ __forceinline__ void ssd_scan(ArgsP A, int tid, int bid, int G) {
    float* st = (float*)(A->ws + WS_ST); const float* cd = (const float*)(A->ws + WS_CD);
    for (int i = bid * 512 + tid; i < 32 * 64 * 128 / 4; i += G * 512) {
        const int h = i / 2048; f32x4 run = {0.f, 0.f, 0.f, 0.f};
#pragma unroll 16
        for (int c = 0; c < 64; ++c) { f32x4* p = (f32x4*)(st + (size_t)c * 32 * 64 * 128) + i; const f32x4 s = *p; const float d = cd[c * 32 + h]; *p = run; run = run * d + s; }
    }
}

constexpr int SC_CM = 0, SC_BM = 34816, SC_MH = 69632, SC_XT = 104448, SC_PV = 121856, SC_ACS = 139264, SC_DTV = 141312;
__device__ __forceinline__ void ssd_out_unit(ArgsP A, const LayerP& P, float* rowss, LAS unsigned char* lds, int c, int g, int tid, int lane, int wave) {
    tid = fresh(tid); lane = fresh(lane); wave = fresh_s(wave);
    unsigned char* ws = A->ws;
    const bf16* proj = (const bf16*)(ws + WS_PROJ);
    LAS bf16* CM = (LAS bf16*)(lds + SC_CM); LAS bf16* BM = (LAS bf16*)(lds + SC_BM); LAS bf16* MH = (LAS bf16*)(lds + SC_MH);
    LAS bf16* XT = (LAS bf16*)(lds + SC_XT); LAS bf16* PV = (LAS bf16*)(lds + SC_PV);
    LAS float* acs = (LAS float*)(lds + SC_ACS); LAS float* dtv = (LAS float*)(lds + SC_DTV);
    const int t0 = c * 128, fr = lane & 15, fq = lane >> 4;
    { const int l = tid >> 2, hh = tid & 3; acs[l * 4 + hh] = ((const float*)(ws + WS_ACS))[(size_t)(t0 + l) * 32 + g * 4 + hh]; dtv[l * 4 + hh] = ((const float*)(ws + WS_DTV))[(size_t)(t0 + l) * 32 + g * 4 + hh]; }
#pragma unroll 1
    for (int item = fresh(tid); item < 32 * 128; item += 512) {
        const int l = item & 127, v = item >> 7, t = t0 + l; float o[8];
        const int n0 = (v & 15) * 8, ch = g * 128 + n0;
        if (v < 16) conv8(proj, t, C_BA + ch, P.conv_w, P.conv_b, 2048 + ch, o); else conv8(proj, t, C_CA + ch, P.conv_w, P.conv_b, 3072 + ch, o);
        u32x4 w; w.x = pk2(o[0], o[1]); w.y = pk2(o[2], o[3]); w.z = pk2(o[4], o[5]); w.w = pk2(o[6], o[7]);
        *(LAS u32x4*)((v < 16 ? BM : CM) + l * 136 + n0) = w;
    }
    __syncthreads();
    f32x4 cb[8];
#pragma unroll
    for (int b = 0; b < 8; ++b) cb[b] = (f32x4){0.f, 0.f, 0.f, 0.f};
#pragma unroll
    for (int ks = 0; ks < 4; ++ks) { const bf16x8 xf = ldfrag(CM, 136, wave * 16 + fr, ks * 32 + fq * 8);
#pragma unroll
        for (int b = 0; b < 8; ++b) cb[b] = mma16(xf, ldfrag(BM, 136, b * 16 + fr, ks * 32 + fq * 8), cb[b]); }
    float ssq[4] = {0.f, 0.f, 0.f, 0.f};
    for (int hh = 0; hh < 4; ++hh) {
        const int h = g * 4 + hh;
#pragma unroll 1
        for (int item = fresh(tid); item < 8 * 128; item += 512) { const int l = item & 127, v = item >> 7, ch = h * 64 + v * 8; float o[8];
            conv8(proj, t0 + l, C_XA + ch, P.conv_w, P.conv_b, ch, o);
#pragma unroll
            for (int i = 0; i < 8; ++i) XT[(v * 8 + i) * 136 + l] = (bf16)f2bf(o[i]); }
        { const float* st = (const float*)(ws + WS_ST) + ((size_t)(c * 32 + h) * 64) * 128;
#pragma unroll 1
          for (int item = fresh(tid); item < 64 * 16; item += 512) { const int p = item >> 4, n0 = (item & 15) * 8;
              const f32x4 a = *(const f32x4*)(st + p * 128 + n0), b = *(const f32x4*)(st + p * 128 + n0 + 4);
              u32x4 w; w.x = pk2(a[0], a[1]); w.y = pk2(a[2], a[3]); w.z = pk2(b[0], b[1]); w.w = pk2(b[2], b[3]);
              *(LAS u32x4*)(PV + p * 136 + n0) = w; } }
#pragma unroll
        for (int b = 0; b < 8; ++b)
#pragma unroll
            for (int r = 0; r < 4; ++r) { const int l = wave * 16 + fq * 4 + r, s = b * 16 + fr;
                const float v = (s <= l) ? cb[b][r] * __expf(acs[l * 4 + hh] - acs[s * 4 + hh]) * dtv[s * 4 + hh] : 0.f;
                MH[l * 136 + s] = (bf16)f2bf(v); }
        __syncthreads();
        f32x4 yd[4], yo[4];
#pragma unroll
        for (int b = 0; b < 4; ++b) { yd[b] = (f32x4){0.f, 0.f, 0.f, 0.f}; yo[b] = (f32x4){0.f, 0.f, 0.f, 0.f}; }
#pragma unroll
        for (int ks = 0; ks < 4; ++ks) { const bf16x8 mf = ldfrag(MH, 136, wave * 16 + fr, ks * 32 + fq * 8), cf = ldfrag(CM, 136, wave * 16 + fr, ks * 32 + fq * 8);
#pragma unroll
            for (int b = 0; b < 4; ++b) { yd[b] = mma16(mf, ldfrag(XT, 136, b * 16 + fr, ks * 32 + fq * 8), yd[b]); yo[b] = mma16(cf, ldfrag(PV, 136, b * 16 + fr, ks * 32 + fq * 8), yo[b]); } }
        const float dsk = P.d_skip[h];
#pragma unroll
        for (int r = 0; r < 4; ++r) { const int l = wave * 16 + fq * 4 + r, t = t0 + l; const float ea = __expf(acs[l * 4 + hh]);
#pragma unroll
            for (int b = 0; b < 4; ++b) { const int p = b * 16 + fr, ch = h * 64 + p;
                const float xs = bf2f(XT[p * 136 + l]);
                const float y = yd[b][r] + yo[b][r] * ea + xs * dsk;
                const float z = bf2f(proj[(size_t)t * NPROJ + C_ZA + ch]);
                const float yg = y * siluf(z);
                ssq[r] += yg * yg;
                ((bf16*)(ws + WS_YA))[(size_t)t * DM + ch] = (bf16)f2bf(yg * P.ssm_norm[ch]); } }
        __syncthreads();
    }
#pragma unroll
    for (int r = 0; r < 4; ++r) { float s = ssq[r]; s += __shfl_xor(s, 1); s += __shfl_xor(s, 2); s += __shfl_xor(s, 4); s += __shfl_xor(s, 8);
        if (fr == 0) atomicAdd(rowss + t0 + wave * 16 + fq * 4 + r, s); }
}

__device__ __forceinline__ float ret_logg(int h) { return log1pf(-exp2f(-5.0f - (float)h)); }
__device__ __forceinline__ void rotary8(const u32x4 v, int t, int d0, float sc, const LAS float* invt, float (&o)[8]) {
    const float x[8] = {blo(v.x), bhi(v.x), blo(v.y), bhi(v.y), blo(v.z), bhi(v.z), blo(v.w), bhi(v.w)};
#pragma unroll
    for (int i = 0; i < 4; ++i) { const int pi = (d0 >> 1) + i;
        const float inv = invt[pi];
        float sn, cs; sincosf((float)t * inv, &sn, &cs);
        o[2 * i] = (x[2 * i] * cs - x[2 * i + 1] * sn) * sc; o[2 * i + 1] = (x[2 * i] * sn + x[2 * i + 1] * cs) * sc; }
}
constexpr int RA_VT = 0, RA_KT = 69632;
__device__ __forceinline__ void ret_kv_unit(ArgsP A, LAS unsigned char* lds, int c, int h, int tid, int lane, int wave) {
    tid = fresh(tid); lane = fresh(lane); wave = fresh_s(wave);
    unsigned char* ws = A->ws; const bf16* proj = (const bf16*)(ws + WS_PROJ);
    LAS bf16* VT = (LAS bf16*)(lds + RA_VT); LAS bf16* KT = (LAS bf16*)(lds + RA_KT);
    const int t0 = c * 128; const float lg = ret_logg(h);
#pragma unroll 1
    for (int item = fresh(tid); item < 64 * 128; item += 512) { const int j = item & 127, v = item >> 7, t = t0 + j;
        if (v < 32) { const u32x4 w = *(const u32x4*)(proj + (size_t)t * NPROJ + C_VC + h * 256 + v * 8);
            VT[(v * 8 + 0) * 136 + j] = (bf16)(w.x & 0xffff); VT[(v * 8 + 1) * 136 + j] = (bf16)(w.x >> 16); VT[(v * 8 + 2) * 136 + j] = (bf16)(w.y & 0xffff); VT[(v * 8 + 3) * 136 + j] = (bf16)(w.y >> 16);
            VT[(v * 8 + 4) * 136 + j] = (bf16)(w.z & 0xffff); VT[(v * 8 + 5) * 136 + j] = (bf16)(w.z >> 16); VT[(v * 8 + 6) * 136 + j] = (bf16)(w.w & 0xffff); VT[(v * 8 + 7) * 136 + j] = (bf16)(w.w >> 16);
        } else { const int d0 = (v - 32) * 8; const u32x4 w = *(const u32x4*)(proj + (size_t)t * NPROJ + C_KC + h * 256 + d0); float o[8];
            rotary8(w, t, d0, 0.0625f * __expf(lg * (float)(127 - j)), (const LAS float*)(lds + MISC_OFF + 512), o);
#pragma unroll
            for (int i = 0; i < 8; ++i) KT[(d0 + i) * 136 + j] = (bf16)f2bf(o[i]); }
    }
    __syncthreads();
    const int fr = lane & 15, fq = lane >> 4;
    float* out = (float*)(ws + WS_KVT) + (size_t)(c * 8 + h) * 65536;
    for (int half = 0; half < 2; ++half) {
        f32x4 acc[2][8];
#pragma unroll
        for (int a = 0; a < 2; ++a)
#pragma unroll
            for (int b = 0; b < 8; ++b) acc[a][b] = (f32x4){0.f, 0.f, 0.f, 0.f};
#pragma unroll
        for (int ks = 0; ks < 4; ++ks) { bf16x8 xf[2];
#pragma unroll
            for (int a = 0; a < 2; ++a) xf[a] = ldfrag(VT, 136, wave * 32 + a * 16 + fr, ks * 32 + fq * 8);
#pragma unroll
            for (int b = 0; b < 8; ++b) { const bf16x8 yf = ldfrag(KT, 136, half * 128 + b * 16 + fr, ks * 32 + fq * 8);
#pragma unroll
                for (int a = 0; a < 2; ++a) acc[a][b] = mma16(xf[a], yf, acc[a][b]); } }
#pragma unroll
        for (int a = 0; a < 2; ++a)
#pragma unroll
            for (int b = 0; b < 8; ++b)
#pragma unroll
                for (int r = 0; r < 4; ++r) { const int e = wave * 32 + a * 16 + fq * 4 + r, d = half * 128 + b * 16 + fr; out[(size_t)e * 256 + d] = acc[a][b][r]; }
    }
    __syncthreads();
}
__device__ __forceinline__ void ret_scan(ArgsP A, int tid, int bid, int G) {
    float* kv = (float*)(A->ws + WS_KVT);
    for (int i = bid * 512 + tid; i < 8 * 65536 / 4; i += G * 512) {
        const int h = i / 16384; const float d = __expf(ret_logg(h) * 128.0f); f32x4 run = {0.f, 0.f, 0.f, 0.f};
#pragma unroll 16
        for (int c = 0; c < 64; ++c) { f32x4* p = (f32x4*)(kv + (size_t)c * 8 * 65536) + i; const f32x4 s = *p; *p = run; run = run * d + s; }
    }
}
constexpr int RC_Q = 0, RC_K = 67584, RC_S = 67584, RC_VT = 102400, RC_RT = 67584;
__device__ __forceinline__ void ret_out_unit(ArgsP A, const LayerP& P, LAS unsigned char* lds, int c, int h, int tid, int lane, int wave) {
    tid = fresh(tid); lane = fresh(lane); wave = fresh_s(wave);
    unsigned char* ws = A->ws; const bf16* proj = (const bf16*)(ws + WS_PROJ);
    LAS bf16* Q = (LAS bf16*)(lds + RC_Q); LAS bf16* K = (LAS bf16*)(lds + RC_K); LAS bf16* S = (LAS bf16*)(lds + RC_S);
    LAS bf16* VT = (LAS bf16*)(lds + RC_VT); LAS bf16* RT = (LAS bf16*)(lds + RC_RT);
    const int t0 = c * 128, fr = lane & 15, fq = lane >> 4; const float lg = ret_logg(h);
#pragma unroll 1
    for (int item = fresh(tid); item < 64 * 128; item += 512) { const int j = item & 127, v = item >> 7, t = t0 + j, d0 = (v & 31) * 8; float o[8];
        const u32x4 w = *(const u32x4*)(proj + (size_t)t * NPROJ + (v < 32 ? C_QC : C_KC) + h * 256 + d0);
        rotary8(w, t, d0, v < 32 ? 1.0f : 0.0625f, (const LAS float*)(lds + MISC_OFF + 512), o);
        u32x4 pw; pw.x = pk2(o[0], o[1]); pw.y = pk2(o[2], o[3]); pw.z = pk2(o[4], o[5]); pw.w = pk2(o[6], o[7]);
        *(LAS u32x4*)((v < 32 ? Q : K) + j * 264 + d0) = pw; }
    __syncthreads();
    f32x4 sc[8];
#pragma unroll
    for (int b = 0; b < 8; ++b) sc[b] = (f32x4){0.f, 0.f, 0.f, 0.f};
#pragma unroll
    for (int ks = 0; ks < 8; ++ks) { const bf16x8 xf = ldfrag(Q, 264, wave * 16 + fr, ks * 32 + fq * 8);
#pragma unroll
        for (int b = 0; b < 8; ++b) sc[b] = mma16(xf, ldfrag(K, 264, b * 16 + fr, ks * 32 + fq * 8), sc[b]); }
    __syncthreads();
#pragma unroll
    for (int b = 0; b < 8; ++b)
#pragma unroll
        for (int r = 0; r < 4; ++r) { const int i = wave * 16 + fq * 4 + r, j = b * 16 + fr;
            S[i * 136 + j] = (bf16)f2bf(i >= j ? sc[b][r] * __expf(lg * (float)(i - j)) : 0.f); }
    f32x4 o[16];
#pragma unroll
    for (int b = 0; b < 16; ++b) o[b] = (f32x4){0.f, 0.f, 0.f, 0.f};
#pragma unroll
    for (int eh = 0; eh < 2; ++eh) {
#pragma unroll 1
        for (int item = fresh(tid); item < 16 * 128; item += 512) { const int j = item & 127, v = item >> 7;
            const u32x4 w = *(const u32x4*)(proj + (size_t)(t0 + j) * NPROJ + C_VC + h * 256 + eh * 128 + v * 8);
            VT[(v * 8 + 0) * 136 + j] = (bf16)(w.x & 0xffff); VT[(v * 8 + 1) * 136 + j] = (bf16)(w.x >> 16); VT[(v * 8 + 2) * 136 + j] = (bf16)(w.y & 0xffff); VT[(v * 8 + 3) * 136 + j] = (bf16)(w.y >> 16);
            VT[(v * 8 + 4) * 136 + j] = (bf16)(w.z & 0xffff); VT[(v * 8 + 5) * 136 + j] = (bf16)(w.z >> 16); VT[(v * 8 + 6) * 136 + j] = (bf16)(w.w & 0xffff); VT[(v * 8 + 7) * 136 + j] = (bf16)(w.w >> 16); }
        __syncthreads();
#pragma unroll
        for (int ks = 0; ks < 4; ++ks) { const bf16x8 xf = ldfrag(S, 136, wave * 16 + fr, ks * 32 + fq * 8);
#pragma unroll
            for (int b = 0; b < 8; ++b) o[eh * 8 + b] = mma16(xf, ldfrag(VT, 136, b * 16 + fr, ks * 32 + fq * 8), o[eh * 8 + b]); }
        __syncthreads();
    }
    const float* kvt = (const float*)(ws + WS_KVT) + (size_t)(c * 8 + h) * 65536;
    float xi[4];
#pragma unroll
    for (int r = 0; r < 4; ++r) xi[r] = __expf(lg * (float)(wave * 16 + fq * 4 + r + 1));
#pragma unroll
    for (int eq = 0; eq < 4; ++eq) {
#pragma unroll 1
        for (int item = fresh(tid); item < 64 * 32; item += 512) { const int e = item >> 5, d0 = (item & 31) * 8;
            const f32x4 a = *(const f32x4*)(kvt + (size_t)(eq * 64 + e) * 256 + d0), b = *(const f32x4*)(kvt + (size_t)(eq * 64 + e) * 256 + d0 + 4);
            u32x4 w; w.x = pk2(a[0], a[1]); w.y = pk2(a[2], a[3]); w.z = pk2(b[0], b[1]); w.w = pk2(b[2], b[3]);
            *(LAS u32x4*)(RT + e * 264 + d0) = w; }
        __syncthreads();
        f32x4 cr[4];
#pragma unroll
        for (int b = 0; b < 4; ++b) cr[b] = (f32x4){0.f, 0.f, 0.f, 0.f};
#pragma unroll
        for (int ks = 0; ks < 8; ++ks) { const bf16x8 xf = ldfrag(Q, 264, wave * 16 + fr, ks * 32 + fq * 8);
#pragma unroll
            for (int b = 0; b < 4; ++b) cr[b] = mma16(xf, ldfrag(RT, 264, b * 16 + fr, ks * 32 + fq * 8), cr[b]); }
#pragma unroll
        for (int b = 0; b < 4; ++b)
#pragma unroll
            for (int r = 0; r < 4; ++r) o[eq * 4 + b][r] += cr[b][r] * xi[r];
        __syncthreads();
    }
#pragma unroll
    for (int r = 0; r < 4; ++r) {
        float s = 0.f;
#pragma unroll
        for (int b = 0; b < 16; ++b) s += o[b][r];
        s += __shfl_xor(s, 1); s += __shfl_xor(s, 2); s += __shfl_xor(s, 4); s += __shfl_xor(s, 8);
        const float mu = s * (1.0f / 256.0f); float q = 0.f;
#pragma unroll
        for (int b = 0; b < 16; ++b) { const float d = o[b][r] - mu; q += d * d; }
        q += __shfl_xor(q, 1); q += __shfl_xor(q, 2); q += __shfl_xor(q, 4); q += __shfl_xor(q, 8);
        const float rs = rsqrtf(q * (1.0f / 256.0f) + EPS);
        const int t = t0 + wave * 16 + fq * 4 + r;
#pragma unroll
        for (int b = 0; b < 16; ++b) { const int ch = h * 256 + b * 16 + fr;
            const float z = bf2f(proj[(size_t)t * NPROJ + C_ZC + ch]);
            ((bf16*)(ws + WS_YC))[(size_t)t * DM + ch] = (bf16)f2bf((o[b][r] - mu) * rs * P.ret_norm[ch] * siluf(z)); }
    }
    __syncthreads();
}

__device__ __forceinline__ void nsa_im2col(ArgsP A, int tid, int bid, int G) {
    const bf16* proj = (const bf16*)(A->ws + WS_PROJ); u32x4* aim = (u32x4*)(A->ws + WS_AIM);
    const size_t nvec = (size_t)2 * 2048 * 512;
    for (size_t i = (size_t)bid * 512 + tid; i < nvec; i += (size_t)G * 512) {
        const int s = (int)(i >> 20), row = (int)((i >> 9) & 2047), kv = (int)(i & 511), l = kv >> 4, d0 = (kv & 15) * 8, n = row >> 2, hk = row & 3;
        u32x4 v = {0u, 0u, 0u, 0u};
        if (row < NCMP * 4) v = *(const u32x4*)(proj + (size_t)(n * 16 + l) * NPROJ + (s ? C_VCB : C_KCB) + hk * 128 + d0);
        aim[i] = v;
    }
}

constexpr int NA_Q = 0, NA_K = 34816, NA_VT = 52224, NA_S = 70656, NA_P = 105472, NA_M = 123904, NA_L = 124416, NA_AL = 124928, NA_IMP = 125440, NA_SEL = 141824, NA_ANY = 142336;
__device__ __forceinline__ void na_stage_kv(const bf16* kbase, const bf16* vbase, size_t rstride, int row0, int rowstep, int maxrow, LAS bf16* Kt, LAS bf16* Vt, int tid, bool with_v) {
#pragma unroll 1
    for (int item = fresh(tid); item < 1024; item += 512) { const int kk = item >> 4, d0 = (item & 15) * 8; int row = row0 + kk * rowstep; row = row < 0 ? 0 : (row > maxrow ? maxrow : row);
        *(LAS u32x4*)(Kt + kk * 136 + d0) = *(const u32x4*)(kbase + (size_t)row * rstride + d0); }
    if (with_v) {
#pragma unroll 1
    for (int item = fresh(tid); item < 1024; item += 512) { const int kk = item & 63, d0 = (item >> 6) * 8; int row = row0 + kk * rowstep; row = row < 0 ? 0 : (row > maxrow ? maxrow : row);
        const u32x4 w = *(const u32x4*)(vbase + (size_t)row * rstride + d0);
        Vt[(d0 + 0) * 72 + kk] = (bf16)(w.x & 0xffff); Vt[(d0 + 1) * 72 + kk] = (bf16)(w.x >> 16); Vt[(d0 + 2) * 72 + kk] = (bf16)(w.y & 0xffff); Vt[(d0 + 3) * 72 + kk] = (bf16)(w.y >> 16);
        Vt[(d0 + 4) * 72 + kk] = (bf16)(w.z & 0xffff); Vt[(d0 + 5) * 72 + kk] = (bf16)(w.z >> 16); Vt[(d0 + 6) * 72 + kk] = (bf16)(w.w & 0xffff); Vt[(d0 + 7) * 72 + kk] = (bf16)(w.w >> 16); } }
}
__device__ __forceinline__ void na_scores(const LAS bf16* Q, const LAS bf16* Kt, LAS float* S, int lane, int wave) {
    const int fr = lane & 15, fq = lane >> 4; f32x4 acc[4];
#pragma unroll
    for (int b = 0; b < 4; ++b) acc[b] = (f32x4){0.f, 0.f, 0.f, 0.f};
#pragma unroll
    for (int ks = 0; ks < 4; ++ks) { const bf16x8 xf = ldfrag(Q, 136, wave * 16 + fr, ks * 32 + fq * 8);
#pragma unroll
        for (int b = 0; b < 4; ++b) acc[b] = mma16(xf, ldfrag(Kt, 136, b * 16 + fr, ks * 32 + fq * 8), acc[b]); }
#pragma unroll
    for (int b = 0; b < 4; ++b)
#pragma unroll
        for (int r = 0; r < 4; ++r) S[(wave * 16 + fq * 4 + r) * 68 + b * 16 + fr] = acc[b][r] * 0.08838834764831845f;
}
template <int KIND> __device__ __forceinline__ bool na_valid(int t, int kidx, const LAS unsigned* selrow, int j) {
    if (KIND == 0) return kidx < NCMP && kidx * 16 + 31 <= t;
    if (KIND == 1) return ((selrow[j >> 5] >> (j & 31)) & 1u) && kidx <= t;
    return kidx <= t && kidx > t - 512 && kidx >= 0;
}
template <int KIND> __device__ __forceinline__ void na_softmax_online(LAS float* S, LAS bf16* Pm, LAS float* M, LAS float* Ls, LAS float* AL, const LAS unsigned* SEL, int t0, int kidx0, int j, int tid) {
    const int row = tid >> 2, q = tid & 3, tt = row >> 2, t = t0 + tt; const LAS unsigned* selrow = SEL + tt * 4;
    float sv[16]; float mx = -1e30f;
#pragma unroll
    for (int i = 0; i < 16; ++i) { const int col = q * 16 + i; const bool ok = na_valid<KIND>(t, kidx0 + col, selrow, j); sv[i] = ok ? S[row * 68 + col] : -1e30f; mx = fmaxf(mx, sv[i]); }
    mx = fmaxf(mx, __shfl_xor(mx, 1)); mx = fmaxf(mx, __shfl_xor(mx, 2));
    const float mo = M[row], mn = fmaxf(mo, mx); float ps = 0.f;
#pragma unroll
    for (int i = 0; i < 16; i += 2) { const float p0 = sv[i] > -1e29f ? __expf(sv[i] - mn) : 0.f, p1 = sv[i + 1] > -1e29f ? __expf(sv[i + 1] - mn) : 0.f; ps += p0 + p1;
        *(LAS unsigned*)(Pm + row * 72 + q * 16 + i) = pk2(p0, p1); }
    ps += __shfl_xor(ps, 1); ps += __shfl_xor(ps, 2);
    if (q == 0) { const float al = __expf(mo - mn); AL[row] = al; Ls[row] = Ls[row] * al + ps; M[row] = mn; }
}
__device__ __forceinline__ void na_pv(f32x4 (&O)[8], const LAS bf16* Pm, const LAS bf16* Vt, const LAS float* AL, bool rescale, int lane, int wave) {
    const int fr = lane & 15, fq = lane >> 4;
    if (rescale) {
#pragma unroll
        for (int r = 0; r < 4; ++r) { const float al = AL[wave * 16 + fq * 4 + r];
#pragma unroll
            for (int b = 0; b < 8; ++b) O[b][r] *= al; } }
#pragma unroll
    for (int ks = 0; ks < 2; ++ks) { const bf16x8 xf = ldfrag(Pm, 72, wave * 16 + fr, ks * 32 + fq * 8);
#pragma unroll
        for (int b = 0; b < 8; ++b) O[b] = mma16(xf, ldfrag(Vt, 72, b * 16 + fr, ks * 32 + fq * 8), O[b]); }
}
__device__ __forceinline__ void na_reset_stats(LAS float* M, LAS float* Ls, int tid) { if (tid < 128) { M[tid] = -1e30f; Ls[tid] = 0.f; } }
__device__ __forceinline__ void na_combine(f32x4 (&comb)[8], f32x4 (&O)[8], const LAS float* Ls, const float* small, int t0, int g, int branch, int lane, int wave) {
    const int fq = lane >> 4;
#pragma unroll
    for (int r = 0; r < 4; ++r) { const int row = wave * 16 + fq * 4 + r, tt = row >> 2, hr = row & 3; const float l = Ls[row];
        const float gate = sigm(small[(size_t)(t0 + tt) * 256 + 32 + (g * 4 + hr) * 3 + branch]);
        const float f = l > 0.f ? gate / l : 0.f;
#pragma unroll
        for (int b = 0; b < 8; ++b) { comb[b][r] += O[b][r] * f; O[b][r] = 0.f; } }
}

__device__ __forceinline__ void nsa_attn_unit(ArgsP A, LAS unsigned char* lds, int qt, int g, int tid, int lane, int wave) {
    tid = fresh(tid); lane = fresh(lane); wave = fresh_s(wave);
    unsigned char* ws = A->ws; const bf16* proj = (const bf16*)(ws + WS_PROJ); const float* small = (const float*)(ws + WS_SMALL);
    LAS bf16* Q = (LAS bf16*)(lds + NA_Q); LAS bf16* Kt = (LAS bf16*)(lds + NA_K); LAS bf16* Vt = (LAS bf16*)(lds + NA_VT);
    LAS float* S = (LAS float*)(lds + NA_S); LAS bf16* Pm = (LAS bf16*)(lds + NA_P);
    LAS float* M = (LAS float*)(lds + NA_M); LAS float* Ls = (LAS float*)(lds + NA_L); LAS float* AL = (LAS float*)(lds + NA_AL);
    LAS float* IMP = (LAS float*)(lds + NA_IMP); LAS unsigned* SEL = (LAS unsigned*)(lds + NA_SEL); LAS unsigned* ANY = (LAS unsigned*)(lds + NA_ANY);
    const int t0 = qt * 32, tlast = t0 + 31, fr = lane & 15, fq = lane >> 4;
#pragma unroll 1
    for (int item = fresh(tid); item < 128 * 16; item += 512) { const int row = item >> 4, d0 = (item & 15) * 8, tt = row >> 2, hr = row & 3;
        *(LAS u32x4*)(Q + row * 136 + d0) = *(const u32x4*)(proj + (size_t)(t0 + tt) * NPROJ + C_QB + (g * 4 + hr) * 128 + d0); }
    for (int i = tid; i < 32 * 128; i += 512) IMP[i] = 0.f;
    if (tid < 128) { SEL[tid] = 0u; ANY[tid] = 0u; }
    na_reset_stats(M, Ls, tid);
    f32x4 O[8], comb[8];
#pragma unroll
    for (int b = 0; b < 8; ++b) { O[b] = (f32x4){0.f, 0.f, 0.f, 0.f}; comb[b] = (f32x4){0.f, 0.f, 0.f, 0.f}; }
    __syncthreads();
    const bf16* kcmp = (const bf16*)(ws + WS_KVC) + g * 128; const bf16* vcmp = (const bf16*)(ws + WS_KVC + 524288) + g * 128;
    const int ncmp_tiles = tlast >= 31 ? ((tlast - 31) / 16) / 64 + 1 : 0;
    for (int kt = 0; kt < ncmp_tiles; ++kt) {
        na_stage_kv(kcmp, vcmp, 512, kt * 64, 1, NCMP - 1, Kt, Vt, tid, false);
        __syncthreads();
        na_scores(Q, Kt, S, lane, wave);
        __syncthreads();
        na_softmax_online<0>(S, Pm, M, Ls, AL, SEL, t0, kt * 64, 0, tid);
        __syncthreads();
    }
    for (int kt = 0; kt < ncmp_tiles; ++kt) {
        na_stage_kv(kcmp, vcmp, 512, kt * 64, 1, NCMP - 1, Kt, Vt, tid, true);
        __syncthreads();
        na_scores(Q, Kt, S, lane, wave);
        __syncthreads();
        { const int row = tid >> 2, q = tid & 3, t = t0 + (row >> 2); const float m = M[row], l = Ls[row], il = l > 0.f ? 1.0f / l : 0.f;
#pragma unroll
          for (int i = 0; i < 16; i += 2) { const int col = q * 16 + i;
              const float p0 = na_valid<0>(t, kt * 64 + col, SEL, 0) ? __expf(S[row * 68 + col] - m) * il : 0.f, p1 = na_valid<0>(t, kt * 64 + col + 1, SEL, 0) ? __expf(S[row * 68 + col + 1] - m) * il : 0.f;
              S[row * 68 + col] = p0; S[row * 68 + col + 1] = p1; *(LAS unsigned*)(Pm + row * 72 + col) = pk2(p0, p1); } }
        __syncthreads();
        na_pv(O, Pm, Vt, AL, false, lane, wave);
#pragma unroll 1
        for (int item = fresh(tid); item < 32 * 17; item += 512) { const int tt = item / 17, jj = item % 17, j = kt * 16 + jj;
            if (j < 128) { float s = 0.f;
#pragma unroll
                for (int dn = -1; dn < 4; ++dn) { const int col = 4 * jj + dn; if (col >= 0 && col < 64 && !(jj == 16 && dn >= 0)) {
#pragma unroll
                        for (int hr = 0; hr < 4; ++hr) s += S[(tt * 4 + hr) * 68 + col]; } }
                IMP[tt * 128 + j] += s; } }
        __syncthreads();
    }
    { const int fq2 = lane >> 4;
#pragma unroll
      for (int r = 0; r < 4; ++r) { const int row = wave * 16 + fq2 * 4 + r, tt = row >> 2, hr = row & 3;
          const float gate = sigm(small[(size_t)(t0 + tt) * 256 + 32 + (g * 4 + hr) * 3 + 0]);
#pragma unroll
          for (int b = 0; b < 8; ++b) { comb[b][r] += O[b][r] * gate; O[b][r] = 0.f; } } }
#pragma unroll 1
    for (int item = fresh(tid); item < 32 * 128; item += 512) { const int tt = item >> 7, j = item & 127, t = t0 + tt, cur = t >> 6;
        const bool forced = (j == 0) || (j == cur) || (j + 1 == cur); const bool elig = j <= cur;
        const float v = IMP[item]; IMP[item] = forced ? __builtin_inff() : (elig ? v : -__builtin_inff()); }
    __syncthreads();
#pragma unroll 1
    for (int item = fresh(tid); item < 32 * 128; item += 512) { const int tt = item >> 7, j = item & 127; const float v = IMP[item]; int rank = 0;
        for (int k = 0; k < 128; ++k) { const float u = IMP[tt * 128 + k]; rank += (u > v || (u == v && k < j)) ? 1 : 0; }
        if (rank < 16 && v > -__builtin_inff()) { __hip_atomic_fetch_or(SEL + tt * 4 + (j >> 5), 1u << (j & 31), __ATOMIC_RELAXED, __HIP_MEMORY_SCOPE_WORKGROUP); ANY[j] = 1u; } }
    na_reset_stats(M, Ls, tid);
    __syncthreads();
    const int curlast = tlast >> 6;
    for (int j = 0; j <= curlast; ++j) {
        if (ANY[j] == 0u) continue;
        na_stage_kv(proj + C_KSB + g * 128, proj + C_VSB + g * 128, NPROJ, j * 64, 1, L_SEQ - 1, Kt, Vt, tid, true);
        __syncthreads();
        na_scores(Q, Kt, S, lane, wave);
        __syncthreads();
        na_softmax_online<1>(S, Pm, M, Ls, AL, SEL, t0, j * 64, j, tid);
        __syncthreads();
        na_pv(O, Pm, Vt, AL, true, lane, wave);
        __syncthreads();
    }
    na_combine(comb, O, Ls, small, t0, g, 1, lane, wave);
    __syncthreads();
    na_reset_stats(M, Ls, tid);
    __syncthreads();
    { const int kmin = t0 - 511 > 0 ? t0 - 511 : 0;
      for (int jb = kmin >> 6; jb <= curlast; ++jb) {
        na_stage_kv(proj + C_KWB + g * 128, proj + C_VWB + g * 128, NPROJ, jb * 64, 1, L_SEQ - 1, Kt, Vt, tid, true);
        __syncthreads();
        na_scores(Q, Kt, S, lane, wave);
        __syncthreads();
        na_softmax_online<2>(S, Pm, M, Ls, AL, SEL, t0, jb * 64, 0, tid);
        __syncthreads();
        na_pv(O, Pm, Vt, AL, true, lane, wave);
        __syncthreads();
      } }
    na_combine(comb, O, Ls, small, t0, g, 2, lane, wave);
#pragma unroll
    for (int r = 0; r < 4; ++r) { const int row = wave * 16 + fq * 4 + r, tt = row >> 2, hr = row & 3, t = t0 + tt;
#pragma unroll
        for (int b = 0; b < 8; ++b) { const int ch = (g * 4 + hr) * 128 + b * 16 + fr;
            const float z = bf2f(proj[(size_t)t * NPROJ + C_ZB + ch]);
            ((bf16*)(ws + WS_YB))[(size_t)t * DM + ch] = (bf16)f2bf(comb[b][r] * siluf(z)); } }
    __syncthreads();
}

constexpr int NB_K = 0, NB_V = 16384, NB_STAGE = 32768, NB_IMP = 98304, NB_SEL = 131072;
typedef short s16x4 __attribute__((ext_vector_type(4)));
struct KVSrc { const bf16* k; const bf16* v; size_t rstride; int maxrow; };
__device__ __forceinline__ void glds16(const void* gsrc, unsigned lds_dst) {
    unsigned keep;
    asm volatile("s_mov_b32 %0, m0\n\ts_mov_b32 m0, %2\n\ts_nop 0\n\tglobal_load_lds_dwordx4 %1, off\n\ts_mov_b32 m0, %0" : "=&s"(keep) : "v"(gsrc), "s"(lds_dst) : "memory");
}
__device__ __forceinline__ void kv_dma(const KVSrc& s, int row0, LAS unsigned char* stage, int wave, int lane) {
#pragma unroll
    for (int i = 0; i < 2; ++i) { const int rb = 4 * (wave + 8 * i), r = rb + (lane >> 4), cp = lane & 15; int row = row0 + r; row = row < 0 ? 0 : (row > s.maxrow ? s.maxrow : row);
        const int ck = cp ^ (r & 15), cv = cp ^ ((r & 7) << 1);
        glds16(s.k + (size_t)row * s.rstride + ck * 8, (unsigned)(size_t)(stage + NB_K + rb * 256));
        glds16(s.v + (size_t)row * s.rstride + cv * 8, (unsigned)(size_t)(stage + NB_V + rb * 256)); }
}
template <int KIND> __device__ __forceinline__ bool nb_valid(int t, int kidx) {
    if (KIND == 0) return kidx < NCMP && kidx * 16 + 31 <= t;
    if (KIND == 1) return kidx <= t;
    return kidx <= t && kidx > t - 512 && kidx >= 0;
}
constexpr float NB_SC = 0.12751743082459868f;
template <int KIND, int MODE>
__device__ __forceinline__ void flash_block(const LAS unsigned char* stage, const bf16x8 (&Q)[2][4], f32x4 (&O)[2][8], float (&m)[2], float (&l)[2], const float (&il)[2],
                                            int kidx0, const int (&trow)[2], const bool (&lane_ok)[2], const bool (&act)[2], bool full, LAS float* IMP, int tokl0, int lane) {
    const int fr = lane & 15, fq = lane >> 4;
    const LAS unsigned char* Kb = stage + NB_K + fr * 256; const LAS unsigned char* Vb = stage + NB_V;
#define NB_KFRAG(t, ks) (*(const LAS bf16x8*)(Kb + (t) * 4096 + (((4 * (ks) + fq) ^ fr) << 4)))
    f32x4 S[2][4];
#pragma unroll
    for (int rg = 0; rg < 2; ++rg)
#pragma unroll
        for (int t = 0; t < 4; ++t) S[rg][t] = (f32x4){0.f, 0.f, 0.f, 0.f};
    if (act[0] && act[1]) {
#pragma unroll
        for (int ks = 0; ks < 4; ++ks)
#pragma unroll
            for (int t = 0; t < 4; ++t) { const bf16x8 kf = NB_KFRAG(t, ks); S[0][t] = mma16(kf, Q[0][ks], S[0][t]); S[1][t] = mma16(kf, Q[1][ks], S[1][t]); }
    } else if (act[0]) {
#pragma unroll
        for (int ks = 0; ks < 4; ++ks)
#pragma unroll
            for (int t = 0; t < 4; ++t) S[0][t] = mma16(NB_KFRAG(t, ks), Q[0][ks], S[0][t]);
    } else if (act[1]) {
#pragma unroll
        for (int ks = 0; ks < 4; ++ks)
#pragma unroll
            for (int t = 0; t < 4; ++t) S[1][t] = mma16(NB_KFRAG(t, ks), Q[1][ks], S[1][t]);
    }
    __builtin_amdgcn_sched_barrier(0);
    bf16x8 P[2][2];
    const float NINF = -__builtin_inff();
#pragma unroll
    for (int rg = 0; rg < 2; ++rg) {
        if (!act[rg]) continue;
        float mx = NINF;
        if (full) {
#pragma unroll
            for (int t = 0; t < 4; ++t)
#pragma unroll
                for (int r = 0; r < 4; ++r) { const float sv = S[rg][t][r] * NB_SC; S[rg][t][r] = sv; mx = fmaxf(mx, sv); }
        } else {
#pragma unroll
            for (int t = 0; t < 4; ++t)
#pragma unroll
                for (int r = 0; r < 4; ++r) { const bool ok = nb_valid<KIND>(trow[rg], kidx0 + 16 * t + 4 * fq + r); const float sv = ok ? S[rg][t][r] * NB_SC : NINF; S[rg][t][r] = sv; mx = fmaxf(mx, sv); }
        }
        if (KIND == 1) mx = lane_ok[rg] ? mx : NINF;
        float mn, scale_l = 1.0f;
        if (MODE == 2) { mn = m[rg]; scale_l = il[rg]; }
        else { mx = fmaxf(mx, __shfl_xor(mx, 16)); mx = fmaxf(mx, __shfl_xor(mx, 32)); mn = fmaxf(m[rg], mx); }
        const float mne = (KIND == 1) ? (lane_ok[rg] ? mn : 1e30f) : mn;
        float ps = 0.f;
#pragma unroll
        for (int t = 0; t < 4; ++t)
#pragma unroll
            for (int r = 0; r < 4; ++r) { float p = __builtin_amdgcn_exp2f(S[rg][t][r] - mne); if (MODE == 2) p *= scale_l; ps += p; S[rg][t][r] = p; }
        if (MODE != 2) { const float al = __builtin_amdgcn_exp2f(m[rg] - mn); m[rg] = mn; l[rg] = l[rg] * al + ps;
            if (MODE == 0 && !__all(al == 1.0f)) {
#pragma unroll
                for (int dt = 0; dt < 8; ++dt) O[rg][dt] *= al; } }
        if (MODE == 2) {
#pragma unroll
            for (int t = 0; t < 4; ++t) { float G = (S[rg][t][0] + S[rg][t][1]) + (S[rg][t][2] + S[rg][t][3]), last = S[rg][t][3];
                G += __shfl_xor(G, 1); G += __shfl_xor(G, 2); last += __shfl_xor(last, 1); last += __shfl_xor(last, 2);
                const int j = (kidx0 >> 2) + 4 * t + fq, tok = tokl0 + rg * 4 + (fr >> 2);
                if ((fr & 3) == 0 && j < 128) { IMP[tok * 128 + j] += G; if (j + 1 < 128) IMP[tok * 128 + j + 1] += last; } } }
        if (MODE != 1) {
#pragma unroll
            for (int s = 0; s < 2; ++s) { u32x4 w; w.x = pg8::cvt_pk_bf16(S[rg][2 * s][0], S[rg][2 * s][1]); w.y = pg8::cvt_pk_bf16(S[rg][2 * s][2], S[rg][2 * s][3]); w.z = pg8::cvt_pk_bf16(S[rg][2 * s + 1][0], S[rg][2 * s + 1][1]); w.w = pg8::cvt_pk_bf16(S[rg][2 * s + 1][2], S[rg][2 * s + 1][3]);
                P[rg][s] = __builtin_bit_cast(bf16x8, w); } }
    }
    __builtin_amdgcn_sched_barrier(0);
    if (MODE != 1) {
        const int a = fr >> 2, p4 = fr & 3;
        const int vrow = 4 * fq + a, vx = (vrow & 7) << 1, vlo = 8 * (p4 & 1);
#define NB_VFRAG(s, dt) const s16x4 v0 = __builtin_amdgcn_ds_read_tr16_b64_v4i16((LAS s16x4*)(Vb + (32 * (s) + vrow) * 256 + (((2 * (dt) + (p4 >> 1)) ^ vx) << 4) + vlo)); \
                const s16x4 v1 = __builtin_amdgcn_ds_read_tr16_b64_v4i16((LAS s16x4*)(Vb + (32 * (s) + 16 + vrow) * 256 + (((2 * (dt) + (p4 >> 1)) ^ vx) << 4) + vlo)); \
                const bf16x8 vf = {v0[0], v0[1], v0[2], v0[3], v1[0], v1[1], v1[2], v1[3]};
        if (act[0] && act[1]) {
#pragma unroll
            for (int s = 0; s < 2; ++s)
#pragma unroll
                for (int dt = 0; dt < 8; ++dt) { NB_VFRAG(s, dt) O[0][dt] = mma16(vf, P[0][s], O[0][dt]); O[1][dt] = mma16(vf, P[1][s], O[1][dt]); }
        } else if (act[0]) {
#pragma unroll
            for (int s = 0; s < 2; ++s)
#pragma unroll
                for (int dt = 0; dt < 8; ++dt) { NB_VFRAG(s, dt) O[0][dt] = mma16(vf, P[0][s], O[0][dt]); }
        } else if (act[1]) {
#pragma unroll
            for (int s = 0; s < 2; ++s)
#pragma unroll
                for (int dt = 0; dt < 8; ++dt) { NB_VFRAG(s, dt) O[1][dt] = mma16(vf, P[1][s], O[1][dt]); }
        }
#undef NB_VFRAG
#undef NB_KFRAG
    }
}
template <int KIND, int MODE>
__device__ __forceinline__ void flash_pass(LAS unsigned char* lds, const KVSrc& src, int b0, int b1, const bf16x8 (&Q)[2][4], f32x4 (&O)[2][8], float (&m)[2], float (&l)[2], const float (&il)[2],
                                           const int (&trow)[2], int tokl0, int tmin, int tid, int lane) {
    LAS float* IMP = (LAS float*)(lds + NB_IMP); const LAS unsigned* SEL = (const LAS unsigned*)(lds + NB_SEL);
    if (b1 <= b0) return;
    const int wave = __builtin_amdgcn_readfirstlane(tid >> 6), nb = b1 - b0;
    kv_dma(src, b0 * 64, lds, wave, lane);
    if (nb > 1) { kv_dma(src, (b0 + 1) * 64, lds + NB_STAGE, wave, lane); asm volatile("s_waitcnt vmcnt(4)" ::: "memory"); } else asm volatile("s_waitcnt vmcnt(0)" ::: "memory");
    __builtin_amdgcn_s_barrier();
    int sc = 0;
    for (int i = 0; i < nb; ++i) {
        const int b = b0 + i; const bool more2 = i + 2 < nb;
        int s2 = sc + 2; s2 = s2 >= 3 ? s2 - 3 : s2;
        if (more2) kv_dma(src, (b + 2) * 64, lds + s2 * NB_STAGE, wave, lane);
        bool lane_ok[2] = {true, true}, act[2] = {true, true};
        if (KIND == 1) {
#pragma unroll
            for (int rg = 0; rg < 2; ++rg) { const int tok = tokl0 + rg * 4 + ((lane & 15) >> 2); lane_ok[rg] = (SEL[tok * 4 + (b >> 5)] >> (b & 31)) & 1u; act[rg] = __any(lane_ok[rg]); } }
        bool full;
        if (KIND == 0) full = (b * 64 + 63 < NCMP) && ((b * 64 + 63) * 16 + 31 <= tmin);
        else if (KIND == 1) full = b * 64 + 63 <= tmin;
        else full = (b * 64 + 63 <= tmin) && (b * 64 > tmin + 7 - 512);
        flash_block<KIND, MODE>(lds + sc * NB_STAGE, Q, O, m, l, il, b * 64, trow, lane_ok, act, full, IMP, tokl0, lane);
        if (more2) asm volatile("s_waitcnt vmcnt(4)" ::: "memory"); else asm volatile("s_waitcnt vmcnt(0)" ::: "memory");
        asm volatile("s_waitcnt lgkmcnt(0)" ::: "memory");
        __builtin_amdgcn_s_barrier();
        sc = sc + 1 == 3 ? 0 : sc + 1;
    }
}
__device__ __forceinline__ void nb_emit(unsigned char* ws, f32x4 (&O)[2][8], const float (&f)[2], const int (&trow)[2], int g, int mode, int lane) {
    const int fr = lane & 15, fq = lane >> 4; const bf16* proj = (const bf16*)(ws + WS_PROJ);
#pragma unroll
    for (int rg = 0; rg < 2; ++rg) { const int t = trow[rg], head = g * 4 + (fr & 3), ch0 = head * 128 + 4 * fq; float* tp = (float*)(ws + WS_TF) + (size_t)t * DM + ch0;
        f32x4 tv[8]; u32x2 zw[8];
#pragma unroll
        for (int dt = 0; dt < 8; ++dt) { tv[dt] = (f32x4){0.f, 0.f, 0.f, 0.f}; zw[dt] = (u32x2){0u, 0u}; }
        if (mode > 0) {
#pragma unroll
            for (int dt = 0; dt < 8; ++dt) tv[dt] = *(const f32x4*)(tp + 16 * dt); }
        if (mode == 2) {
#pragma unroll
            for (int dt = 0; dt < 8; ++dt) zw[dt] = *(const u32x2*)(proj + (size_t)t * NPROJ + C_ZB + ch0 + 16 * dt); }
#pragma unroll
        for (int dt = 0; dt < 8; ++dt) { const f32x4 v = O[rg][dt] * f[rg] + tv[dt];
            if (mode < 2) *(f32x4*)(tp + 16 * dt) = v;
            else { u32x2 w; w.x = pg8::cvt_pk_bf16(v[0] * siluf(blo(zw[dt].x)), v[1] * siluf(bhi(zw[dt].x))); w.y = pg8::cvt_pk_bf16(v[2] * siluf(blo(zw[dt].y)), v[3] * siluf(bhi(zw[dt].y)));
                *(u32x2*)((bf16*)(ws + WS_YB) + (size_t)t * DM + ch0 + 16 * dt) = w; }
            O[rg][dt] = (f32x4){0.f, 0.f, 0.f, 0.f}; } }
}
__device__ __forceinline__ float nb_rowsum(float l) { l += __shfl_xor(l, 16); l += __shfl_xor(l, 32); return l; }

__device__ __forceinline__ void nsa_attn2_unit(ArgsP A, LAS unsigned char* lds, int qt, int g, int tid, int lane, int wave) {
    tid = fresh(tid); lane = fresh(lane); wave = fresh_s(wave);
    unsigned char* ws = A->ws; const bf16* proj = (const bf16*)(ws + WS_PROJ); const float* small = (const float*)(ws + WS_SMALL);
    LAS float* IMP = (LAS float*)(lds + NB_IMP); LAS unsigned* SEL = (LAS unsigned*)(lds + NB_SEL);
    const int t0 = qt * 64, tlast = t0 + 63, fr = lane & 15, fq = lane >> 4, tokl0 = wave * 8;
    int trow[2]; trow[0] = t0 + tokl0 + (fr >> 2); trow[1] = trow[0] + 4;
    bf16x8 Q[2][4];
#pragma unroll
    for (int rg = 0; rg < 2; ++rg)
#pragma unroll
        for (int ks = 0; ks < 4; ++ks) Q[rg][ks] = *(const bf16x8*)(proj + (size_t)trow[rg] * NPROJ + C_QB + (g * 4 + (fr & 3)) * 128 + 32 * ks + 8 * fq);
#pragma unroll
    for (int rg = 0; rg < 2; ++rg)
#pragma unroll
        for (int ks = 0; ks < 4; ++ks) asm volatile("" : "+v"(Q[rg][ks]));
    for (int i = tid; i < 64 * 128; i += 512) IMP[i] = 0.f;
    if (tid < 256) SEL[tid] = 0u;
    f32x4 O[2][8];
#pragma unroll
    for (int rg = 0; rg < 2; ++rg)
#pragma unroll
        for (int dt = 0; dt < 8; ++dt) O[rg][dt] = (f32x4){0.f, 0.f, 0.f, 0.f};
    float m[2], l[2], il[2] = {0.f, 0.f}, gate[2], f[2];
    const int curlast = tlast >> 6;
    { m[0] = m[1] = -1e30f; l[0] = l[1] = 0.f;
      KVSrc src{proj + C_KWB + g * 128, proj + C_VWB + g * 128, (size_t)NPROJ, L_SEQ - 1};
      const int kmin = t0 - 511 > 0 ? t0 - 511 : 0;
      flash_pass<2, 0>(lds, src, kmin >> 6, curlast + 1, Q, O, m, l, il, trow, tokl0, t0 + tokl0, tid, lane);
#pragma unroll
      for (int rg = 0; rg < 2; ++rg) { const float lr = nb_rowsum(l[rg]); gate[rg] = sigm(small[(size_t)trow[rg] * 256 + 32 + (g * 4 + (fr & 3)) * 3 + 2]); f[rg] = lr > 0.f ? gate[rg] / lr : 0.f; }
      nb_emit(ws, O, f, trow, g, 0, lane); }
    { m[0] = m[1] = -1e30f; l[0] = l[1] = 0.f;
      KVSrc src{(const bf16*)(ws + WS_KVC) + g * 128, (const bf16*)(ws + WS_KVC + 524288) + g * 128, (size_t)512, NCMP - 1};
      const int nt = ((tlast - 31) / 16) / 64 + 1;
      flash_pass<0, 1>(lds, src, 0, nt, Q, O, m, l, il, trow, tokl0, t0 + tokl0, tid, lane);
#pragma unroll
      for (int rg = 0; rg < 2; ++rg) { const float lr = nb_rowsum(l[rg]); il[rg] = lr > 0.f ? 1.0f / lr : 0.f; }
      flash_pass<0, 2>(lds, src, 0, nt, Q, O, m, l, il, trow, tokl0, t0 + tokl0, tid, lane);
#pragma unroll
      for (int rg = 0; rg < 2; ++rg) f[rg] = sigm(small[(size_t)trow[rg] * 256 + 32 + (g * 4 + (fr & 3)) * 3 + 0]);
      nb_emit(ws, O, f, trow, g, 1, lane); }
    __syncthreads();
#pragma unroll 1
    for (int tk = 0; tk < 8; ++tk) { const int tt = tokl0 + tk, t = t0 + tt, cur = t >> 6;
        unsigned u0, u1;
        { const int j0 = lane, j1 = lane + 64;
          const bool f0 = (j0 == 0) || (j0 == cur) || (j0 + 1 == cur), f1 = (j1 == cur) || (j1 + 1 == cur);
          u0 = f0 ? 0x7f800001u : (j0 <= cur ? __float_as_uint(IMP[tt * 128 + j0]) + 1u : 0u);
          u1 = f1 ? 0x7f800001u : (j1 <= cur ? __float_as_uint(IMP[tt * 128 + j1]) + 1u : 0u); }
        unsigned T = 0u;
#pragma unroll
        for (int bit = 31; bit >= 0; --bit) { const unsigned cand = T | (1u << bit);
            const int cnt = __popcll(__ballot(u0 >= cand)) + __popcll(__ballot(u1 >= cand));
            if (cnt >= 16) T = cand; }
        const unsigned long long g0 = __ballot(u0 > T), g1 = __ballot(u1 > T), e0 = __ballot(u0 == T), e1 = __ballot(u1 == T);
        const int need = 16 - (__popcll(g0) + __popcll(g1));
        const unsigned long long lt = (1ull << lane) - 1ull;
        const bool s0 = (u0 > T) || (u0 == T && __popcll(e0 & lt) < need);
        const bool s1 = (u1 > T) || (u1 == T && __popcll(e0) + __popcll(e1 & lt) < need);
        const unsigned long long m0 = __ballot(s0 && u0 != 0u), m1 = __ballot(s1 && u1 != 0u);
        if (lane == 0) { SEL[tt * 4 + 0] = (unsigned)m0; SEL[tt * 4 + 1] = (unsigned)(m0 >> 32); SEL[tt * 4 + 2] = (unsigned)m1; SEL[tt * 4 + 3] = (unsigned)(m1 >> 32); }
    }
    __syncthreads();
    { m[0] = m[1] = -1e30f; l[0] = l[1] = 0.f;
      KVSrc src{proj + C_KSB + g * 128, proj + C_VSB + g * 128, (size_t)NPROJ, L_SEQ - 1};
      flash_pass<1, 0>(lds, src, 0, curlast + 1, Q, O, m, l, il, trow, tokl0, t0 + tokl0, tid, lane);
#pragma unroll
      for (int rg = 0; rg < 2; ++rg) { const float lr = nb_rowsum(l[rg]); gate[rg] = sigm(small[(size_t)trow[rg] * 256 + 32 + (g * 4 + (fr & 3)) * 3 + 1]); f[rg] = lr > 0.f ? gate[rg] / lr : 0.f; }
      nb_emit(ws, O, f, trow, g, 2, lane); }
    __syncthreads();
}

__device__ __forceinline__ bf16x8 ldfrag_trN(const LAS bf16* img, int stride, int row0, int k0, int fr, int fq) {
    const int a = fr >> 2, p4 = fr & 3;
    const s16x4 v0 = __builtin_amdgcn_ds_read_tr16_b64_v4i16((LAS s16x4*)(img + (k0 + 8 * fq + a) * stride + row0 + 4 * p4));
    const s16x4 v1 = __builtin_amdgcn_ds_read_tr16_b64_v4i16((LAS s16x4*)(img + (k0 + 8 * fq + 4 + a) * stride + row0 + 4 * p4));
    return (bf16x8){v0[0], v0[1], v0[2], v0[3], v1[0], v1[1], v1[2], v1[3]};
}
__device__ __forceinline__ bf16x8 ldfrag_trP(const LAS bf16* img, int stride, int row0, int k0, int fr, int fq) {
    const int a = fr >> 2, p4 = fr & 3;
    const s16x4 v0 = __builtin_amdgcn_ds_read_tr16_b64_v4i16((LAS s16x4*)(img + (k0 + 4 * fq + a) * stride + row0 + 4 * p4));
    const s16x4 v1 = __builtin_amdgcn_ds_read_tr16_b64_v4i16((LAS s16x4*)(img + (k0 + 16 + 4 * fq + a) * stride + row0 + 4 * p4));
    return (bf16x8){v0[0], v0[1], v0[2], v0[3], v1[0], v1[1], v1[2], v1[3]};
}
__device__ __forceinline__ u32x4 pack8(const float (&o)[8]) { u32x4 w; w.x = pg8::cvt_pk_bf16(o[0], o[1]); w.y = pg8::cvt_pk_bf16(o[2], o[3]); w.z = pg8::cvt_pk_bf16(o[4], o[5]); w.w = pg8::cvt_pk_bf16(o[6], o[7]); return w; }
__device__ __forceinline__ void rotary8t(const u32x4 v, const float* rot, int t, int d0, float sc, float (&o)[8]) {
    const f32x4 r0 = *(const f32x4*)(rot + ((size_t)t * 128 + (d0 >> 1)) * 2), r1 = *(const f32x4*)(rot + ((size_t)t * 128 + (d0 >> 1)) * 2 + 4);
    const float x0 = blo(v.x), x1 = bhi(v.x), x2 = blo(v.y), x3 = bhi(v.y), x4 = blo(v.z), x5 = bhi(v.z), x6 = blo(v.w), x7 = bhi(v.w);
    o[0] = (x0 * r0[0] - x1 * r0[1]) * sc; o[1] = (x0 * r0[1] + x1 * r0[0]) * sc; o[2] = (x2 * r0[2] - x3 * r0[3]) * sc; o[3] = (x2 * r0[3] + x3 * r0[2]) * sc;
    o[4] = (x4 * r1[0] - x5 * r1[1]) * sc; o[5] = (x4 * r1[1] + x5 * r1[0]) * sc; o[6] = (x6 * r1[2] - x7 * r1[3]) * sc; o[7] = (x6 * r1[3] + x7 * r1[2]) * sc;
}

constexpr int SA2_XS = 0, SA2_BS = 69632, SA2_ACS = 106496, SA2_DTV = 108544;
__device__ __forceinline__ void ssd_states_unit2(ArgsP A, const LayerP& P, LAS unsigned char* lds, int c, int g, int tid, int lane, int wave) {
    tid = fresh(tid); lane = fresh(lane); wave = fresh_s(wave);
    unsigned char* ws = A->ws;
    const bf16* proj = (const bf16*)(ws + WS_PROJ); const float* small = (const float*)(ws + WS_SMALL);
    LAS bf16* XS = (LAS bf16*)(lds + SA2_XS); LAS bf16* BS = (LAS bf16*)(lds + SA2_BS);
    LAS float* acs = (LAS float*)(lds + SA2_ACS); LAS float* dtv = (LAS float*)(lds + SA2_DTV);
    const int t0 = c * 128;
    { const int l = tid >> 2, hh = tid & 3, h = g * 4 + hh, t = t0 + l;
      const float raw = small[(size_t)t * 256 + h] + P.dt_bias[h];
      const float dt = raw > 20.f ? raw : log1pf(expf(raw));
      const float a = -expf(P.a_log[h]) * dt;
      dtv[l * 4 + hh] = dt; acs[l * 4 + hh] = a;
      ((float*)(ws + WS_DTV))[(size_t)t * 32 + h] = dt; }
    __syncthreads();
    if (wave < 4) {
        const int hh = wave; const float v0 = acs[(2 * lane) * 4 + hh], v1 = acs[(2 * lane + 1) * 4 + hh]; float s = v0 + v1;
#pragma unroll
        for (int d = 1; d < 64; d <<= 1) { const float t = __shfl_up(s, d); if (lane >= d) s += t; }
        const float ex = s - (v0 + v1);
        acs[(2 * lane) * 4 + hh] = ex + v0; acs[(2 * lane + 1) * 4 + hh] = ex + v0 + v1;
    }
    __syncthreads();
    { const int l = tid >> 2, hh = tid & 3; ((float*)(ws + WS_ACS))[(size_t)(t0 + l) * 32 + g * 4 + hh] = acs[l * 4 + hh];
      if (tid < 4) ((float*)(ws + WS_CD))[c * 32 + g * 4 + tid] = __expf(acs[127 * 4 + tid]); }
#pragma unroll 4
    for (int item = fresh(tid); item < 48 * 128; item += 512) {
        const int l = item / 48, v = item % 48, t = t0 + l; float o[8];
        const bool isx = v < 32; const int hh = isx ? (v >> 3) : 0, n0 = (v - 32) * 8;
        const int col0 = isx ? C_XA + g * 256 + v * 8 : C_BA + g * 128 + n0, cch0 = isx ? g * 256 + v * 8 : 2048 + g * 128 + n0;
        conv8(proj, t, col0, P.conv_w, P.conv_b, cch0, o);
        const float sc = isx ? dtv[l * 4 + hh] * __expf(acs[127 * 4 + hh] - acs[l * 4 + hh]) : 1.0f;
#pragma unroll
        for (int i = 0; i < 8; ++i) o[i] *= sc;
        *(LAS u32x4*)(isx ? XS + l * 272 + v * 8 : BS + l * 144 + n0) = pack8(o);
    }
    __syncthreads();
    { f32x4 acc[2][8];
#pragma unroll
      for (int a = 0; a < 2; ++a)
#pragma unroll
          for (int b = 0; b < 8; ++b) acc[a][b] = (f32x4){0.f, 0.f, 0.f, 0.f};
      const int fr = lane & 15, fq = lane >> 4;
#pragma unroll
      for (int ks = 0; ks < 4; ++ks) {
          bf16x8 xf[2];
#pragma unroll
          for (int a = 0; a < 2; ++a) xf[a] = ldfrag_trP(XS, 272, wave * 32 + a * 16, ks * 32, fr, fq);
#pragma unroll
          for (int b = 0; b < 8; ++b) { const bf16x8 yf = ldfrag_trP(BS, 144, b * 16, ks * 32, fr, fq);
#pragma unroll
              for (int a = 0; a < 2; ++a) acc[a][b] = mma16(xf[a], yf, acc[a][b]); }
      }
      const int hh = wave >> 1, h = g * 4 + hh;
      float* st = (float*)(ws + WS_ST) + ((size_t)(c * 32 + h) * 64) * 128;
#pragma unroll
      for (int a = 0; a < 2; ++a)
#pragma unroll
          for (int b = 0; b < 8; ++b)
#pragma unroll
              for (int r = 0; r < 4; ++r) { const int p = (wave & 1) * 32 + a * 16 + fq * 4 + r, n = b * 16 + fr; st[(size_t)p * 128 + n] = acc[a][b][r]; }
    }
    __syncthreads();
}

constexpr int SC2_CM = 0, SC2_BM = 34816, SC2_MH = 69632, SC2_XS = 104448, SC2_PV = 122880, SC2_ACS = 140288, SC2_DTV = 142336;
__device__ __forceinline__ void ssd_out_unit2(ArgsP A, const LayerP& P, float* rowss, LAS unsigned char* lds, int c, int g, int tid, int lane, int wave) {
    tid = fresh(tid); lane = fresh(lane); wave = fresh_s(wave);
    unsigned char* ws = A->ws;
    const bf16* proj = (const bf16*)(ws + WS_PROJ);
    LAS bf16* CM = (LAS bf16*)(lds + SC2_CM); LAS bf16* BM = (LAS bf16*)(lds + SC2_BM); LAS bf16* MH = (LAS bf16*)(lds + SC2_MH);
    LAS bf16* XS = (LAS bf16*)(lds + SC2_XS); LAS bf16* PV = (LAS bf16*)(lds + SC2_PV);
    LAS float* acs = (LAS float*)(lds + SC2_ACS); LAS float* dtv = (LAS float*)(lds + SC2_DTV);
    const int t0 = c * 128, fr = lane & 15, fq = lane >> 4;
    { const int l = tid >> 2, hh = tid & 3; acs[l * 4 + hh] = ((const float*)(ws + WS_ACS))[(size_t)(t0 + l) * 32 + g * 4 + hh]; dtv[l * 4 + hh] = ((const float*)(ws + WS_DTV))[(size_t)(t0 + l) * 32 + g * 4 + hh]; }
#pragma unroll 4
    for (int item = fresh(tid); item < 32 * 128; item += 512) {
        const int l = item >> 5, v = item & 31, t = t0 + l; float o[8];
        const int n0 = (v & 15) * 8, ch = g * 128 + n0;
        conv8(proj, t, (v < 16 ? C_BA : C_CA) + ch, P.conv_w, P.conv_b, (v < 16 ? 2048 : 3072) + ch, o);
        *(LAS u32x4*)((v < 16 ? BM : CM) + l * 136 + n0) = pack8(o);
    }
    __syncthreads();
    f32x4 cb[8];
#pragma unroll
    for (int b = 0; b < 8; ++b) cb[b] = (f32x4){0.f, 0.f, 0.f, 0.f};
#pragma unroll
    for (int ks = 0; ks < 4; ++ks) { const bf16x8 xf = ldfrag(CM, 136, wave * 16 + fr, ks * 32 + fq * 8);
#pragma unroll
        for (int b = 0; b < 8; ++b) cb[b] = mma16(xf, ldfrag(BM, 136, b * 16 + fr, ks * 32 + fq * 8), cb[b]); }
    float ssq[4] = {0.f, 0.f, 0.f, 0.f};
    for (int hh = 0; hh < 4; ++hh) {
        const int h = g * 4 + hh;
#pragma unroll 2
        for (int item = fresh(tid); item < 8 * 128; item += 512) { const int l = item >> 3, v = item & 7, ch = h * 64 + v * 8; float o[8];
            conv8(proj, t0 + l, C_XA + ch, P.conv_w, P.conv_b, ch, o);
            *(LAS u32x4*)(XS + l * 72 + v * 8) = pack8(o); }
        { const float* st = (const float*)(ws + WS_ST) + ((size_t)(c * 32 + h) * 64) * 128;
#pragma unroll 2
          for (int item = fresh(tid); item < 64 * 16; item += 512) { const int p = item >> 4, n0 = (item & 15) * 8;
              const f32x4 a = *(const f32x4*)(st + p * 128 + n0), b = *(const f32x4*)(st + p * 128 + n0 + 4);
              u32x4 w; w.x = pg8::cvt_pk_bf16(a[0], a[1]); w.y = pg8::cvt_pk_bf16(a[2], a[3]); w.z = pg8::cvt_pk_bf16(b[0], b[1]); w.w = pg8::cvt_pk_bf16(b[2], b[3]);
              *(LAS u32x4*)(PV + p * 136 + n0) = w; } }
#pragma unroll
        for (int b = 0; b < 8; ++b)
#pragma unroll
            for (int r = 0; r < 4; ++r) { const int l = wave * 16 + fq * 4 + r, s = b * 16 + fr;
                const float v = (s <= l) ? cb[b][r] * __expf(acs[l * 4 + hh] - acs[s * 4 + hh]) * dtv[s * 4 + hh] : 0.f;
                MH[l * 136 + s] = (bf16)f2bf(v); }
        unsigned short zr[4][4];
#pragma unroll
        for (int r = 0; r < 4; ++r)
#pragma unroll
            for (int b = 0; b < 4; ++b) zr[r][b] = proj[(size_t)(t0 + wave * 16 + fq * 4 + r) * NPROJ + C_ZA + h * 64 + b * 16 + fr];
        __syncthreads();
        f32x4 yd[4], yo[4];
#pragma unroll
        for (int b = 0; b < 4; ++b) { yd[b] = (f32x4){0.f, 0.f, 0.f, 0.f}; yo[b] = (f32x4){0.f, 0.f, 0.f, 0.f}; }
#pragma unroll
        for (int ks = 0; ks < 4; ++ks) { const bf16x8 mf = ldfrag(MH, 136, wave * 16 + fr, ks * 32 + fq * 8), cf = ldfrag(CM, 136, wave * 16 + fr, ks * 32 + fq * 8);
#pragma unroll
            for (int b = 0; b < 4; ++b) { yd[b] = mma16(mf, ldfrag_trN(XS, 72, b * 16, ks * 32, fr, fq), yd[b]); yo[b] = mma16(cf, ldfrag(PV, 136, b * 16 + fr, ks * 32 + fq * 8), yo[b]); } }
        const float dsk = P.d_skip[h];
#pragma unroll
        for (int r = 0; r < 4; ++r) { const int l = wave * 16 + fq * 4 + r, t = t0 + l; const float ea = __expf(acs[l * 4 + hh]);
#pragma unroll
            for (int b = 0; b < 4; ++b) { const int p = b * 16 + fr, ch = h * 64 + p;
                const float xs = bf2f(XS[l * 72 + p]);
                const float y = yd[b][r] + yo[b][r] * ea + xs * dsk;
                const float z = bf2f(zr[r][b]);
                const float yg = y * siluf(z);
                ssq[r] += yg * yg;
                ((bf16*)(ws + WS_YA))[(size_t)t * DM + ch] = (bf16)f2bf(yg * P.ssm_norm[ch]); } }
        __syncthreads();
    }
#pragma unroll
    for (int r = 0; r < 4; ++r) { float s = ssq[r]; s += __shfl_xor(s, 1); s += __shfl_xor(s, 2); s += __shfl_xor(s, 4); s += __shfl_xor(s, 8);
        if (fr == 0) atomicAdd(rowss + t0 + wave * 16 + fq * 4 + r, s); }
}

constexpr int RA2_VS = 0, RA2_KS = 69632;
__device__ __forceinline__ void ret_kv_unit2(ArgsP A, LAS unsigned char* lds, int c, int h, int tid, int lane, int wave) {
    tid = fresh(tid); lane = fresh(lane); wave = fresh_s(wave);
    unsigned char* ws = A->ws; const bf16* proj = (const bf16*)(ws + WS_PROJ); const float* rot = (const float*)(ws + WS_ROT);
    LAS bf16* VS = (LAS bf16*)(lds + RA2_VS); LAS bf16* KS = (LAS bf16*)(lds + RA2_KS);
    const int t0 = c * 128; const float lg = ret_logg(h);
#pragma unroll 4
    for (int item = fresh(tid); item < 32 * 128; item += 512) { const int j = item >> 5, v = item & 31;
        *(LAS u32x4*)(VS + j * 272 + v * 8) = *(const u32x4*)(proj + (size_t)(t0 + j) * NPROJ + C_VC + h * 256 + v * 8); }
#pragma unroll 4
    for (int item = fresh(tid); item < 32 * 128; item += 512) { const int j = item >> 5, d0 = (item & 31) * 8, t = t0 + j; float o[8];
        const u32x4 w = *(const u32x4*)(proj + (size_t)t * NPROJ + C_KC + h * 256 + d0);
        rotary8t(w, rot, t, d0, 0.0625f * __expf(lg * (float)(127 - j)), o);
        *(LAS u32x4*)(KS + j * 272 + d0) = pack8(o); }
    __syncthreads();
    const int fr = lane & 15, fq = lane >> 4;
    float* out = (float*)(ws + WS_KVT) + (size_t)(c * 8 + h) * 65536;
    for (int half = 0; half < 2; ++half) {
        f32x4 acc[2][8];
#pragma unroll
        for (int a = 0; a < 2; ++a)
#pragma unroll
            for (int b = 0; b < 8; ++b) acc[a][b] = (f32x4){0.f, 0.f, 0.f, 0.f};
#pragma unroll
        for (int ks = 0; ks < 4; ++ks) { bf16x8 xf[2];
#pragma unroll
            for (int a = 0; a < 2; ++a) xf[a] = ldfrag_trP(VS, 272, wave * 32 + a * 16, ks * 32, fr, fq);
#pragma unroll
            for (int b = 0; b < 8; ++b) { const bf16x8 yf = ldfrag_trP(KS, 272, half * 128 + b * 16, ks * 32, fr, fq);
#pragma unroll
                for (int a = 0; a < 2; ++a) acc[a][b] = mma16(xf[a], yf, acc[a][b]); } }
#pragma unroll
        for (int a = 0; a < 2; ++a)
#pragma unroll
            for (int b = 0; b < 8; ++b)
#pragma unroll
                for (int r = 0; r < 4; ++r) { const int e = wave * 32 + a * 16 + fq * 4 + r, d = half * 128 + b * 16 + fr; out[(size_t)e * 256 + d] = acc[a][b][r]; }
    }
    __syncthreads();
}

constexpr int RC2_Q = 0, RC2_K = 67584, RC2_S = 67584, RC2_VS = 102400, RC2_RT = 67584;
__device__ __forceinline__ void ret_out_unit2(ArgsP A, const LayerP& P, LAS unsigned char* lds, int c, int h, int tid, int lane, int wave) {
    tid = fresh(tid); lane = fresh(lane); wave = fresh_s(wave);
    unsigned char* ws = A->ws; const bf16* proj = (const bf16*)(ws + WS_PROJ); const float* rot = (const float*)(ws + WS_ROT);
    LAS bf16* Q = (LAS bf16*)(lds + RC2_Q); LAS bf16* K = (LAS bf16*)(lds + RC2_K); LAS bf16* S = (LAS bf16*)(lds + RC2_S);
    LAS bf16* VS = (LAS bf16*)(lds + RC2_VS); LAS bf16* RT = (LAS bf16*)(lds + RC2_RT);
    const int t0 = c * 128, fr = lane & 15, fq = lane >> 4; const float lg = ret_logg(h);
#pragma unroll 8
    for (int item = fresh(tid); item < 64 * 128; item += 512) { const int j = item >> 6, v = item & 63, t = t0 + j, d0 = (v & 31) * 8; float o[8];
        const u32x4 w = *(const u32x4*)(proj + (size_t)t * NPROJ + (v < 32 ? C_QC : C_KC) + h * 256 + d0);
        rotary8t(w, rot, t, d0, v < 32 ? 1.0f : 0.0625f, o);
        *(LAS u32x4*)((v < 32 ? Q : K) + j * 264 + d0) = pack8(o); }
    __syncthreads();
    f32x4 sc[8];
#pragma unroll
    for (int b = 0; b < 8; ++b) sc[b] = (f32x4){0.f, 0.f, 0.f, 0.f};
#pragma unroll
    for (int ks = 0; ks < 8; ++ks) { const bf16x8 xf = ldfrag(Q, 264, wave * 16 + fr, ks * 32 + fq * 8);
#pragma unroll
        for (int b = 0; b < 8; ++b) sc[b] = mma16(xf, ldfrag(K, 264, b * 16 + fr, ks * 32 + fq * 8), sc[b]); }
    __syncthreads();
#pragma unroll
    for (int b = 0; b < 8; ++b)
#pragma unroll
        for (int r = 0; r < 4; ++r) { const int i = wave * 16 + fq * 4 + r, j = b * 16 + fr;
            S[i * 136 + j] = (bf16)f2bf(i >= j ? sc[b][r] * __expf(lg * (float)(i - j)) : 0.f); }
    f32x4 o[16];
#pragma unroll
    for (int b = 0; b < 16; ++b) o[b] = (f32x4){0.f, 0.f, 0.f, 0.f};
#pragma unroll
    for (int eh = 0; eh < 2; ++eh) {
#pragma unroll 4
        for (int item = fresh(tid); item < 16 * 128; item += 512) { const int j = item >> 4, v = item & 15;
            *(LAS u32x4*)(VS + j * 136 + v * 8) = *(const u32x4*)(proj + (size_t)(t0 + j) * NPROJ + C_VC + h * 256 + eh * 128 + v * 8); }
        __syncthreads();
#pragma unroll
        for (int ks = 0; ks < 4; ++ks) { const bf16x8 xf = ldfrag(S, 136, wave * 16 + fr, ks * 32 + fq * 8);
#pragma unroll
            for (int b = 0; b < 8; ++b) o[eh * 8 + b] = mma16(xf, ldfrag_trN(VS, 136, b * 16, ks * 32, fr, fq), o[eh * 8 + b]); }
        __syncthreads();
    }
    const float* kvt = (const float*)(ws + WS_KVT) + (size_t)(c * 8 + h) * 65536;
    float xi[4];
#pragma unroll
    for (int r = 0; r < 4; ++r) xi[r] = __expf(lg * (float)(wave * 16 + fq * 4 + r + 1));
#pragma unroll
    for (int eq = 0; eq < 4; ++eq) {
#pragma unroll 4
        for (int item = fresh(tid); item < 64 * 32; item += 512) { const int e = item >> 5, d0 = (item & 31) * 8;
            const f32x4 a = *(const f32x4*)(kvt + (size_t)(eq * 64 + e) * 256 + d0), b = *(const f32x4*)(kvt + (size_t)(eq * 64 + e) * 256 + d0 + 4);
            u32x4 w; w.x = pg8::cvt_pk_bf16(a[0], a[1]); w.y = pg8::cvt_pk_bf16(a[2], a[3]); w.z = pg8::cvt_pk_bf16(b[0], b[1]); w.w = pg8::cvt_pk_bf16(b[2], b[3]);
            *(LAS u32x4*)(RT + e * 264 + d0) = w; }
        __syncthreads();
        f32x4 cr[4];
#pragma unroll
        for (int b = 0; b < 4; ++b) cr[b] = (f32x4){0.f, 0.f, 0.f, 0.f};
#pragma unroll
        for (int ks = 0; ks < 8; ++ks) { const bf16x8 xf = ldfrag(Q, 264, wave * 16 + fr, ks * 32 + fq * 8);
#pragma unroll
            for (int b = 0; b < 4; ++b) cr[b] = mma16(xf, ldfrag(RT, 264, b * 16 + fr, ks * 32 + fq * 8), cr[b]); }
#pragma unroll
        for (int b = 0; b < 4; ++b)
#pragma unroll
            for (int r = 0; r < 4; ++r) o[eq * 4 + b][r] += cr[b][r] * xi[r];
        __syncthreads();
    }
#pragma unroll
    for (int r = 0; r < 4; ++r) {
        float s = 0.f;
#pragma unroll
        for (int b = 0; b < 16; ++b) s += o[b][r];
        s += __shfl_xor(s, 1); s += __shfl_xor(s, 2); s += __shfl_xor(s, 4); s += __shfl_xor(s, 8);
        const float mu = s * (1.0f / 256.0f); float q = 0.f;
#pragma unroll
        for (int b = 0; b < 16; ++b) { const float d = o[b][r] - mu; q += d * d; }
        q += __shfl_xor(q, 1); q += __shfl_xor(q, 2); q += __shfl_xor(q, 4); q += __shfl_xor(q, 8);
        const float rs = rsqrtf(q * (1.0f / 256.0f) + EPS);
        const int t = t0 + wave * 16 + fq * 4 + r;
#pragma unroll
        for (int hb = 0; hb < 16; hb += 8) {
            unsigned short zv[8]; float nw[8];
#pragma unroll
            for (int b = 0; b < 8; ++b) { const int ch = h * 256 + (hb + b) * 16 + fr; zv[b] = proj[(size_t)t * NPROJ + C_ZC + ch]; nw[b] = P.ret_norm[ch]; }
#pragma unroll
            for (int b = 0; b < 8; ++b) { const int ch = h * 256 + (hb + b) * 16 + fr;
                ((bf16*)(ws + WS_YC))[(size_t)t * DM + ch] = (bf16)f2bf((o[hb + b][r] - mu) * rs * nw[b] * siluf(bf2f(zv[b]))); } }
    }
    __syncthreads();
}

__device__ __forceinline__ void norm_pass1(const float* xin, const float* o, const float* rowss, const float* gain, float* x1, bf16* h2, int gw, int NGW, int lane) {
    for (int m = gw; m < L_SEQ; m += NGW) {
        const float rs = rsqrtf(rowss[m] * (1.0f / 2048.0f) + EPS); f32x4 v[8]; float s = 0.f;
#pragma unroll
        for (int j = 0; j < 8; ++j) { const size_t off = (size_t)m * DM + 4 * lane + 256 * j; const f32x4 xo = *(const f32x4*)(xin + off), oo = *(const f32x4*)(o + off), g = *(const f32x4*)(gain + 4 * lane + 256 * j);
            v[j] = xo + oo * rs * g; *(f32x4*)(x1 + off) = v[j]; s += (v[j][0] * v[j][0] + v[j][1] * v[j][1]) + (v[j][2] * v[j][2] + v[j][3] * v[j][3]); }
        const float r2 = rsqrtf(wave_sum(s) * (1.0f / 2048.0f) + EPS);
#pragma unroll
        for (int j = 0; j < 8; ++j) { u32x2 w; w.x = pk2(v[j][0] * r2, v[j][1] * r2); w.y = pk2(v[j][2] * r2, v[j][3] * r2); *(u32x2*)(h2 + (size_t)m * DM + 4 * lane + 256 * j) = w; }
    }
}
__device__ __forceinline__ void norm_pass2(const float* x1, const float* vv, const float* rowss, const float* gain, float* xout, bf16* hn, const float* gain_next, int gw, int NGW, int lane) {
    for (int m = gw; m < L_SEQ; m += NGW) {
        const float rs = rsqrtf(rowss[m] * (1.0f / 2048.0f) + EPS); f32x4 v[8]; float s = 0.f;
#pragma unroll
        for (int j = 0; j < 8; ++j) { const size_t off = (size_t)m * DM + 4 * lane + 256 * j; const f32x4 xo = *(const f32x4*)(x1 + off), oo = *(const f32x4*)(vv + off), g = *(const f32x4*)(gain + 4 * lane + 256 * j);
            v[j] = xo + oo * rs * g; *(f32x4*)(xout + off) = v[j]; s += (v[j][0] * v[j][0] + v[j][1] * v[j][1]) + (v[j][2] * v[j][2] + v[j][3] * v[j][3]); }
        if (hn) { const float r2 = rsqrtf(wave_sum(s) * (1.0f / 2048.0f) + EPS);
#pragma unroll
            for (int j = 0; j < 8; ++j) { const f32x4 g = *(const f32x4*)(gain_next + 4 * lane + 256 * j);
                u32x2 w; w.x = pk2(v[j][0] * r2 * g[0], v[j][1] * r2 * g[1]); w.y = pk2(v[j][2] * r2 * g[2], v[j][3] * r2 * g[3]); *(u32x2*)(hn + (size_t)m * DM + 4 * lane + 256 * j) = w; } }
    }
}

#ifndef PHMASK
#define PHMASK 0xFFFF
#endif
#define PHEN(k) ((PHMASK >> (k)) & 1)
#ifndef REP_PHASE
#define REP_PHASE -1
#endif
#define REP(k) ((REP_PHASE == (k)) ? 2 : 1)
#define JUNKSS ((float*)(ws + 768 * 1024))
#ifndef SUBMASK
#define SUBMASK 0xFFFF
#endif
#define SUBEN(k) ((SUBMASK >> (k)) & 1)
constexpr int PH_PER_LAYER = 10, N_PHASES = 1 + NLAYER * PH_PER_LAYER;
__global__ void __launch_bounds__(512, 2) hyb_fwd(Args Aval) {
    extern __shared__ __attribute__((aligned(16))) unsigned char lds_raw[];
    LAS unsigned char* lds = (LAS unsigned char*)lds_raw;
    const int wave = __builtin_amdgcn_readfirstlane((int)threadIdx.x >> 6);
    const int G = gridDim.x, bid = blockIdx.x;
    { const int tid0 = threadIdx.x;
      for (int u = tid0; u < 128; u += 512) ((LAS unsigned*)(lds + MISC_OFF))[u] = 0u;
      if (tid0 < 128) ((LAS float*)(lds + MISC_OFF + 512))[tid0] = (float)exp2(-(double)(2 * tid0) * (13.287712379549449 / 256.0)); }
#define lane ((int)__builtin_amdgcn_mbcnt_hi(~0u, __builtin_amdgcn_mbcnt_lo(~0u, 0u)))
#define tid (wave * 64 + lane)
    __syncthreads();
    int lo, hi, use_bar; XcdBarrier bar;
    { ArgsP A = argp(); lo = A->ph_lo; hi = A->ph_hi; use_bar = A->use_bar;
      bar.bar = (unsigned*)(A->ws + WS_CTL) + CW_BAR; bar.x = 0; bar.st = (volatile LAS unsigned*)(lds + MISC_OFF) + 8;
      if (use_bar) bar = xcd_barrier_post((unsigned*)(A->ws + WS_CTL) + CW_BAR, (volatile LAS unsigned*)(lds + MISC_OFF) + 8); }
#define IN(k) (lo <= (k) && (k) < hi)
#define SEAM(k) do { if (use_bar && IN(k) && IN((k) + 1)) xcd_barrier(bar); } while (0)
#define LAYERP(P) LayerP P; P.conv_w = A->in[5] + (size_t)l * 4 * 4096; P.conv_b = A->in[6] + (size_t)l * 4096; P.dt_bias = A->in[7] + l * 32; P.a_log = A->in[8] + l * 32; P.d_skip = A->in[9] + l * 32; \
        P.ssm_norm = A->in[10] + l * 2048; P.ret_norm = A->in[14] + l * 2048
#define ROWSS(k) ((float*)(ws + ROWSS_OFF) + (l * 3 + (k)) * L_SEQ)

    if (PHEN(0) && IN(0)) for (int rep = 0; rep < REP(0); ++rep) { ArgsP A = argp(); phase_prologue(A, lds, fresh(tid), fresh(lane), fresh_s(wave), G, bid); }
    SEAM(0);

    for (int l = 0; l < NLAYER; ++l) {
        const int pb = 1 + l * PH_PER_LAYER;
        if (PHEN(1) && IN(pb + 0)) for (int rep = 0; rep < REP(1); ++rep) { ArgsP A = argp(); unsigned char* ws = A->ws;
            pg8::Gemm g{(const bf16*)(ws + WS_HBF), (const bf16*)(ws + WS_WIN + (size_t)l * SZ_WIN), L_SEQ, NPAD, DM}; pg8::StaticOrder S; S.init(L_SEQ, NPAD, G, bid);
            pg8::EpiInProj E{(bf16*)(ws + WS_PROJ), NPROJ, (float*)(ws + WS_SMALL), NPROJ / 256};
            pg8::gemm_phase<pg8::EpiInProj, pg8::StaticOrder, true, true>(lds, g, S, E, wave);
        }
        SEAM(pb + 0);
        if (PHEN(2) && IN(pb + 1)) for (int rep = 0; rep < REP(2); ++rep) {
            if (SUBEN(1)) { ArgsP A = argp(); LAYERP(P);
              for (int u = bid; u < 512; u += G) ssd_states_unit2(A, P, lds, u >> 3, u & 7, tid, lane, wave); }
            if (SUBEN(2)) { ArgsP A = argp();
              for (int u = bid; u < 512; u += G) ret_kv_unit2(A, lds, u >> 3, u & 7, tid, lane, wave); }
            if (SUBEN(3)) { ArgsP A = argp(); nsa_im2col(A, fresh(tid), bid, G);
              if (l == 0 && bid == G - 1) { unsigned char* ws = A->ws;
                  for (int o = fresh(tid); o < 1024; o += 512) { const float* pp = (const float*)(ws + WS_HBP) + (size_t)(o >> 8) * 64 * 256 + (o & 255); float s = 0.f;
                      for (int ck = 0; ck < 64; ++ck) s += pp[ck * 256];
                      ((float*)(ws + WS_HB))[o] = s; } } }
        }
        SEAM(pb + 1);
        if (PHEN(3) && IN(pb + 2)) {
            for (int rep = 0; rep < REP(3); ++rep)
#pragma unroll
            for (int s = 0; s < 2; ++s) { ArgsP A = argp(); unsigned char* ws = A->ws;
                pg8::Gemm g{(const bf16*)(ws + WS_AIM + (size_t)s * 16 * MiB), (const bf16*)(ws + WS_WC1 + (size_t)(l * 2 + s) * 2 * MiB), 2048, 256, 4096}; pg8::StaticOrder S; S.init(2048, 256, G, (bid + G - 8 * s) % G);
                pg8::EpiCmp1 E{(bf16*)(ws + WS_HID + (size_t)s * MiB), (const float*)(ws + WS_HB) + (l * 2 + s) * 256};
                pg8::gemm_phase<pg8::EpiCmp1, pg8::StaticOrder, true, true>(lds, g, S, E, wave);
                __syncthreads();
            }
            if (bid >= 16) { ArgsP A = argp(); ssd_scan(A, fresh(tid), bid - 16, G - 16); ret_scan(A, fresh(tid), bid - 16, G - 16); }
        }
        SEAM(pb + 2);
        if (PHEN(4) && IN(pb + 3)) for (int rep = 0; rep < REP(4); ++rep) {
#pragma unroll
            for (int s = 0; s < 2; ++s) { ArgsP A = argp(); unsigned char* ws = A->ws;
                pg8::Gemm g{(const bf16*)(ws + WS_HID + (size_t)s * MiB), (const bf16*)(ws + WS_WC2 + (size_t)(l * 2 + s) * 131072), 2048, 256, 256}; pg8::StaticOrder S; S.init(2048, 256, G, (bid + G - 8 * s) % G);
                pg8::EpiCmp2 E{(bf16*)(ws + WS_KVC + (size_t)s * 524288)};
                pg8::gemm_phase<pg8::EpiCmp2, pg8::StaticOrder, true, true>(lds, g, S, E, wave);
                __syncthreads();
            }
            if (SUBEN(5)) { ArgsP A = argp(); unsigned char* ws = A->ws; LAYERP(P);
              for (int u = bid; u < 512; u += G) ssd_out_unit2(A, P, rep ? JUNKSS : ROWSS(0), lds, u >> 3, u & 7, tid, lane, wave); }
            if (SUBEN(6)) { ArgsP A = argp(); LAYERP(P);
              for (int u = bid; u < 512; u += G) ret_out_unit2(A, P, lds, u >> 3, u & 7, tid, lane, wave); }
        }
        SEAM(pb + 3);
        if (PHEN(5) && IN(pb + 4)) for (int rep = 0; rep < REP(5); ++rep) { ArgsP A = argp();
            for (int u = bid; u < 512; u += G) { const int idx = u >> 2, g = u & 3; const int qt = idx < 64 ? idx : 191 - idx;
                nsa_attn2_unit(A, lds, qt, g, tid, lane, wave); }
        }
        SEAM(pb + 4);
        if (PHEN(6) && IN(pb + 5)) for (int rep = 0; rep < REP(6); ++rep) {
            { ArgsP A = argp(); unsigned char* ws = A->ws;
              pg8::Gemm g{(const bf16*)(ws + WS_YA), (const bf16*)(ws + WS_WBR + (size_t)(l * 3 + 0) * 8 * MiB), L_SEQ, DM, DM}; pg8::StaticOrder S; S.init(L_SEQ, DM, G, bid);
              pg8::EpiBranch<0> E{(bf16*)(ws + WS_TF), (bf16*)(ws + WS_MB), (const bf16*)(ws + WS_PROJ) + C_GM, NPROJ, ROWSS(0), EPS};
              pg8::gemm_phase<pg8::EpiBranch<0>, pg8::StaticOrder, true, true>(lds, g, S, E, wave); }
            __syncthreads();
            { ArgsP A = argp(); unsigned char* ws = A->ws;
              pg8::Gemm g{(const bf16*)(ws + WS_YB), (const bf16*)(ws + WS_WBR + (size_t)(l * 3 + 1) * 8 * MiB), L_SEQ, DM, DM}; pg8::StaticOrder S; S.init(L_SEQ, DM, G, bid);
              pg8::EpiBranch<1> E{(bf16*)(ws + WS_TF), (bf16*)(ws + WS_MB), (const bf16*)(ws + WS_PROJ) + C_GM + 2048, NPROJ, ROWSS(0), EPS};
              pg8::gemm_phase<pg8::EpiBranch<1>, pg8::StaticOrder, true, true>(lds, g, S, E, wave); }
            __syncthreads();
            { ArgsP A = argp(); unsigned char* ws = A->ws;
              pg8::Gemm g{(const bf16*)(ws + WS_YC), (const bf16*)(ws + WS_WBR + (size_t)(l * 3 + 2) * 8 * MiB), L_SEQ, DM, DM}; pg8::StaticOrder S; S.init(L_SEQ, DM, G, bid);
              pg8::EpiBranch<2> E{(bf16*)(ws + WS_TF), (bf16*)(ws + WS_MB), (const bf16*)(ws + WS_PROJ) + C_GM + 4096, NPROJ, ROWSS(0), EPS};
              pg8::gemm_phase<pg8::EpiBranch<2>, pg8::StaticOrder, true, true>(lds, g, S, E, wave); }
        }
        SEAM(pb + 5);
        if (PHEN(7) && IN(pb + 6)) for (int rep = 0; rep < REP(7); ++rep) { ArgsP A = argp(); unsigned char* ws = A->ws;
            pg8::Gemm g{(const bf16*)(ws + WS_MB), (const bf16*)(ws + WS_WOUT + (size_t)l * 8 * MiB), L_SEQ, DM, DM}; pg8::StaticOrder S; S.init(L_SEQ, DM, G, bid);
            pg8::EpiRowSS<0> E{(float*)(ws + WS_TF), nullptr, rep ? JUNKSS : ROWSS(1)};
            pg8::gemm_phase<pg8::EpiRowSS<0>, pg8::StaticOrder, true, true>(lds, g, S, E, wave);
        }
        SEAM(pb + 6);
        if (PHEN(8) && IN(pb + 7)) for (int rep = 0; rep < REP(8); ++rep) {
            if (SUBEN(0)) { ArgsP A = argp(); unsigned char* ws = A->ws;
              pg8::Gemm g{(const bf16*)(ws + WS_PBF) + (size_t)l * L_SEQ * PDIM, (const bf16*)(ws + WS_WPP + (size_t)l * MiB), L_SEQ, DM, fresh_s(PDIM)}; pg8::StaticOrder S; S.init(L_SEQ, DM, G, bid);
              pg8::EpiF32 E{(float*)(ws + WS_EBUF), DM};
              pg8::gemm_phase<pg8::EpiF32, pg8::StaticOrder, true, true>(lds, g, S, E, wave); }
            __syncthreads();
          { ArgsP A = argp(); unsigned char* ws = A->ws;
            norm_pass1(l == 0 ? A->in[0] : (const float*)(ws + WS_XL), (const float*)(ws + WS_TF), ROWSS(1), A->in[3] + l * 2048, (float*)(ws + WS_X1), (bf16*)(ws + WS_HBF), bid * 8 + fresh_s(wave), G * 8, fresh(lane)); } }
        SEAM(pb + 7);
        if (PHEN(9) && IN(pb + 8)) for (int rep = 0; rep < REP(7); ++rep) { ArgsP A = argp(); unsigned char* ws = A->ws;
            pg8::Gemm g{(const bf16*)(ws + WS_HBF), (const bf16*)(ws + WS_WGATE + (size_t)l * 8 * MiB), L_SEQ, DM, DM}; pg8::StaticOrder S; S.init(L_SEQ, DM, G, bid);
            pg8::EpiRowSS<1> E{(float*)(ws + WS_TF), (const float*)(ws + WS_EBUF), rep ? JUNKSS : ROWSS(2)};
            pg8::gemm_phase<pg8::EpiRowSS<1>, pg8::StaticOrder, true, true>(lds, g, S, E, wave);
        }
        SEAM(pb + 8);
        if (PHEN(10) && IN(pb + 9)) for (int rep = 0; rep < REP(8); ++rep) { ArgsP A = argp(); unsigned char* ws = A->ws;
            norm_pass2((const float*)(ws + WS_X1), (const float*)(ws + WS_TF), ROWSS(2), A->in[19] + l * 2048, l == NLAYER - 1 ? A->out : (float*)(ws + WS_XL),
                       l + 1 < NLAYER ? (bf16*)(ws + WS_HBF) : nullptr, l + 1 < NLAYER ? A->in[2] + (l + 1) * 2048 : nullptr, bid * 8 + fresh_s(wave), G * 8, fresh(lane)); }
        SEAM(pb + 9);
    }
#undef IN
#undef SEAM
#undef lane
#undef tid
}

#ifndef MK_ONE_LAUNCH
#define MK_ONE_LAUNCH 1
#endif
extern "C" void kernel_launch(void* const* d_in, const int* in_sizes, int n_in, void* d_out, int out_size, void* d_ws, size_t ws_size, hipStream_t stream) {
    static int grid = 0;
    if (grid == 0) {
        if (n_in != 20 || out_size != L_SEQ * DM || ws_size < WS_END) { fprintf(stderr, "kernel_launch: unexpected shapes (n_in %d, out %d, ws %zu < %zu)\n", n_in, out_size, ws_size, (size_t)WS_END); grid = -1; return; }
        int dev = 0, cus = 0, per_cu = 0;
        if (hipGetDevice(&dev) != hipSuccess || hipDeviceGetAttribute(&cus, hipDeviceAttributeMultiprocessorCount, dev) != hipSuccess) { grid = -1; return; }
        if (hipFuncSetAttribute((const void*)hyb_fwd, hipFuncAttributeMaxDynamicSharedMemorySize, LDS_BYTES) != hipSuccess) { fprintf(stderr, "kernel_launch: hipFuncSetAttribute failed\n"); grid = -1; return; }
        if (hipOccupancyMaxActiveBlocksPerMultiprocessor(&per_cu, (const void*)hyb_fwd, 512, LDS_BYTES) != hipSuccess || per_cu < 1) { fprintf(stderr, "kernel_launch: occupancy query says %d\n", per_cu); (void)hipGetLastError(); grid = -1; return; }
        grid = cus;
    }
    if (grid < 0) return;
    if (hipMemsetAsync((char*)d_ws + WS_CTL, 0, CTL_ZERO_BYTES, stream) != hipSuccess) return;
    Args a{};
    for (int i = 0; i < 20; ++i) a.in[i] = (const float*)d_in[i];
    a.out = (float*)d_out; a.ws = (unsigned char*)d_ws; a.pad = 0;
#if MK_ONE_LAUNCH
    a.ph_lo = 0; a.ph_hi = N_PHASES; a.use_bar = 1;
    hipLaunchKernelGGL(hyb_fwd, dim3(grid), dim3(512), LDS_BYTES, stream, a);
#else
    for (int ph = 0; ph < N_PHASES; ++ph) { a.ph_lo = ph; a.ph_hi = ph + 1; a.use_bar = 0; hipLaunchKernelGGL(hyb_fwd, dim3(grid), dim3(512), LDS_BYTES, stream, a); }
#endif
}
```

```cpp
#include <hip/hip_runtime.h>
#include <cstdio>
#include <cstdint>
namespace pg8 {
#define PG8_LAS __attribute__((address_space(3)))
typedef unsigned short bf16_t;
typedef short bf16x8 __attribute__((ext_vector_type(8)));
typedef float f32x4 __attribute__((ext_vector_type(4)));
typedef unsigned u32x4 __attribute__((ext_vector_type(4)));
constexpr int BM = 256, BK = 64, HALF = 128, HTB = HALF * BK * 2  , STAGE_BYTES = 8 * HTB, NXCD = 8, WGM = 8;

__host__ __device__ __forceinline__ int lds_byte(int r, int c) { const int st = (r >> 4) * 2 + (c >> 5), rr = r & 15, cc = c & 31, ob = rr * 64 + cc * 2; return st * 1024 + (ob ^ (((ob >> 9) & 1) << 5)); }
__host__ __device__ __forceinline__ void stage_rc(int b, int& R, int& C) { const int st = b / 1024, sb = b % 1024, swz = sb ^ (((sb >> 9) & 1) << 5); R = (st >> 1) * 16 + swz / 64; C = (st & 1) * 32 + (swz % 64) / 2; }
__host__ __device__ __forceinline__ int perm32(int rho) { const int n = rho >> 4, i = rho & 15; return 8 * (i >> 2) + 4 * n + (i & 3); }

struct Unit { int pm, pn; };
struct Gemm { const bf16_t* A; const bf16_t* Bt; int M, N, K; };

struct StaticOrder {
    int nM, nN, nwg, G, c;
    __host__ __device__ void init(int M, int N, int G_, int c_) { nM = M / BM; nN = N / BM; nwg = nM * nN; G = G_; c = c_; }
    __host__ __device__ bool next(int i, Unit& u) const {
        const long L = (long)i * G + c; if (L >= nwg) return false;
        int wgid = (int)L; { const int q = nwg / NXCD, r = nwg % NXCD, xcd = wgid % NXCD, off = wgid / NXCD; wgid = (xcd < r ? xcd * (q + 1) : r * (q + 1) + (xcd - r) * q) + off; }
        const int nig = WGM * nN, gid = wgid / nig, fm = gid * WGM, gsz = (nM - fm) < WGM ? (nM - fm) : WGM;
        u.pm = fm + ((wgid % nig) % gsz); u.pn = (wgid % nig) / gsz; return true;
    }
    __device__ __forceinline__ void a_ready(const Unit&) const {}
    __device__ __forceinline__ void done(const Unit&) const {}
};
__device__ __forceinline__ unsigned cvt_pk_bf16(float lo, float hi) { unsigned r; asm volatile("v_cvt_pk_bf16_f32 %0, %1, %2" : "=v"(r) : "v"(lo), "v"(hi)); return r; }
typedef unsigned u32x2 __attribute__((ext_vector_type(2)));
__device__ __forceinline__ float sigmoidf_(float x) { return 1.0f / (1.0f + __expf(-x)); }
__device__ __forceinline__ float bflo(unsigned w) { return __uint_as_float(w << 16); }
__device__ __forceinline__ float bfhi(unsigned w) { return __uint_as_float(w & 0xffff0000u); }

struct EpiF32 {
    static constexpr bool PERM = false, AFTER_DRAIN = false;
    float* C; int ldc;
    __device__ __forceinline__ void operator()(const f32x4 (&acc)[2][2][4][2], const Unit& u, int wr, int wc, int fr, int fq) const {
        const int row0 = u.pm * BM + wr * 64 + fr, col0 = u.pn * BM + wc * 32 + 4 * fq;
#pragma unroll
        for (int ai = 0; ai < 2; ++ai)
#pragma unroll
            for (int m = 0; m < 4; ++m) { float* rowp = C + (size_t)(row0 + ai * HALF + m * 16) * ldc + col0;
#pragma unroll
                for (int bj = 0; bj < 2; ++bj)
#pragma unroll
                    for (int n = 0; n < 2; ++n) *(f32x4*)(rowp + bj * HALF + n * 16) = acc[ai][bj][m][n]; }
    }
};
struct EpiInProj {
    static constexpr bool PERM = true, AFTER_DRAIN = false;
    bf16_t* O; int ldc; float* S; int nbf;
    __device__ __forceinline__ void operator()(const f32x4 (&acc)[2][2][4][2], const Unit& u, int wr, int wc, int fr, int fq) const {
        const int row0 = u.pm * BM + wr * 64 + fr;
        if (u.pn < nbf) {
            const int col0 = u.pn * BM + wc * 32 + 8 * fq;
#pragma unroll
            for (int ai = 0; ai < 2; ++ai)
#pragma unroll
                for (int m = 0; m < 4; ++m) { bf16_t* rowp = O + (size_t)(row0 + ai * HALF + m * 16) * ldc + col0;
#pragma unroll
                    for (int bj = 0; bj < 2; ++bj) { const f32x4 v0 = acc[ai][bj][m][0], v1 = acc[ai][bj][m][1];
                        u32x4 w; w.x = cvt_pk_bf16(v0[0], v0[1]); w.y = cvt_pk_bf16(v0[2], v0[3]); w.z = cvt_pk_bf16(v1[0], v1[1]); w.w = cvt_pk_bf16(v1[2], v1[3]);
                        *(u32x4*)(rowp + bj * HALF) = w; } }
        } else {
            const int col0 = wc * 32 + 8 * fq;
#pragma unroll
            for (int ai = 0; ai < 2; ++ai)
#pragma unroll
                for (int m = 0; m < 4; ++m) { float* rowp = S + (size_t)(row0 + ai * HALF + m * 16) * 256 + col0;
#pragma unroll
                    for (int bj = 0; bj < 2; ++bj)
#pragma unroll
                        for (int n = 0; n < 2; ++n) *(f32x4*)(rowp + bj * HALF + 4 * n) = acc[ai][bj][m][n]; }
        }
    }
};
template <int J> struct EpiBranch {
    static constexpr bool PERM = false, AFTER_DRAIN = false;
    bf16_t* T; bf16_t* MB; const bf16_t* GM; int ldg; const float* rowss; float eps;
    __device__ __forceinline__ void operator()(const f32x4 (&acc)[2][2][4][2], const Unit& u, int wr, int wc, int fr, int fq) const {
        const int row0 = u.pm * BM + wr * 64 + fr, col0 = u.pn * BM + wc * 32 + 4 * fq;
#pragma unroll
        for (int ai = 0; ai < 2; ++ai)
#pragma unroll
            for (int mp = 0; mp < 4; mp += 2) {
                u32x2 gw[2][4], tw[2][4]; float rs[2];
#pragma unroll
                for (int mm = 0; mm < 2; ++mm) { const int row = row0 + ai * HALF + (mp + mm) * 16; rs[mm] = J == 0 ? rsqrtf(rowss[row] * (1.0f / 2048.0f) + eps) : 1.0f;
#pragma unroll
                    for (int q = 0; q < 4; ++q) { const int col = col0 + (q >> 1) * HALF + (q & 1) * 16;
                        gw[mm][q] = *(const u32x2*)(GM + (size_t)row * ldg + col);
                        tw[mm][q] = J > 0 ? *(const u32x2*)(T + (size_t)row * 2048 + col) : (u32x2){0u, 0u}; } }
#pragma unroll
                for (int mm = 0; mm < 2; ++mm) { const int row = row0 + ai * HALF + (mp + mm) * 16;
#pragma unroll
                    for (int q = 0; q < 4; ++q) { const int col = col0 + (q >> 1) * HALF + (q & 1) * 16;
                        f32x4 g; g[0] = sigmoidf_(bflo(gw[mm][q].x)); g[1] = sigmoidf_(bfhi(gw[mm][q].x)); g[2] = sigmoidf_(bflo(gw[mm][q].y)); g[3] = sigmoidf_(bfhi(gw[mm][q].y));
                        f32x4 v = acc[ai][q >> 1][mp + mm][q & 1] * g * rs[mm];
                        v[0] += bflo(tw[mm][q].x); v[1] += bfhi(tw[mm][q].x); v[2] += bflo(tw[mm][q].y); v[3] += bfhi(tw[mm][q].y);
                        u32x2 w; w.x = cvt_pk_bf16(v[0], v[1]); w.y = cvt_pk_bf16(v[2], v[3]);
                        *(u32x2*)((J < 2 ? T : MB) + (size_t)row * 2048 + col) = w; } } }
    }
};
template <int GATE> struct EpiRowSS {
    static constexpr bool PERM = false, AFTER_DRAIN = false;
    float* C; const float* E; float* rowss;
    __device__ __forceinline__ void operator()(const f32x4 (&acc)[2][2][4][2], const Unit& u, int wr, int wc, int fr, int fq) const {
        const int row0 = u.pm * BM + wr * 64 + fr, col0 = u.pn * BM + wc * 32 + 4 * fq;
#pragma unroll
        for (int ai = 0; ai < 2; ++ai)
#pragma unroll
            for (int mp = 0; mp < 4; mp += 2) {
                f32x4 ev[2][4];
                if (GATE) {
#pragma unroll
                    for (int mm = 0; mm < 2; ++mm)
#pragma unroll
                        for (int q = 0; q < 4; ++q) ev[mm][q] = *(const f32x4*)(E + (size_t)(row0 + ai * HALF + (mp + mm) * 16) * 2048 + col0 + (q >> 1) * HALF + (q & 1) * 16); }
#pragma unroll
                for (int mm = 0; mm < 2; ++mm) { const int row = row0 + ai * HALF + (mp + mm) * 16; float ss = 0.f;
#pragma unroll
                    for (int q = 0; q < 4; ++q) { const int col = col0 + (q >> 1) * HALF + (q & 1) * 16; f32x4 v = acc[ai][q >> 1][mp + mm][q & 1];
                        if (GATE) { v[0] = sigmoidf_(v[0]) * ev[mm][q][0]; v[1] = sigmoidf_(v[1]) * ev[mm][q][1]; v[2] = sigmoidf_(v[2]) * ev[mm][q][2]; v[3] = sigmoidf_(v[3]) * ev[mm][q][3]; }
                        ss += (v[0] * v[0] + v[1] * v[1]) + (v[2] * v[2] + v[3] * v[3]);
                        *(f32x4*)(C + (size_t)row * 2048 + col) = v; }
                    ss += __shfl_xor(ss, 16); ss += __shfl_xor(ss, 32);
                    if (fq == 0) atomicAdd(rowss + row, ss); } }
    }
};
struct EpiCmp1 {
    static constexpr bool PERM = true, AFTER_DRAIN = false;
    bf16_t* O; const float* hb;
    __device__ __forceinline__ void operator()(const f32x4 (&acc)[2][2][4][2], const Unit& u, int wr, int wc, int fr, int fq) const {
        const int row0 = u.pm * BM + wr * 64 + fr, col0 = wc * 32 + 8 * fq;
#pragma unroll
        for (int ai = 0; ai < 2; ++ai)
#pragma unroll
            for (int m = 0; m < 4; ++m) { bf16_t* rowp = O + (size_t)(row0 + ai * HALF + m * 16) * 256 + col0;
#pragma unroll
                for (int bj = 0; bj < 2; ++bj) { f32x4 v0 = acc[ai][bj][m][0] + *(const f32x4*)(hb + col0 + bj * HALF), v1 = acc[ai][bj][m][1] + *(const f32x4*)(hb + col0 + bj * HALF + 4);
#pragma unroll
                    for (int j = 0; j < 4; ++j) { v0[j] = v0[j] * sigmoidf_(v0[j]); v1[j] = v1[j] * sigmoidf_(v1[j]); }
                    u32x4 w; w.x = cvt_pk_bf16(v0[0], v0[1]); w.y = cvt_pk_bf16(v0[2], v0[3]); w.z = cvt_pk_bf16(v1[0], v1[1]); w.w = cvt_pk_bf16(v1[2], v1[3]);
                    *(u32x4*)(rowp + bj * HALF) = w; } }
    }
};
struct EpiCmp2 {
    static constexpr bool PERM = true, AFTER_DRAIN = false;
    bf16_t* O;
    __device__ __forceinline__ void operator()(const f32x4 (&acc)[2][2][4][2], const Unit& u, int wr, int wc, int fr, int fq) const {
        const int row0 = u.pm * BM + wr * 64 + fr, col0 = wc * 32 + 8 * fq;
#pragma unroll
        for (int ai = 0; ai < 2; ++ai)
#pragma unroll
            for (int m = 0; m < 4; ++m) { bf16_t* rowp = O + (size_t)(row0 + ai * HALF + m * 16) * 128 + col0;
                const f32x4 v0 = acc[ai][0][m][0], v1 = acc[ai][0][m][1];
                u32x4 w; w.x = cvt_pk_bf16(v0[0], v0[1]); w.y = cvt_pk_bf16(v0[2], v0[3]); w.z = cvt_pk_bf16(v1[0], v1[1]); w.w = cvt_pk_bf16(v1[2], v1[3]);
                *(u32x4*)rowp = w; }
    }
};
template <class Epi, class Sched, bool ALIGN_EPI = false, bool SP2 = false>
__device__ __forceinline__ void gemm_phase(PG8_LAS unsigned char* lds, const Gemm g, const Sched& S, const Epi& E, int wave_in) {
    int tid_ = wave_in * 64 + (int)__builtin_amdgcn_mbcnt_hi(~0u, __builtin_amdgcn_mbcnt_lo(~0u, 0u)); asm volatile("" : "+v"(tid_));
    const int tid = tid_, wid = __builtin_amdgcn_readfirstlane(tid >> 6), lane = tid & 63, wr = wid >> 2, wc = wid & 3, fr = lane & 15, fq = lane >> 4;
    const int K = g.K, nt = K / BK;
    unsigned voffA[2], voffB[2];
#pragma unroll
    for (int i = 0; i < 2; ++i) { int R, C; stage_rc(tid * 16 + i * 8192, R, C); const int Rb = Epi::PERM ? ((R & ~31) + perm32(R & 31)) : R;
        voffA[i] = (unsigned)(R * K + C) * 2u; voffB[i] = (unsigned)(Rb * K + C) * 2u; }
    const size_t kstep = (size_t)(BK * 2);
    const size_t hstep = (size_t)HALF * K * 2;
    const size_t tstep = 2 * hstep;
    const unsigned ldsw = (unsigned)wid * 1024u;
    const int aoff = lds_byte(wr * 64 + fr, fq * 8), boff = lds_byte(wc * 32 + fr, fq * 8);
#define PG8_SA(b, h) (((b) * 2 + (h)) * HTB)
#define PG8_SB(b, h) ((4 + (b) * 2 + (h)) * HTB)
#define PG8_STAGE(bufoff, gbase, voff) do { _Pragma("unroll") for (int _i = 0; _i < 2; ++_i) \
        __builtin_amdgcn_global_load_lds((const unsigned*)((const char*)(gbase) + (voff)[_i]), (PG8_LAS unsigned*)(lds + (bufoff) + ldsw + _i * 8192), 16, 0, 0); } while (0)
#define PG8_LDA(dst, b, h) do { _Pragma("unroll") for (int m = 0; m < 4; ++m) _Pragma("unroll") for (int k = 0; k < 2; ++k) dst[m][k] = *(const PG8_LAS bf16x8*)(lds + PG8_SA(b, h) + aoff + m * 2048 + k * 1024); } while (0)
#define PG8_LDB(dst, b, h) do { _Pragma("unroll") for (int n = 0; n < 2; ++n) _Pragma("unroll") for (int k = 0; k < 2; ++k) dst[n][k] = *(const PG8_LAS bf16x8*)(lds + PG8_SB(b, h) + boff + n * 2048 + k * 1024); } while (0)
#define PG8_MMA(ai, bj, At, Bt) do { __builtin_amdgcn_s_setprio(1); _Pragma("unroll") for (int m = 0; m < 4; ++m) _Pragma("unroll") for (int n = 0; n < 2; ++n) _Pragma("unroll") for (int k = 0; k < 2; ++k) \
        acc[ai][bj][m][n] = __builtin_amdgcn_mfma_f32_16x16x32_bf16(Bt[n][k], At[m][k], acc[ai][bj][m][n], 0, 0, 0); __builtin_amdgcn_s_setprio(0); } while (0)
#define PG8_WAIT_V(n) asm volatile("s_waitcnt vmcnt(" #n ")" ::: "memory")
#define PG8_WAIT_L(n) asm volatile("s_waitcnt lgkmcnt(" #n ")" ::: "memory")
#define PG8_BAR __builtin_amdgcn_s_barrier()
#define PG8_SCHED __builtin_amdgcn_sched_barrier(0)
    Unit cur, nxt; int ui = 0;
    if (!S.next(0, cur)) return;
    f32x4 acc[2][2][4][2];
#pragma unroll
    for (int a = 0; a < 2; ++a)
#pragma unroll
        for (int b = 0; b < 2; ++b)
#pragma unroll
            for (int m = 0; m < 4; ++m)
#pragma unroll
                for (int n = 0; n < 2; ++n) acc[a][b][m][n] = (f32x4){0.f, 0.f, 0.f, 0.f};
    bf16x8 At[4][2], B0[2][2], B1[2][2];
    const char* cA = (const char*)g.A + (size_t)cur.pm * tstep; const char* cB = (const char*)g.Bt + (size_t)cur.pn * tstep;
    S.a_ready(cur);
    if constexpr (SP2) {
        PG8_STAGE(PG8_SB(0, 0), cB, voffB); PG8_STAGE(PG8_SB(0, 1), cB + hstep, voffB); PG8_STAGE(PG8_SA(0, 0), cA, voffA); PG8_STAGE(PG8_SA(0, 1), cA + hstep, voffA);
        if (wr == 1) PG8_BAR;
        PG8_WAIT_V(2); PG8_BAR;
        PG8_STAGE(PG8_SB(1, 0), cB + kstep, voffB); PG8_STAGE(PG8_SA(1, 0), cA + kstep, voffA); PG8_STAGE(PG8_SB(1, 1), cB + hstep + kstep, voffB);
        PG8_WAIT_V(6); PG8_BAR;
    } else {
        PG8_STAGE(PG8_SB(0, 0), cB, voffB); PG8_STAGE(PG8_SA(0, 0), cA, voffA); PG8_STAGE(PG8_SB(0, 1), cB + hstep, voffB); PG8_STAGE(PG8_SA(0, 1), cA + hstep, voffA);
        if (wr == 1) PG8_BAR;
        PG8_WAIT_V(4); PG8_BAR;
        PG8_STAGE(PG8_SB(1, 0), cB + kstep, voffB); PG8_STAGE(PG8_SA(1, 0), cA + kstep, voffA); PG8_STAGE(PG8_SB(1, 1), cB + hstep + kstep, voffB);
        PG8_WAIT_V(6); PG8_BAR;
    }
    for (;;) {
        const bool has_next = S.next(ui + 1, nxt);
        const char* nA = has_next ? (const char*)g.A + (size_t)nxt.pm * tstep : cA; const char* nB = has_next ? (const char*)g.Bt + (size_t)nxt.pn * tstep : cB;
        for (int t = 0; t < nt; t += 2) {
            const bool last = (t == nt - 2);
            const char* a1 = cA + (size_t)(t + 1) * kstep;
            const char* a2 = last ? nA : cA + (size_t)(t + 2) * kstep; const char* b2 = last ? nB : cB + (size_t)(t + 2) * kstep;
            const char* a3 = a2 + kstep; const char* b3 = b2 + kstep;
            if (last && has_next) S.a_ready(nxt);
            if constexpr (SP2) {
            PG8_LDB(B0, 0, 0); PG8_LDB(B1, 0, 1); PG8_SCHED; PG8_LDA(At, 0, 0); PG8_STAGE(PG8_SA(1, 1), a1 + hstep, voffA);
            PG8_WAIT_V(8); PG8_WAIT_L(0); PG8_BAR; PG8_MMA(0, 0, At, B0); PG8_MMA(0, 1, At, B1); PG8_BAR; PG8_SCHED;
            PG8_LDA(At, 0, 1); PG8_STAGE(PG8_SB(0, 0), b2, voffB); PG8_STAGE(PG8_SB(0, 1), b2 + hstep, voffB); PG8_STAGE(PG8_SA(0, 0), a2, voffA);
            PG8_WAIT_V(8); PG8_WAIT_L(0); PG8_BAR; PG8_MMA(1, 0, At, B0); PG8_MMA(1, 1, At, B1); PG8_BAR; PG8_SCHED;
            PG8_LDB(B0, 1, 0); PG8_LDB(B1, 1, 1); PG8_SCHED; PG8_LDA(At, 1, 0); PG8_STAGE(PG8_SA(0, 1), a2 + hstep, voffA);
            PG8_WAIT_V(8); PG8_WAIT_L(0); PG8_BAR; PG8_MMA(0, 0, At, B0); PG8_MMA(0, 1, At, B1); PG8_BAR; PG8_SCHED;
            PG8_LDA(At, 1, 1); PG8_STAGE(PG8_SB(1, 0), b3, voffB); PG8_STAGE(PG8_SB(1, 1), b3 + hstep, voffB); PG8_STAGE(PG8_SA(1, 0), a3, voffA);
            PG8_WAIT_V(8); PG8_WAIT_L(0); PG8_BAR; PG8_MMA(1, 0, At, B0); PG8_MMA(1, 1, At, B1); PG8_BAR; PG8_SCHED;
            } else {
            PG8_LDB(B0, 0, 0); PG8_SCHED; PG8_LDA(At, 0, 0); PG8_STAGE(PG8_SA(1, 1), a1 + hstep, voffA);
            PG8_WAIT_L(8); PG8_BAR; PG8_WAIT_L(0); PG8_MMA(0, 0, At, B0); PG8_BAR; PG8_SCHED;
            PG8_LDB(B1, 0, 1); PG8_STAGE(PG8_SB(0, 0), b2, voffB);
            PG8_BAR; PG8_WAIT_L(0); PG8_MMA(0, 1, At, B1); PG8_BAR;
            PG8_LDA(At, 0, 1); PG8_STAGE(PG8_SA(0, 0), a2, voffA);
            PG8_BAR; PG8_WAIT_L(0); PG8_MMA(1, 0, At, B0); PG8_BAR; PG8_SCHED;
            PG8_STAGE(PG8_SB(0, 1), b2 + hstep, voffB);
            PG8_WAIT_V(6); PG8_BAR; PG8_MMA(1, 1, At, B1); PG8_BAR;
            PG8_LDB(B0, 1, 0); PG8_SCHED; PG8_LDA(At, 1, 0); PG8_STAGE(PG8_SA(0, 1), a2 + hstep, voffA);
            PG8_WAIT_L(8); PG8_BAR; PG8_WAIT_L(0); PG8_MMA(0, 0, At, B0); PG8_BAR; PG8_SCHED;
            PG8_LDB(B1, 1, 1); PG8_STAGE(PG8_SB(1, 0), b3, voffB);
            PG8_BAR; PG8_WAIT_L(0); PG8_MMA(0, 1, At, B1); PG8_BAR;
            PG8_LDA(At, 1, 1); PG8_STAGE(PG8_SA(1, 0), a3, voffA);
            PG8_BAR; PG8_WAIT_L(0); PG8_MMA(1, 0, At, B0); PG8_BAR; PG8_SCHED;
            PG8_STAGE(PG8_SB(1, 1), b3 + hstep, voffB);
            PG8_WAIT_V(6); PG8_BAR; PG8_MMA(1, 1, At, B1); PG8_BAR;
            }
        }
        if constexpr (ALIGN_EPI) { if (wr == 0) PG8_BAR; }
        if constexpr (!Epi::AFTER_DRAIN) { E(acc, cur, wr, wc, fr, fq); S.done(cur); }
        if (!has_next) break;
#pragma unroll
        for (int a = 0; a < 2; ++a)
#pragma unroll
            for (int b = 0; b < 2; ++b)
#pragma unroll
                for (int m = 0; m < 4; ++m)
#pragma unroll
                    for (int n = 0; n < 2; ++n) acc[a][b][m][n] = (f32x4){0.f, 0.f, 0.f, 0.f};
        cur = nxt; cA = nA; cB = nB; ++ui;
        if constexpr (ALIGN_EPI) { if (wr == 1) PG8_BAR; }
    }
    PG8_WAIT_V(0);
    if constexpr (!ALIGN_EPI) { if (wr == 0) PG8_BAR; }
    PG8_BAR;
    if constexpr (Epi::AFTER_DRAIN) { E.fused(acc, cur, wr, wc, fr, fq, lds, wid, lane); S.done(cur); }
#undef PG8_SA
#undef PG8_SB
#undef PG8_STAGE
#undef PG8_LDA
#undef PG8_LDB
#undef PG8_MMA
#undef PG8_WAIT_V
#undef PG8_WAIT_L
#undef PG8_BAR
#undef PG8_SCHED
}
}

constexpr int L_SEQ = 8192, DM = 2048, NLAYER = 2, PDIM = 256;
constexpr int IN_DIM = 27728;
constexpr int NPROJ = 27648;
constexpr int NPAD = 27904;
constexpr int C_XA = 0, C_ZA = 2048, C_BA = 4096, C_CA = 5120, C_QB = 6144, C_KCB = 8192, C_VCB = 8704, C_KSB = 9216, C_VSB = 9728, C_KWB = 10240, C_VWB = 10752,
              C_ZB = 11264, C_QC = 13312, C_KC = 15360, C_VC = 17408, C_ZC = 19456, C_GM = 21504;
constexpr int S_XA = 0, S_DTA = 6144, S_QB = 6176, S_GB = 11296, S_ZB = 11344;
constexpr float EPS = 1e-6f;
constexpr int NCMP = 511;

constexpr size_t MiB = 1u << 20;
constexpr size_t WS_CTL = 0, CTL_ZERO_BYTES = 1 * MiB;
constexpr size_t ROWSS_OFF = 512 * 1024;
constexpr size_t SZ_WIN = (size_t)NPAD * DM * 2;
constexpr size_t WS_WIN = 1 * MiB;
constexpr size_t WS_WBR = WS_WIN + 2 * SZ_WIN;
constexpr size_t WS_WOUT = WS_WBR + 6 * 8 * MiB;
constexpr size_t WS_WGATE = WS_WOUT + 2 * 8 * MiB;
constexpr size_t WS_WPP = WS_WGATE + 2 * 8 * MiB;
constexpr size_t WS_WC1 = WS_WPP + 2 * MiB;
constexpr size_t WS_WC2 = WS_WC1 + 8 * MiB;
constexpr size_t WS_HB = WS_WC2 + 512 * 1024;
constexpr size_t WS_PBF = WS_HB + 512 * 1024;
constexpr size_t WS_HBF = WS_PBF + 8 * MiB;
constexpr size_t WS_PROJ = WS_HBF + 32 * MiB;
constexpr size_t WS_SMALL = WS_PROJ + (size_t)L_SEQ * NPROJ * 2;
constexpr size_t WS_EBUF = WS_SMALL + 8 * MiB;
constexpr size_t WS_AIM = WS_EBUF + 64 * MiB;
constexpr size_t WS_HID = WS_AIM + 32 * MiB;
constexpr size_t WS_KVC = WS_HID + 2 * MiB;
constexpr size_t WS_ACS = WS_KVC + 1 * MiB;
constexpr size_t WS_DTV = WS_ACS + 1 * MiB;
constexpr size_t WS_CD = WS_DTV + 1 * MiB;
constexpr size_t WS_ST = WS_CD + 1 * MiB;
constexpr size_t WS_KVT = WS_ST + 64 * MiB;
constexpr size_t WS_YA = WS_KVT + 128 * MiB;
constexpr size_t WS_YB = WS_YA + 32 * MiB;
constexpr size_t WS_YC = WS_YB + 32 * MiB;
constexpr size_t WS_TF = WS_YC + 32 * MiB;
constexpr size_t WS_MB = WS_TF + 64 * MiB;
constexpr size_t WS_X1 = WS_MB + 32 * MiB;
constexpr size_t WS_XL = WS_X1 + 64 * MiB;
constexpr size_t WS_ROT = WS_XL + 64 * MiB;
constexpr size_t WS_HBP = WS_ROT + 8 * MiB;
constexpr size_t WS_END = WS_HBP + 1 * MiB;

constexpr int CW_BAR = 4096;

constexpr int LDS_BYTES = 155648;
constexpr int MISC_OFF = 154624;

#define GAS __attribute__((address_space(1)))
#define LAS __attribute__((address_space(3)))
typedef unsigned short bf16;
typedef short bf16x8 __attribute__((ext_vector_type(8)));
typedef float f32x4 __attribute__((ext_vector_type(4)));
typedef unsigned u32x4 __attribute__((ext_vector_type(4)));
typedef unsigned u32x2 __attribute__((ext_vector_type(2)));

__device__ __forceinline__ unsigned f2bf(float f) { unsigned u = __builtin_bit_cast(unsigned, f); return (u + 0x7fffu + ((u >> 16) & 1u)) >> 16; }
__device__ __forceinline__ unsigned pk2(float lo, float hi) { return f2bf(lo) | (f2bf(hi) << 16); }
__device__ __forceinline__ float bf2f(unsigned short b) { return __uint_as_float(((unsigned)b) << 16); }
__device__ __forceinline__ float blo(unsigned w) { return __uint_as_float(w << 16); }
__device__ __forceinline__ float bhi(unsigned w) { return __uint_as_float(w & 0xffff0000u); }
__device__ __forceinline__ float sigm(float x) { return 1.0f / (1.0f + __expf(-x)); }
__device__ __forceinline__ float siluf(float x) { return x * sigm(x); }
__device__ __forceinline__ float wave_sum(float v) {
#pragma unroll
    for (int o = 1; o < 64; o <<= 1) v += __shfl_xor(v, o);
    return v;
}
__device__ __forceinline__ int fresh(int x) { asm volatile("" : "+v"(x)); return x; }
__device__ __forceinline__ int fresh_s(int x) { asm volatile("" : "+s"(x)); return x; }
#define LDS_WAIT() asm volatile("s_waitcnt lgkmcnt(0)" ::: "memory")

#define XB_TMO      128
#define XB_XCNT(j)  (256  + 64 * (j))
#define XB_XSUB(j)  (1280 + 64 * (j))
#define XB_XGEN(j)  (2304 + 64 * (j))
#define XB_TOP      3328
#define XB_TOPGEN   3392
#define XCD_BAR_WORDS 3456
#define XB_SPIN_CAP (1u << 18)
__device__ __forceinline__ unsigned xb_ld(unsigned* p)              { return __hip_atomic_load(p, __ATOMIC_RELAXED, __HIP_MEMORY_SCOPE_AGENT); }
__device__ __forceinline__ unsigned xb_add(unsigned* p, unsigned v) { return __hip_atomic_fetch_add(p, v, __ATOMIC_RELAXED, __HIP_MEMORY_SCOPE_AGENT); }
__device__ __forceinline__ unsigned xb_xcc_id() { return (unsigned)__builtin_amdgcn_s_getreg((3 << 11) | 20) & 0xFu; }
#define XB_SPIN(cond, bar) do { unsigned _sp = 0; while (cond) { __builtin_amdgcn_s_sleep(1); \
    if ((++_sp & 255u) == 0u) { if (xb_ld(&(bar)[XB_TMO])) break; if (_sp > XB_SPIN_CAP) { atomicAdd(&(bar)[XB_TMO], 1u); break; } } } } while (0)
struct XcdBarrier { unsigned* bar; unsigned x; volatile LAS unsigned* st; };
__device__ __forceinline__ XcdBarrier xcd_barrier_post(unsigned* bar, volatile LAS unsigned* st) {
    XcdBarrier b; b.bar = bar; b.x = xb_xcc_id(); b.st = st;
    if (threadIdx.x == 0) (void)xb_add(&bar[XB_XCNT(b.x)], 1u);
    return b;
}
__device__ __forceinline__ void xcd_barrier_complete(unsigned* bar, unsigned x, unsigned& nloc, unsigned& nx) {
    const unsigned G = gridDim.x * gridDim.y * gridDim.z;
    unsigned sum, cnt, mine, sp = 0u;
    for (;;) {
        sum = 0u; cnt = 0u; mine = 0u;
#pragma unroll
        for (unsigned j = 0; j < 16; ++j) { const unsigned c = xb_ld(&bar[XB_XCNT(j)]); sum += c; cnt += (c > 0u) ? 1u : 0u; mine = (j == x) ? c : mine; }
        if (sum == G) break;
        __builtin_amdgcn_s_sleep(1);
        if ((++sp & 255u) == 0u) { if (xb_ld(&bar[XB_TMO])) break; if (sp > XB_SPIN_CAP) { atomicAdd(&bar[XB_TMO], 1u); break; } }
    }
    nloc = mine > 0u ? mine : 1u; nx = cnt > 0u ? cnt : 1u;
}
__device__ __forceinline__ void xcd_barrier(const XcdBarrier& b) {
    asm volatile("s_waitcnt vmcnt(0)" ::: "memory");
    __syncthreads();
    if (threadIdx.x == 0) {
        unsigned* bar = b.bar;
        __builtin_amdgcn_s_waitcnt(0);
        unsigned nloc = b.st[0], nx = b.st[1];
        if (nloc == 0u) { xcd_barrier_complete(bar, b.x, nloc, nx); b.st[0] = nloc; b.st[1] = nx; }
        const unsigned old = xb_add(&bar[XB_XSUB(b.x)], 1u);
        const unsigned gen = old / nloc;
        if (old + 1u == (gen + 1u) * nloc) {
            __builtin_amdgcn_fence(__ATOMIC_RELEASE, "agent");
            asm volatile("s_waitcnt vmcnt(0)" ::: "memory");
            const unsigned og = xb_add(&bar[XB_TOP], 1u);
            const unsigned tg = og / nx;
            if (og + 1u == (tg + 1u) * nx) xb_add(&bar[XB_TOPGEN], 1u);
            else XB_SPIN(xb_ld(&bar[XB_TOPGEN]) == tg, bar);
            __builtin_amdgcn_fence(__ATOMIC_ACQUIRE, "agent");
            xb_add(&bar[XB_XGEN(b.x)], 1u);
            asm volatile("s_waitcnt vmcnt(0)" ::: "memory");
        } else {
            XB_SPIN(xb_ld(&bar[XB_XGEN(b.x)]) == gen, bar);
            __builtin_amdgcn_fence(__ATOMIC_ACQUIRE, "agent");
            asm volatile("s_waitcnt vmcnt(0)" ::: "memory");
        }
    }
    __syncthreads();
}

struct Args { const float* in[20]; float* out; unsigned char* ws; int ph_lo, ph_hi, use_bar, pad; };
typedef const __attribute__((address_space(4))) Args* ArgsP;
__device__ __forceinline__ ArgsP argp() { ArgsP p = (ArgsP)__builtin_amdgcn_kernarg_segment_ptr(); asm volatile("" : "+s"(p)); return p; }

__device__ __forceinline__ f32x4 mma16(bf16x8 x, bf16x8 y, f32x4 c) { return __builtin_amdgcn_mfma_f32_16x16x32_bf16(x, y, c, 0, 0, 0); }
__device__ __forceinline__ bf16x8 ldfrag(const LAS bf16* base, int stride, int row, int k) { return *(const LAS bf16x8*)(base + row * stride + k); }

struct TItem { const float* W; bf16* WT; int ldw, K, k0, src0, src1, ndst0; };
__device__ __forceinline__ void titem_load(const TItem& T, f32x4 (&v)[16], int lane) {
    const int col = (lane & 15) * 4, src = (col >> 5) ? T.src1 : T.src0;
#pragma unroll
    for (int i = 0; i < 16; ++i) { const int kk = 4 * i + (lane >> 4); v[i] = src >= 0 ? __builtin_nontemporal_load((const f32x4*)(T.W + (size_t)(T.k0 + kk) * T.ldw + src + (col & 31))) : (f32x4){0.f, 0.f, 0.f, 0.f}; }
}
__device__ __forceinline__ void titem_finish(const TItem& T, const f32x4 (&v)[16], LAS float* scr, int lane) {
    const int col = (lane & 15) * 4;
#pragma unroll
    for (int i = 0; i < 16; ++i) { const int kk = 4 * i + (lane >> 4); LAS float* d = scr + kk * 65 + col; d[0] = v[i][0]; d[1] = v[i][1]; d[2] = v[i][2]; d[3] = v[i][3]; }
    LDS_WAIT(); asm volatile("" ::: "memory");
    const int c = lane & 7;
#pragma unroll
    for (int j = 0; j < 8; ++j) { const int n = (lane >> 3) + 8 * j; const LAS float* s = scr + (8 * c) * 65 + n;
        u32x4 o; o.x = pk2(s[0 * 65], s[1 * 65]); o.y = pk2(s[2 * 65], s[3 * 65]); o.z = pk2(s[4 * 65], s[5 * 65]); o.w = pk2(s[6 * 65], s[7 * 65]);
        *(u32x4*)(T.WT + (size_t)(T.ndst0 + n) * T.K + T.k0 + 8 * c) = o; }
    LDS_WAIT(); asm volatile("" ::: "memory");
}
__device__ __forceinline__ TItem titem_plain(const float* W, int K, int N, int Npad, bf16* WT, int item) {
    const int nblk = Npad / 64, kb = item / nblk, nb = item % nblk, n0 = 64 * nb;
    TItem T; T.W = W; T.WT = WT; T.ldw = N; T.K = K; T.k0 = 64 * kb; T.src0 = n0 < N ? n0 : -1; T.src1 = n0 + 32 < N ? n0 + 32 : -1; T.ndst0 = n0; return T;
}
__device__ __forceinline__ int win_src(int n0) {
    if (n0 < 6144) return n0; if (n0 < 11264) return n0 + 32; if (n0 < 27648) return n0 + 80; if (n0 < 27680) return S_DTA; if (n0 < 27744) return S_GB + (n0 - 27680); return -1;
}
__device__ __forceinline__ TItem titem_win(const float* W, bf16* WT, int item) {
    constexpr int nblk = NPAD / 64;
    const int kb = item / nblk, nb = item % nblk, n0 = 64 * nb;
    TItem T; T.W = W; T.WT = WT; T.ldw = IN_DIM; T.K = DM; T.k0 = 64 * kb; T.src0 = win_src(n0); T.src1 = win_src(n0 + 32); T.ndst0 = n0; return T;
}
__device__ __forceinline__ void rms_row_to_bf16(const float* xrow, const float* gain, bf16* orow, int lane) {
    f32x4 v[8]; float s = 0.f;
#pragma unroll
    for (int j = 0; j < 8; ++j) { v[j] = *(const f32x4*)(xrow + 4 * lane + 256 * j); s += (v[j][0] * v[j][0] + v[j][1] * v[j][1]) + (v[j][2] * v[j][2] + v[j][3] * v[j][3]); }
    const float rs = rsqrtf(wave_sum(s) * (1.0f / 2048.0f) + EPS);
#pragma unroll
    for (int j = 0; j < 8; ++j) { f32x4 g = {1.f, 1.f, 1.f, 1.f}; if (gain) g = *(const f32x4*)(gain + 4 * lane + 256 * j);
        u32x2 w; w.x = pk2(v[j][0] * rs * g[0], v[j][1] * rs * g[1]); w.y = pk2(v[j][2] * rs * g[2], v[j][3] * rs * g[3]);
        *(u32x2*)(orow + 4 * lane + 256 * j) = w; }
}

__device__ __forceinline__ TItem prologue_item(ArgsP A, unsigned char* ws, int it) {
    constexpr int I_WIN = (DM / 64) * (NPAD / 64), I_SQ = (DM / 64) * (DM / 64), I_PP = (PDIM / 64) * (DM / 64), I_C1 = (4096 / 64) * (256 / 64), I_C2 = (256 / 64) * (256 / 64);
    constexpr int PER_LAYER = I_WIN + 3 * I_SQ + I_SQ + I_SQ + I_PP + 2 * I_C1 + 2 * I_C2;
    const int l = it / PER_LAYER; int r = it % PER_LAYER;
    if (r < I_WIN) return titem_win(A->in[4] + (size_t)l * DM * IN_DIM, (bf16*)(ws + WS_WIN + (size_t)l * SZ_WIN), r); r -= I_WIN;
    if (r < 3 * I_SQ) { const int j = r / I_SQ; return titem_plain(A->in[15] + (size_t)(l * 3 + j) * DM * DM, DM, DM, DM, (bf16*)(ws + WS_WBR + (size_t)(l * 3 + j) * 8 * MiB), r % I_SQ); } r -= 3 * I_SQ;
    if (r < I_SQ) return titem_plain(A->in[16] + (size_t)l * DM * DM, DM, DM, DM, (bf16*)(ws + WS_WOUT + (size_t)l * 8 * MiB), r); r -= I_SQ;
    if (r < I_SQ) return titem_plain(A->in[18] + (size_t)l * DM * DM, DM, DM, DM, (bf16*)(ws + WS_WGATE + (size_t)l * 8 * MiB), r); r -= I_SQ;
    if (r < I_PP) return titem_plain(A->in[17] + (size_t)l * PDIM * DM, PDIM, DM, DM, (bf16*)(ws + WS_WPP + (size_t)l * 1 * MiB), r); r -= I_PP;
    if (r < 2 * I_C1) { const int s = r / I_C1; return titem_plain(A->in[12] + (size_t)(l * 2 + s) * 4096 * 256, 4096, 256, 256, (bf16*)(ws + WS_WC1 + (size_t)(l * 2 + s) * 2 * MiB), r % I_C1); } r -= 2 * I_C1;
    { const int s = r / I_C2; return titem_plain(A->in[13] + (size_t)(l * 2 + s) * 256 * 128, 256, 128, 256, (bf16*)(ws + WS_WC2 + (size_t)(l * 2 + s) * 131072), r % I_C2); }
}

__device__ __forceinline__ void phase_prologue(ArgsP A, LAS unsigned char* lds, int tid, int lane, int wave, int G, int bid) {
    unsigned char* ws = A->ws;
    LAS float* scr = (LAS float*)(lds + wave * 17408);
    const int gw = bid * 8 + wave, NGW = G * 8;
    constexpr int I_WIN = (DM / 64) * (NPAD / 64);
    constexpr int I_SQ = (DM / 64) * (DM / 64);
    constexpr int I_PP = (PDIM / 64) * (DM / 64);
    constexpr int I_C1 = (4096 / 64) * (256 / 64);
    constexpr int I_C2 = (256 / 64) * (256 / 64);
    constexpr int PER_LAYER = I_WIN + 3 * I_SQ + I_SQ + I_SQ + I_PP + 2 * I_C1 + 2 * I_C2;
    {
        f32x4 va[16], vb[16]; TItem Ta, Tb; Ta.W = nullptr; Tb.W = nullptr;
        int it = gw;
        if (it < NLAYER * PER_LAYER) { Ta = prologue_item(A, ws, it); titem_load(Ta, va, lane); }
        while (it < NLAYER * PER_LAYER) {
            const int itb = it + NGW; const bool hb_ = itb < NLAYER * PER_LAYER;
            if (hb_) { Tb = prologue_item(A, ws, itb); titem_load(Tb, vb, lane); }
            titem_finish(Ta, va, scr, lane);
            const int ita = itb + NGW; const bool ha_ = ita < NLAYER * PER_LAYER;
            if (ha_) { Ta = prologue_item(A, ws, ita); titem_load(Ta, va, lane); }
            if (hb_) titem_finish(Tb, vb, scr, lane);
            it = ita;
        }
    }
    __syncthreads();
    for (int task = bid; task < 256; task += G) {
        const int ls = task >> 6, ck = task & 63, j = tid & 255, hf = tid >> 8;
        const float* pe = A->in[11] + (size_t)ls * 4096 + ck * 64 + hf * 32; const float* w1 = A->in[12] + ((size_t)ls * 4096 + ck * 64 + hf * 32) * 256 + j;
        float s = 0.f;
#pragma unroll 8
        for (int i = 0; i < 32; ++i) s += pe[i] * w1[(size_t)i * 256];
        LAS float* red = (LAS float*)lds;
        red[tid] = s; __syncthreads();
        if (tid < 256) ((float*)(ws + WS_HBP))[(size_t)task * 256 + tid] = red[tid] + red[tid + 256];
        __syncthreads();
    }
    { float* rot = (float*)(ws + WS_ROT); const LAS float* invt = (const LAS float*)(lds + MISC_OFF + 512);
      for (int i = bid * 512 + tid; i < L_SEQ * 128; i += G * 512) { float sn, cs; sincosf((float)(i >> 7) * invt[i & 127], &sn, &cs); rot[2 * i] = cs; rot[2 * i + 1] = sn; } }
    { const size_t n4 = (size_t)NLAYER * L_SEQ * PDIM / 4; const f32x4* src = (const f32x4*)A->in[1]; u32x2* dst = (u32x2*)(ws + WS_PBF);
      for (size_t i = (size_t)bid * 512 + tid; i < n4; i += (size_t)G * 512) { const f32x4 v = src[i]; u32x2 w; w.x = pk2(v[0], v[1]); w.y = pk2(v[2], v[3]); dst[i] = w; } }
    for (int m = gw; m < L_SEQ; m += NGW) rms_row_to_bf16(A->in[0] + (size_t)m * DM, A->in[2], (bf16*)(ws + WS_HBF) + (size_t)m * DM, lane);
}

struct LayerP {
    const float *conv_w, *conv_b, *dt_bias, *a_log, *d_skip, *ssm_norm, *ret_norm;
};
__device__ __forceinline__ void conv8(const bf16* proj, int t, int col0, const float* cw, const float* cb, int cch0, float (&out)[8]) {
    u32x4 v[4]; f32x4 w0[4], w1[4];
#pragma unroll
    for (int k = 0; k < 4; ++k) { const int tt = t - 3 + k, tc = tt < 0 ? 0 : tt; v[k] = *(const u32x4*)(proj + (size_t)tc * NPROJ + col0);
        w0[k] = *(const f32x4*)(cw + k * 4096 + cch0); w1[k] = *(const f32x4*)(cw + k * 4096 + cch0 + 4); }
    const f32x4 b0 = *(const f32x4*)(cb + cch0), b1 = *(const f32x4*)(cb + cch0 + 4);
    float acc[8] = {b0[0], b0[1], b0[2], b0[3], b1[0], b1[1], b1[2], b1[3]};
#pragma unroll
    for (int k = 0; k < 4; ++k) { const float ok = (t - 3 + k) < 0 ? 0.f : 1.f; const f32x4 a0 = w0[k] * ok, a1 = w1[k] * ok;
        acc[0] += a0[0] * blo(v[k].x); acc[1] += a0[1] * bhi(v[k].x); acc[2] += a0[2] * blo(v[k].y); acc[3] += a0[3] * bhi(v[k].y);
        acc[4] += a1[0] * blo(v[k].z); acc[5] += a1[1] * bhi(v[k].z); acc[6] += a1[2] * blo(v[k].w); acc[7] += a1[3] * bhi(v[k].w); }
#pragma unroll
    for (int i = 0; i < 8; ++i) out[i] = siluf(acc[i]);
}

constexpr int SA_XT = 0, SA_BT = 69632, SA_ACS = 104448, SA_DTV = 106496;
__device__ __forceinline__ void ssd_states_unit(ArgsP A, const LayerP& P, LAS unsigned char* lds, int c, int g, int tid, int lane, int wave) {
    tid = fresh(tid); lane = fresh(lane); wave = fresh_s(wave);
    unsigned char* ws = A->ws;
    const bf16* proj = (const bf16*)(ws + WS_PROJ); const float* small = (const float*)(ws + WS_SMALL);
    LAS bf16* XT = (LAS bf16*)(lds + SA_XT); LAS bf16* BT = (LAS bf16*)(lds + SA_BT);
    LAS float* acs = (LAS float*)(lds + SA_ACS); LAS float* dtv = (LAS float*)(lds + SA_DTV);
    const int t0 = c * 128;
    { const int l = tid >> 2, hh = tid & 3, h = g * 4 + hh, t = t0 + l;
      const float raw = small[(size_t)t * 256 + h] + P.dt_bias[h];
      const float dt = raw > 20.f ? raw : log1pf(expf(raw));
      const float a = -expf(P.a_log[h]) * dt;
      dtv[l * 4 + hh] = dt; acs[l * 4 + hh] = a;
      ((float*)(ws + WS_DTV))[(size_t)t * 32 + h] = dt; }
    __syncthreads();
    if (wave < 4) {
        const int hh = wave; const float v0 = acs[(2 * lane) * 4 + hh], v1 = acs[(2 * lane + 1) * 4 + hh]; float s = v0 + v1;
#pragma unroll
        for (int d = 1; d < 64; d <<= 1) { const float t = __shfl_up(s, d); if (lane >= d) s += t; }
        const float ex = s - (v0 + v1);
        acs[(2 * lane) * 4 + hh] = ex + v0; acs[(2 * lane + 1) * 4 + hh] = ex + v0 + v1;
    }
    __syncthreads();
    { const int l = tid >> 2, hh = tid & 3; ((float*)(ws + WS_ACS))[(size_t)(t0 + l) * 32 + g * 4 + hh] = acs[l * 4 + hh];
      if (tid < 4) ((float*)(ws + WS_CD))[c * 32 + g * 4 + tid] = __expf(acs[127 * 4 + tid]); }
#pragma unroll 1
    for (int item = fresh(tid); item < 48 * 128; item += 512) {
        const int l = item & 127, v = item >> 7, t = t0 + l; float o[8];
        if (v < 32) { const int hh = v >> 3, ch = g * 256 + v * 8;
            conv8(proj, t, C_XA + ch, P.conv_w, P.conv_b, ch, o);
            const float sc = dtv[l * 4 + hh] * __expf(acs[127 * 4 + hh] - acs[l * 4 + hh]);
#pragma unroll
            for (int i = 0; i < 8; ++i) XT[(v * 8 + i) * 136 + l] = (bf16)f2bf(o[i] * sc);
        } else { const int n0 = (v - 32) * 8, ch = g * 128 + n0;
            conv8(proj, t, C_BA + ch, P.conv_w, P.conv_b, 2048 + ch, o);
#pragma unroll
            for (int i = 0; i < 8; ++i) BT[(n0 + i) * 136 + l] = (bf16)f2bf(o[i]);
        }
    }
    __syncthreads();
    { f32x4 acc[2][8];
#pragma unroll
      for (int a = 0; a < 2; ++a)
#pragma unroll
          for (int b = 0; b < 8; ++b) acc[a][b] = (f32x4){0.f, 0.f, 0.f, 0.f};
      const int fr = lane & 15, fq = lane >> 4;
#pragma unroll
      for (int ks = 0; ks < 4; ++ks) {
          bf16x8 xf[2];
#pragma unroll
          for (int a = 0; a < 2; ++a) xf[a] = ldfrag(XT, 136, wave * 32 + a * 16 + fr, ks * 32 + fq * 8);
#pragma unroll
          for (int b = 0; b < 8; ++b) { const bf16x8 yf = ldfrag(BT, 136, b * 16 + fr, ks * 32 + fq * 8);
#pragma unroll
              for (int a = 0; a < 2; ++a) acc[a][b] = mma16(xf[a], yf, acc[a][b]); }
      }
      const int hh = wave >> 1, h = g * 4 + hh;
      float* st = (float*)(ws + WS_ST) + ((size_t)(c * 32 + h) * 64) * 128;
#pragma unroll
      for (int a = 0; a < 2; ++a)
#pragma unroll
          for (int b = 0; b < 8; ++b)
#pragma unroll
              for (int r = 0; r < 4; ++r) { const int p = (wave & 1) * 32 + a * 16 + fq * 4 + r, n = b * 16 + fr; st[(size_t)p * 128 + n] = acc[a][b][r]; }
    }
    __syncthreads();
}

__device__ __forceinline__ void ssd_scan(ArgsP A, int tid, int bid, int G) {
    float* st = (float*)(A->ws + WS_ST); const float* cd = (const float*)(A->ws + WS_CD);
    for (int i = bid * 512 + tid; i < 32 * 64 * 128 / 4; i += G * 512) {
        const int h = i / 2048; f32x4 run = {0.f, 0.f, 0.f, 0.f};
#pragma unroll 16
        for (int c = 0; c < 64; ++c) { f32x4* p = (f32x4*)(st + (size_t)c * 32 * 64 * 128) + i; const f32x4 s = *p; const float d = cd[c * 32 + h]; *p = run; run = run * d + s; }
    }
}

constexpr int SC_CM = 0, SC_BM = 34816, SC_MH = 69632, SC_XT = 104448, SC_PV = 121856, SC_ACS = 139264, SC_DTV = 141312;
__device__ __forceinline__ void ssd_out_unit(ArgsP A, const LayerP& P, float* rowss, LAS unsigned char* lds, int c, int g, int tid, int lane, int wave) {
    tid = fresh(tid); lane = fresh(lane); wave = fresh_s(wave);
    unsigned char* ws = A->ws;
    const bf16* proj = (const bf16*)(ws + WS_PROJ);
    LAS bf16* CM = (LAS bf16*)(lds + SC_CM); LAS bf16* BM = (LAS bf16*)(lds + SC_BM); LAS bf16* MH = (LAS bf16*)(lds + SC_MH);
    LAS bf16* XT = (LAS bf16*)(lds + SC_XT); LAS bf16* PV = (LAS bf16*)(lds + SC_PV);
    LAS float* acs = (LAS float*)(lds + SC_ACS); LAS float* dtv = (LAS float*)(lds + SC_DTV);
    const int t0 = c * 128, fr = lane & 15, fq = lane >> 4;
    { const int l = tid >> 2, hh = tid & 3; acs[l * 4 + hh] = ((const float*)(ws + WS_ACS))[(size_t)(t0 + l) * 32 + g * 4 + hh]; dtv[l * 4 + hh] = ((const float*)(ws + WS_DTV))[(size_t)(t0 + l) * 32 + g * 4 + hh]; }
#pragma unroll 1
    for (int item = fresh(tid); item < 32 * 128; item += 512) {
        const int l = item & 127, v = item >> 7, t = t0 + l; float o[8];
        const int n0 = (v & 15) * 8, ch = g * 128 + n0;
        if (v < 16) conv8(proj, t, C_BA + ch, P.conv_w, P.conv_b, 2048 + ch, o); else conv8(proj, t, C_CA + ch, P.conv_w, P.conv_b, 3072 + ch, o);
        u32x4 w; w.x = pk2(o[0], o[1]); w.y = pk2(o[2], o[3]); w.z = pk2(o[4], o[5]); w.w = pk2(o[6], o[7]);
        *(LAS u32x4*)((v < 16 ? BM : CM) + l * 136 + n0) = w;
    }
    __syncthreads();
    f32x4 cb[8];
#pragma unroll
    for (int b = 0; b < 8; ++b) cb[b] = (f32x4){0.f, 0.f, 0.f, 0.f};
#pragma unroll
    for (int ks = 0; ks < 4; ++ks) { const bf16x8 xf = ldfrag(CM, 136, wave * 16 + fr, ks * 32 + fq * 8);
#pragma unroll
        for (int b = 0; b < 8; ++b) cb[b] = mma16(xf, ldfrag(BM, 136, b * 16 + fr, ks * 32 + fq * 8), cb[b]); }
    float ssq[4] = {0.f, 0.f, 0.f, 0.f};
    for (int hh = 0; hh < 4; ++hh) {
        const int h = g * 4 + hh;
#pragma unroll 1
        for (int item = fresh(tid); item < 8 * 128; item += 512) { const int l = item & 127, v = item >> 7, ch = h * 64 + v * 8; float o[8];
            conv8(proj, t0 + l, C_XA + ch, P.conv_w, P.conv_b, ch, o);
#pragma unroll
            for (int i = 0; i < 8; ++i) XT[(v * 8 + i) * 136 + l] = (bf16)f2bf(o[i]); }
        { const float* st = (const float*)(ws + WS_ST) + ((size_t)(c * 32 + h) * 64) * 128;
#pragma unroll 1
          for (int item = fresh(tid); item < 64 * 16; item += 512) { const int p = item >> 4, n0 = (item & 15) * 8;
              const f32x4 a = *(const f32x4*)(st + p * 128 + n0), b = *(const f32x4*)(st + p * 128 + n0 + 4);
              u32x4 w; w.x = pk2(a[0], a[1]); w.y = pk2(a[2], a[3]); w.z = pk2(b[0], b[1]); w.w = pk2(b[2], b[3]);
              *(LAS u32x4*)(PV + p * 136 + n0) = w; } }
#pragma unroll
        for (int b = 0; b < 8; ++b)
#pragma unroll
            for (int r = 0; r < 4; ++r) { const int l = wave * 16 + fq * 4 + r, s = b * 16 + fr;
                const float v = (s <= l) ? cb[b][r] * __expf(acs[l * 4 + hh] - acs[s * 4 + hh]) * dtv[s * 4 + hh] : 0.f;
                MH[l * 136 + s] = (bf16)f2bf(v); }
        __syncthreads();
        f32x4 yd[4], yo[4];
#pragma unroll
        for (int b = 0; b < 4; ++b) { yd[b] = (f32x4){0.f, 0.f, 0.f, 0.f}; yo[b] = (f32x4){0.f, 0.f, 0.f, 0.f}; }
#pragma unroll
        for (int ks = 0; ks < 4; ++ks) { const bf16x8 mf = ldfrag(MH, 136, wave * 16 + fr, ks * 32 + fq * 8), cf = ldfrag(CM, 136, wave * 16 + fr, ks * 32 + fq * 8);
#pragma unroll
            for (int b = 0; b < 4; ++b) { yd[b] = mma16(mf, ldfrag(XT, 136, b * 16 + fr, ks * 32 + fq * 8), yd[b]); yo[b] = mma16(cf, ldfrag(PV, 136, b * 16 + fr, ks * 32 + fq * 8), yo[b]); } }
        const float dsk = P.d_skip[h];
#pragma unroll
        for (int r = 0; r < 4; ++r) { const int l = wave * 16 + fq * 4 + r, t = t0 + l; const float ea = __expf(acs[l * 4 + hh]);
#pragma unroll
            for (int b = 0; b < 4; ++b) { const int p = b * 16 + fr, ch = h * 64 + p;
                const float xs = bf2f(XT[p * 136 + l]);
                const float y = yd[b][r] + yo[b][r] * ea + xs * dsk;
                const float z = bf2f(proj[(size_t)t * NPROJ + C_ZA + ch]);
                const float yg = y * siluf(z);
                ssq[r] += yg * yg;
                ((bf16*)(ws + WS_YA))[(size_t)t * DM + ch] = (bf16)f2bf(yg * P.ssm_norm[ch]); } }
        __syncthreads();
    }
#pragma unroll
    for (int r = 0; r < 4; ++r) { float s = ssq[r]; s += __shfl_xor(s, 1); s += __shfl_xor(s, 2); s += __shfl_xor(s, 4); s += __shfl_xor(s, 8);
        if (fr == 0) atomicAdd(rowss + t0 + wave * 16 + fq * 4 + r, s); }
}

__device__ __forceinline__ float ret_logg(int h) { return log1pf(-exp2f(-5.0f - (float)h)); }
__device__ __forceinline__ void rotary8(const u32x4 v, int t, int d0, float sc, const LAS float* invt, float (&o)[8]) {
    const float x[8] = {blo(v.x), bhi(v.x), blo(v.y), bhi(v.y), blo(v.z), bhi(v.z), blo(v.w), bhi(v.w)};
#pragma unroll
    for (int i = 0; i < 4; ++i) { const int pi = (d0 >> 1) + i;
        const float inv = invt[pi];
        float sn, cs; sincosf((float)t * inv, &sn, &cs);
        o[2 * i] = (x[2 * i] * cs - x[2 * i + 1] * sn) * sc; o[2 * i + 1] = (x[2 * i] * sn + x[2 * i + 1] * cs) * sc; }
}
constexpr int RA_VT = 0, RA_KT = 69632;
__device__ __forceinline__ void ret_kv_unit(ArgsP A, LAS unsigned char* lds, int c, int h, int tid, int lane, int wave) {
    tid = fresh(tid); lane = fresh(lane); wave = fresh_s(wave);
    unsigned char* ws = A->ws; const bf16* proj = (const bf16*)(ws + WS_PROJ);
    LAS bf16* VT = (LAS bf16*)(lds + RA_VT); LAS bf16* KT = (LAS bf16*)(lds + RA_KT);
    const int t0 = c * 128; const float lg = ret_logg(h);
#pragma unroll 1
    for (int item = fresh(tid); item < 64 * 128; item += 512) { const int j = item & 127, v = item >> 7, t = t0 + j;
        if (v < 32) { const u32x4 w = *(const u32x4*)(proj + (size_t)t * NPROJ + C_VC + h * 256 + v * 8);
            VT[(v * 8 + 0) * 136 + j] = (bf16)(w.x & 0xffff); VT[(v * 8 + 1) * 136 + j] = (bf16)(w.x >> 16); VT[(v * 8 + 2) * 136 + j] = (bf16)(w.y & 0xffff); VT[(v * 8 + 3) * 136 + j] = (bf16)(w.y >> 16);
            VT[(v * 8 + 4) * 136 + j] = (bf16)(w.z & 0xffff); VT[(v * 8 + 5) * 136 + j] = (bf16)(w.z >> 16); VT[(v * 8 + 6) * 136 + j] = (bf16)(w.w & 0xffff); VT[(v * 8 + 7) * 136 + j] = (bf16)(w.w >> 16);
        } else { const int d0 = (v - 32) * 8; const u32x4 w = *(const u32x4*)(proj + (size_t)t * NPROJ + C_KC + h * 256 + d0); float o[8];
            rotary8(w, t, d0, 0.0625f * __expf(lg * (float)(127 - j)), (const LAS float*)(lds + MISC_OFF + 512), o);
#pragma unroll
            for (int i = 0; i < 8; ++i) KT[(d0 + i) * 136 + j] = (bf16)f2bf(o[i]); }
    }
    __syncthreads();
    const int fr = lane & 15, fq = lane >> 4;
    float* out = (float*)(ws + WS_KVT) + (size_t)(c * 8 + h) * 65536;
    for (int half = 0; half < 2; ++half) {
        f32x4 acc[2][8];
#pragma unroll
        for (int a = 0; a < 2; ++a)
#pragma unroll
            for (int b = 0; b < 8; ++b) acc[a][b] = (f32x4){0.f, 0.f, 0.f, 0.f};
#pragma unroll
        for (int ks = 0; ks < 4; ++ks) { bf16x8 xf[2];
#pragma unroll
            for (int a = 0; a < 2; ++a) xf[a] = ldfrag(VT, 136, wave * 32 + a * 16 + fr, ks * 32 + fq * 8);
#pragma unroll
            for (int b = 0; b < 8; ++b) { const bf16x8 yf = ldfrag(KT, 136, half * 128 + b * 16 + fr, ks * 32 + fq * 8);
#pragma unroll
                for (int a = 0; a < 2; ++a) acc[a][b] = mma16(xf[a], yf, acc[a][b]); } }
#pragma unroll
        for (int a = 0; a < 2; ++a)
#pragma unroll
            for (int b = 0; b < 8; ++b)
#pragma unroll
                for (int r = 0; r < 4; ++r) { const int e = wave * 32 + a * 16 + fq * 4 + r, d = half * 128 + b * 16 + fr; out[(size_t)e * 256 + d] = acc[a][b][r]; }
    }
    __syncthreads();
}
__device__ __forceinline__ void ret_scan(ArgsP A, int tid, int bid, int G) {
    float* kv = (float*)(A->ws + WS_KVT);
    for (int i = bid * 512 + tid; i < 8 * 65536 / 4; i += G * 512) {
        const int h = i / 16384; const float d = __expf(ret_logg(h) * 128.0f); f32x4 run = {0.f, 0.f, 0.f, 0.f};
#pragma unroll 16
        for (int c = 0; c < 64; ++c) { f32x4* p = (f32x4*)(kv + (size_t)c * 8 * 65536) + i; const f32x4 s = *p; *p = run; run = run * d + s; }
    }
}
constexpr int RC_Q = 0, RC_K = 67584, RC_S = 67584, RC_VT = 102400, RC_RT = 67584;
__device__ __forceinline__ void ret_out_unit(ArgsP A, const LayerP& P, LAS unsigned char* lds, int c, int h, int tid, int lane, int wave) {
    tid = fresh(tid); lane = fresh(lane); wave = fresh_s(wave);
    unsigned char* ws = A->ws; const bf16* proj = (const bf16*)(ws + WS_PROJ);
    LAS bf16* Q = (LAS bf16*)(lds + RC_Q); LAS bf16* K = (LAS bf16*)(lds + RC_K); LAS bf16* S = (LAS bf16*)(lds + RC_S);
    LAS bf16* VT = (LAS bf16*)(lds + RC_VT); LAS bf16* RT = (LAS bf16*)(lds + RC_RT);
    const int t0 = c * 128, fr = lane & 15, fq = lane >> 4; const float lg = ret_logg(h);
#pragma unroll 1
    for (int item = fresh(tid); item < 64 * 128; item += 512) { const int j = item & 127, v = item >> 7, t = t0 + j, d0 = (v & 31) * 8; float o[8];
        const u32x4 w = *(const u32x4*)(proj + (size_t)t * NPROJ + (v < 32 ? C_QC : C_KC) + h * 256 + d0);
        rotary8(w, t, d0, v < 32 ? 1.0f : 0.0625f, (const LAS float*)(lds + MISC_OFF + 512), o);
        u32x4 pw; pw.x = pk2(o[0], o[1]); pw.y = pk2(o[2], o[3]); pw.z = pk2(o[4], o[5]); pw.w = pk2(o[6], o[7]);
        *(LAS u32x4*)((v < 32 ? Q : K) + j * 264 + d0) = pw; }
    __syncthreads();
    f32x4 sc[8];
#pragma unroll
    for (int b = 0; b < 8; ++b) sc[b] = (f32x4){0.f, 0.f, 0.f, 0.f};
#pragma unroll
    for (int ks = 0; ks < 8; ++ks) { const bf16x8 xf = ldfrag(Q, 264, wave * 16 + fr, ks * 32 + fq * 8);
#pragma unroll
        for (int b = 0; b < 8; ++b) sc[b] = mma16(xf, ldfrag(K, 264, b * 16 + fr, ks * 32 + fq * 8), sc[b]); }
    __syncthreads();
#pragma unroll
    for (int b = 0; b < 8; ++b)
#pragma unroll
        for (int r = 0; r < 4; ++r) { const int i = wave * 16 + fq * 4 + r, j = b * 16 + fr;
            S[i * 136 + j] = (bf16)f2bf(i >= j ? sc[b][r] * __expf(lg * (float)(i - j)) : 0.f); }
    f32x4 o[16];
#pragma unroll
    for (int b = 0; b < 16; ++b) o[b] = (f32x4){0.f, 0.f, 0.f, 0.f};
#pragma unroll
    for (int eh = 0; eh < 2; ++eh) {
#pragma unroll 1
        for (int item = fresh(tid); item < 16 * 128; item += 512) { const int j = item & 127, v = item >> 7;
            const u32x4 w = *(const u32x4*)(proj + (size_t)(t0 + j) * NPROJ + C_VC + h * 256 + eh * 128 + v * 8);
            VT[(v * 8 + 0) * 136 + j] = (bf16)(w.x & 0xffff); VT[(v * 8 + 1) * 136 + j] = (bf16)(w.x >> 16); VT[(v * 8 + 2) * 136 + j] = (bf16)(w.y & 0xffff); VT[(v * 8 + 3) * 136 + j] = (bf16)(w.y >> 16);
            VT[(v * 8 + 4) * 136 + j] = (bf16)(w.z & 0xffff); VT[(v * 8 + 5) * 136 + j] = (bf16)(w.z >> 16); VT[(v * 8 + 6) * 136 + j] = (bf16)(w.w & 0xffff); VT[(v * 8 + 7) * 136 + j] = (bf16)(w.w >> 16); }
        __syncthreads();
#pragma unroll
        for (int ks = 0; ks < 4; ++ks) { const bf16x8 xf = ldfrag(S, 136, wave * 16 + fr, ks * 32 + fq * 8);
#pragma unroll
            for (int b = 0; b < 8; ++b) o[eh * 8 + b] = mma16(xf, ldfrag(VT, 136, b * 16 + fr, ks * 32 + fq * 8), o[eh * 8 + b]); }
        __syncthreads();
    }
    const float* kvt = (const float*)(ws + WS_KVT) + (size_t)(c * 8 + h) * 65536;
    float xi[4];
#pragma unroll
    for (int r = 0; r < 4; ++r) xi[r] = __expf(lg * (float)(wave * 16 + fq * 4 + r + 1));
#pragma unroll
    for (int eq = 0; eq < 4; ++eq) {
#pragma unroll 1
        for (int item = fresh(tid); item < 64 * 32; item += 512) { const int e = item >> 5, d0 = (item & 31) * 8;
            const f32x4 a = *(const f32x4*)(kvt + (size_t)(eq * 64 + e) * 256 + d0), b = *(const f32x4*)(kvt + (size_t)(eq * 64 + e) * 256 + d0 + 4);
            u32x4 w; w.x = pk2(a[0], a[1]); w.y = pk2(a[2], a[3]); w.z = pk2(b[0], b[1]); w.w = pk2(b[2], b[3]);
            *(LAS u32x4*)(RT + e * 264 + d0) = w; }
        __syncthreads();
        f32x4 cr[4];
#pragma unroll
        for (int b = 0; b < 4; ++b) cr[b] = (f32x4){0.f, 0.f, 0.f, 0.f};
#pragma unroll
        for (int ks = 0; ks < 8; ++ks) { const bf16x8 xf = ldfrag(Q, 264, wave * 16 + fr, ks * 32 + fq * 8);
#pragma unroll
            for (int b = 0; b < 4; ++b) cr[b] = mma16(xf, ldfrag(RT, 264, b * 16 + fr, ks * 32 + fq * 8), cr[b]); }
#pragma unroll
        for (int b = 0; b < 4; ++b)
#pragma unroll
            for (int r = 0; r < 4; ++r) o[eq * 4 + b][r] += cr[b][r] * xi[r];
        __syncthreads();
    }
#pragma unroll
    for (int r = 0; r < 4; ++r) {
        float s = 0.f;
#pragma unroll
        for (int b = 0; b < 16; ++b) s += o[b][r];
        s += __shfl_xor(s, 1); s += __shfl_xor(s, 2); s += __shfl_xor(s, 4); s += __shfl_xor(s, 8);
        const float mu = s * (1.0f / 256.0f); float q = 0.f;
#pragma unroll
        for (int b = 0; b < 16; ++b) { const float d = o[b][r] - mu; q += d * d; }
        q += __shfl_xor(q, 1); q += __shfl_xor(q, 2); q += __shfl_xor(q, 4); q += __shfl_xor(q, 8);
        const float rs = rsqrtf(q * (1.0f / 256.0f) + EPS);
        const int t = t0 + wave * 16 + fq * 4 + r;
#pragma unroll
        for (int b = 0; b < 16; ++b) { const int ch = h * 256 + b * 16 + fr;
            const float z = bf2f(proj[(size_t)t * NPROJ + C_ZC + ch]);
            ((bf16*)(ws + WS_YC))[(size_t)t * DM + ch] = (bf16)f2bf((o[b][r] - mu) * rs * P.ret_norm[ch] * siluf(z)); }
    }
    __syncthreads();
}

__device__ __forceinline__ void nsa_im2col(ArgsP A, int tid, int bid, int G) {
    const bf16* proj = (const bf16*)(A->ws + WS_PROJ); u32x4* aim = (u32x4*)(A->ws + WS_AIM);
    const size_t nvec = (size_t)2 * 2048 * 512;
    for (size_t i = (size_t)bid * 512 + tid; i < nvec; i += (size_t)G * 512) {
        const int s = (int)(i >> 20), row = (int)((i >> 9) & 2047), kv = (int)(i & 511), l = kv >> 4, d0 = (kv & 15) * 8, n = row >> 2, hk = row & 3;
        u32x4 v = {0u, 0u, 0u, 0u};
        if (row < NCMP * 4) v = *(const u32x4*)(proj + (size_t)(n * 16 + l) * NPROJ + (s ? C_VCB : C_KCB) + hk * 128 + d0);
        aim[i] = v;
    }
}

constexpr int NA_Q = 0, NA_K = 34816, NA_VT = 52224, NA_S = 70656, NA_P = 105472, NA_M = 123904, NA_L = 124416, NA_AL = 124928, NA_IMP = 125440, NA_SEL = 141824, NA_ANY = 142336;
__device__ __forceinline__ void na_stage_kv(const bf16* kbase, const bf16* vbase, size_t rstride, int row0, int rowstep, int maxrow, LAS bf16* Kt, LAS bf16* Vt, int tid, bool with_v) {
#pragma unroll 1
    for (int item = fresh(tid); item < 1024; item += 512) { const int kk = item >> 4, d0 = (item & 15) * 8; int row = row0 + kk * rowstep; row = row < 0 ? 0 : (row > maxrow ? maxrow : row);
        *(LAS u32x4*)(Kt + kk * 136 + d0) = *(const u32x4*)(kbase + (size_t)row * rstride + d0); }
    if (with_v) {
#pragma unroll 1
    for (int item = fresh(tid); item < 1024; item += 512) { const int kk = item & 63, d0 = (item >> 6) * 8; int row = row0 + kk * rowstep; row = row < 0 ? 0 : (row > maxrow ? maxrow : row);
        const u32x4 w = *(const u32x4*)(vbase + (size_t)row * rstride + d0);
        Vt[(d0 + 0) * 72 + kk] = (bf16)(w.x & 0xffff); Vt[(d0 + 1) * 72 + kk] = (bf16)(w.x >> 16); Vt[(d0 + 2) * 72 + kk] = (bf16)(w.y & 0xffff); Vt[(d0 + 3) * 72 + kk] = (bf16)(w.y >> 16);
        Vt[(d0 + 4) * 72 + kk] = (bf16)(w.z & 0xffff); Vt[(d0 + 5) * 72 + kk] = (bf16)(w.z >> 16); Vt[(d0 + 6) * 72 + kk] = (bf16)(w.w & 0xffff); Vt[(d0 + 7) * 72 + kk] = (bf16)(w.w >> 16); } }
}
__device__ __forceinline__ void na_scores(const LAS bf16* Q, const LAS bf16* Kt, LAS float* S, int lane, int wave) {
    const int fr = lane & 15, fq = lane >> 4; f32x4 acc[4];
#pragma unroll
    for (int b = 0; b < 4; ++b) acc[b] = (f32x4){0.f, 0.f, 0.f, 0.f};
#pragma unroll
    for (int ks = 0; ks < 4; ++ks) { const bf16x8 xf = ldfrag(Q, 136, wave * 16 + fr, ks * 32 + fq * 8);
#pragma unroll
        for (int b = 0; b < 4; ++b) acc[b] = mma16(xf, ldfrag(Kt, 136, b * 16 + fr, ks * 32 + fq * 8), acc[b]); }
#pragma unroll
    for (int b = 0; b < 4; ++b)
#pragma unroll
        for (int r = 0; r < 4; ++r) S[(wave * 16 + fq * 4 + r) * 68 + b * 16 + fr] = acc[b][r] * 0.08838834764831845f;
}
template <int KIND> __device__ __forceinline__ bool na_valid(int t, int kidx, const LAS unsigned* selrow, int j) {
    if (KIND == 0) return kidx < NCMP && kidx * 16 + 31 <= t;
    if (KIND == 1) return ((selrow[j >> 5] >> (j & 31)) & 1u) && kidx <= t;
    return kidx <= t && kidx > t - 512 && kidx >= 0;
}
template <int KIND> __device__ __forceinline__ void na_softmax_online(LAS float* S, LAS bf16* Pm, LAS float* M, LAS float* Ls, LAS float* AL, const LAS unsigned* SEL, int t0, int kidx0, int j, int tid) {
    const int row = tid >> 2, q = tid & 3, tt = row >> 2, t = t0 + tt; const LAS unsigned* selrow = SEL + tt * 4;
    float sv[16]; float mx = -1e30f;
#pragma unroll
    for (int i = 0; i < 16; ++i) { const int col = q * 16 + i; const bool ok = na_valid<KIND>(t, kidx0 + col, selrow, j); sv[i] = ok ? S[row * 68 + col] : -1e30f; mx = fmaxf(mx, sv[i]); }
    mx = fmaxf(mx, __shfl_xor(mx, 1)); mx = fmaxf(mx, __shfl_xor(mx, 2));
    const float mo = M[row], mn = fmaxf(mo, mx); float ps = 0.f;
#pragma unroll
    for (int i = 0; i < 16; i += 2) { const float p0 = sv[i] > -1e29f ? __expf(sv[i] - mn) : 0.f, p1 = sv[i + 1] > -1e29f ? __expf(sv[i + 1] - mn) : 0.f; ps += p0 + p1;
        *(LAS unsigned*)(Pm + row * 72 + q * 16 + i) = pk2(p0, p1); }
    ps += __shfl_xor(ps, 1); ps += __shfl_xor(ps, 2);
    if (q == 0) { const float al = __expf(mo - mn); AL[row] = al; Ls[row] = Ls[row] * al + ps; M[row] = mn; }
}
__device__ __forceinline__ void na_pv(f32x4 (&O)[8], const LAS bf16* Pm, const LAS bf16* Vt, const LAS float* AL, bool rescale, int lane, int wave) {
    const int fr = lane & 15, fq = lane >> 4;
    if (rescale) {
#pragma unroll
        for (int r = 0; r < 4; ++r) { const float al = AL[wave * 16 + fq * 4 + r];
#pragma unroll
            for (int b = 0; b < 8; ++b) O[b][r] *= al; } }
#pragma unroll
    for (int ks = 0; ks < 2; ++ks) { const bf16x8 xf = ldfrag(Pm, 72, wave * 16 + fr, ks * 32 + fq * 8);
#pragma unroll
        for (int b = 0; b < 8; ++b) O[b] = mma16(xf, ldfrag(Vt, 72, b * 16 + fr, ks * 32 + fq * 8), O[b]); }
}
__device__ __forceinline__ void na_reset_stats(LAS float* M, LAS float* Ls, int tid) { if (tid < 128) { M[tid] = -1e30f; Ls[tid] = 0.f; } }
__device__ __forceinline__ void na_combine(f32x4 (&comb)[8], f32x4 (&O)[8], const LAS float* Ls, const float* small, int t0, int g, int branch, int lane, int wave) {
    const int fq = lane >> 4;
#pragma unroll
    for (int r = 0; r < 4; ++r) { const int row = wave * 16 + fq * 4 + r, tt = row >> 2, hr = row & 3; const float l = Ls[row];
        const float gate = sigm(small[(size_t)(t0 + tt) * 256 + 32 + (g * 4 + hr) * 3 + branch]);
        const float f = l > 0.f ? gate / l : 0.f;
#pragma unroll
        for (int b = 0; b < 8; ++b) { comb[b][r] += O[b][r] * f; O[b][r] = 0.f; } }
}

__device__ __forceinline__ void nsa_attn_unit(ArgsP A, LAS unsigned char* lds, int qt, int g, int tid, int lane, int wave) {
    tid = fresh(tid); lane = fresh(lane); wave = fresh_s(wave);
    unsigned char* ws = A->ws; const bf16* proj = (const bf16*)(ws + WS_PROJ); const float* small = (const float*)(ws + WS_SMALL);
    LAS bf16* Q = (LAS bf16*)(lds + NA_Q); LAS bf16* Kt = (LAS bf16*)(lds + NA_K); LAS bf16* Vt = (LAS bf16*)(lds + NA_VT);
    LAS float* S = (LAS float*)(lds + NA_S); LAS bf16* Pm = (LAS bf16*)(lds + NA_P);
    LAS float* M = (LAS float*)(lds + NA_M); LAS float* Ls = (LAS float*)(lds + NA_L); LAS float* AL = (LAS float*)(lds + NA_AL);
    LAS float* IMP = (LAS float*)(lds + NA_IMP); LAS unsigned* SEL = (LAS unsigned*)(lds + NA_SEL); LAS unsigned* ANY = (LAS unsigned*)(lds + NA_ANY);
    const int t0 = qt * 32, tlast = t0 + 31, fr = lane & 15, fq = lane >> 4;
#pragma unroll 1
    for (int item = fresh(tid); item < 128 * 16; item += 512) { const int row = item >> 4, d0 = (item & 15) * 8, tt = row >> 2, hr = row & 3;
        *(LAS u32x4*)(Q + row * 136 + d0) = *(const u32x4*)(proj + (size_t)(t0 + tt) * NPROJ + C_QB + (g * 4 + hr) * 128 + d0); }
    for (int i = tid; i < 32 * 128; i += 512) IMP[i] = 0.f;
    if (tid < 128) { SEL[tid] = 0u; ANY[tid] = 0u; }
    na_reset_stats(M, Ls, tid);
    f32x4 O[8], comb[8];
#pragma unroll
    for (int b = 0; b < 8; ++b) { O[b] = (f32x4){0.f, 0.f, 0.f, 0.f}; comb[b] = (f32x4){0.f, 0.f, 0.f, 0.f}; }
    __syncthreads();
    const bf16* kcmp = (const bf16*)(ws + WS_KVC) + g * 128; const bf16* vcmp = (const bf16*)(ws + WS_KVC + 524288) + g * 128;
    const int ncmp_tiles = tlast >= 31 ? ((tlast - 31) / 16) / 64 + 1 : 0;
    for (int kt = 0; kt < ncmp_tiles; ++kt) {
        na_stage_kv(kcmp, vcmp, 512, kt * 64, 1, NCMP - 1, Kt, Vt, tid, false);
        __syncthreads();
        na_scores(Q, Kt, S, lane, wave);
        __syncthreads();
        na_softmax_online<0>(S, Pm, M, Ls, AL, SEL, t0, kt * 64, 0, tid);
        __syncthreads();
    }
    for (int kt = 0; kt < ncmp_tiles; ++kt) {
        na_stage_kv(kcmp, vcmp, 512, kt * 64, 1, NCMP - 1, Kt, Vt, tid, true);
        __syncthreads();
        na_scores(Q, Kt, S, lane, wave);
        __syncthreads();
        { const int row = tid >> 2, q = tid & 3, t = t0 + (row >> 2); const float m = M[row], l = Ls[row], il = l > 0.f ? 1.0f / l : 0.f;
#pragma unroll
          for (int i = 0; i < 16; i += 2) { const int col = q * 16 + i;
              const float p0 = na_valid<0>(t, kt * 64 + col, SEL, 0) ? __expf(S[row * 68 + col] - m) * il : 0.f, p1 = na_valid<0>(t, kt * 64 + col + 1, SEL, 0) ? __expf(S[row * 68 + col + 1] - m) * il : 0.f;
              S[row * 68 + col] = p0; S[row * 68 + col + 1] = p1; *(LAS unsigned*)(Pm + row * 72 + col) = pk2(p0, p1); } }
        __syncthreads();
        na_pv(O, Pm, Vt, AL, false, lane, wave);
#pragma unroll 1
        for (int item = fresh(tid); item < 32 * 17; item += 512) { const int tt = item / 17, jj = item % 17, j = kt * 16 + jj;
            if (j < 128) { float s = 0.f;
#pragma unroll
                for (int dn = -1; dn < 4; ++dn) { const int col = 4 * jj + dn; if (col >= 0 && col < 64 && !(jj == 16 && dn >= 0)) {
#pragma unroll
                        for (int hr = 0; hr < 4; ++hr) s += S[(tt * 4 + hr) * 68 + col]; } }
                IMP[tt * 128 + j] += s; } }
        __syncthreads();
    }
    { const int fq2 = lane >> 4;
#pragma unroll
      for (int r = 0; r < 4; ++r) { const int row = wave * 16 + fq2 * 4 + r, tt = row >> 2, hr = row & 3;
          const float gate = sigm(small[(size_t)(t0 + tt) * 256 + 32 + (g * 4 + hr) * 3 + 0]);
#pragma unroll
          for (int b = 0; b < 8; ++b) { comb[b][r] += O[b][r] * gate; O[b][r] = 0.f; } } }
#pragma unroll 1
    for (int item = fresh(tid); item < 32 * 128; item += 512) { const int tt = item >> 7, j = item & 127, t = t0 + tt, cur = t >> 6;
        const bool forced = (j == 0) || (j == cur) || (j + 1 == cur); const bool elig = j <= cur;
        const float v = IMP[item]; IMP[item] = forced ? __builtin_inff() : (elig ? v : -__builtin_inff()); }
    __syncthreads();
#pragma unroll 1
    for (int item = fresh(tid); item < 32 * 128; item += 512) { const int tt = item >> 7, j = item & 127; const float v = IMP[item]; int rank = 0;
        for (int k = 0; k < 128; ++k) { const float u = IMP[tt * 128 + k]; rank += (u > v || (u == v && k < j)) ? 1 : 0; }
        if (rank < 16 && v > -__builtin_inff()) { __hip_atomic_fetch_or(SEL + tt * 4 + (j >> 5), 1u << (j & 31), __ATOMIC_RELAXED, __HIP_MEMORY_SCOPE_WORKGROUP); ANY[j] = 1u; } }
    na_reset_stats(M, Ls, tid);
    __syncthreads();
    const int curlast = tlast >> 6;
    for (int j = 0; j <= curlast; ++j) {
        if (ANY[j] == 0u) continue;
        na_stage_kv(proj + C_KSB + g * 128, proj + C_VSB + g * 128, NPROJ, j * 64, 1, L_SEQ - 1, Kt, Vt, tid, true);
        __syncthreads();
        na_scores(Q, Kt, S, lane, wave);
        __syncthreads();
        na_softmax_online<1>(S, Pm, M, Ls, AL, SEL, t0, j * 64, j, tid);
        __syncthreads();
        na_pv(O, Pm, Vt, AL, true, lane, wave);
        __syncthreads();
    }
    na_combine(comb, O, Ls, small, t0, g, 1, lane, wave);
    __syncthreads();
    na_reset_stats(M, Ls, tid);
    __syncthreads();
    { const int kmin = t0 - 511 > 0 ? t0 - 511 : 0;
      for (int jb = kmin >> 6; jb <= curlast; ++jb) {
        na_stage_kv(proj + C_KWB + g * 128, proj + C_VWB + g * 128, NPROJ, jb * 64, 1, L_SEQ - 1, Kt, Vt, tid, true);
        __syncthreads();
        na_scores(Q, Kt, S, lane, wave);
        __syncthreads();
        na_softmax_online<2>(S, Pm, M, Ls, AL, SEL, t0, jb * 64, 0, tid);
        __syncthreads();
        na_pv(O, Pm, Vt, AL, true, lane, wave);
        __syncthreads();
      } }
    na_combine(comb, O, Ls, small, t0, g, 2, lane, wave);
#pragma unroll
    for (int r = 0; r < 4; ++r) { const int row = wave * 16 + fq * 4 + r, tt = row >> 2, hr = row & 3, t = t0 + tt;
#pragma unroll
        for (int b = 0; b < 8; ++b) { const int ch = (g * 4 + hr) * 128 + b * 16 + fr;
            const float z = bf2f(proj[(size_t)t * NPROJ + C_ZB + ch]);
            ((bf16*)(ws + WS_YB))[(size_t)t * DM + ch] = (bf16)f2bf(comb[b][r] * siluf(z)); } }
    __syncthreads();
}

constexpr int NB_K = 0, NB_V = 16384, NB_STAGE = 32768, NB_IMP = 98304, NB_SEL = 131072;
typedef short s16x4 __attribute__((ext_vector_type(4)));
struct KVSrc { const bf16* k; const bf16* v; size_t rstride; int maxrow; };
__device__ __forceinline__ void glds16(const void* gsrc, unsigned lds_dst) {
    unsigned keep;
    asm volatile("s_mov_b32 %0, m0\n\ts_mov_b32 m0, %2\n\ts_nop 0\n\tglobal_load_lds_dwordx4 %1, off\n\ts_mov_b32 m0, %0" : "=&s"(keep) : "v"(gsrc), "s"(lds_dst) : "memory");
}
__device__ __forceinline__ void kv_dma(const KVSrc& s, int row0, LAS unsigned char* stage, int wave, int lane) {
#pragma unroll
    for (int i = 0; i < 2; ++i) { const int rb = 4 * (wave + 8 * i), r = rb + (lane >> 4), cp = lane & 15; int row = row0 + r; row = row < 0 ? 0 : (row > s.maxrow ? s.maxrow : row);
        const int ck = cp ^ (r & 15), cv = cp ^ ((r & 7) << 1);
        glds16(s.k + (size_t)row * s.rstride + ck * 8, (unsigned)(size_t)(stage + NB_K + rb * 256));
        glds16(s.v + (size_t)row * s.rstride + cv * 8, (unsigned)(size_t)(stage + NB_V + rb * 256)); }
}
template <int KIND> __device__ __forceinline__ bool nb_valid(int t, int kidx) {
    if (KIND == 0) return kidx < NCMP && kidx * 16 + 31 <= t;
    if (KIND == 1) return kidx <= t;
    return kidx <= t && kidx > t - 512 && kidx >= 0;
}
__device__ __forceinline__ float rows_max(float x) {
    auto r = __builtin_amdgcn_permlane16_swap(__float_as_uint(x), __float_as_uint(x), false, false); const float y = fmaxf(__uint_as_float(r[0]), __uint_as_float(r[1]));
    auto q = __builtin_amdgcn_permlane32_swap(__float_as_uint(y), __float_as_uint(y), false, false); return fmaxf(__uint_as_float(q[0]), __uint_as_float(q[1]));
}
__device__ __forceinline__ float rows_sum(float x) {
    auto r = __builtin_amdgcn_permlane16_swap(__float_as_uint(x), __float_as_uint(x), false, false); const float y = __uint_as_float(r[0]) + __uint_as_float(r[1]);
    auto q = __builtin_amdgcn_permlane32_swap(__float_as_uint(y), __float_as_uint(y), false, false); return __uint_as_float(q[0]) + __uint_as_float(q[1]);
}
constexpr float NB_SC = 0.12751743082459868f;
template <int KIND, int MODE>
__device__ __forceinline__ void flash_block(const LAS unsigned char* stage, const bf16x8 (&Q)[2][4], f32x4 (&O)[2][8], float (&m)[2], float (&l)[2], const float (&il)[2],
                                            int kidx0, const int (&trow)[2], const bool (&lane_ok)[2], const bool (&act)[2], bool full, LAS float* IMP, int tokl0, int lane) {
    const int fr = lane & 15, fq = lane >> 4;
    const LAS unsigned char* Kb = stage + NB_K + fr * 256; const LAS unsigned char* Vb = stage + NB_V;
#define NB_KFRAG(t, ks) (*(const LAS bf16x8*)(Kb + (t) * 4096 + (((4 * (ks) + fq) ^ fr) << 4)))
    f32x4 S[2][4];
#pragma unroll
    for (int rg = 0; rg < 2; ++rg)
#pragma unroll
        for (int t = 0; t < 4; ++t) S[rg][t] = (f32x4){0.f, 0.f, 0.f, 0.f};
    if (act[0] || act[1]) {
#pragma unroll
        for (int ks = 0; ks < 4; ++ks) {
            bf16x8 kf[4];
#pragma unroll
            for (int t = 0; t < 4; ++t) kf[t] = NB_KFRAG(t, ks);
            __builtin_amdgcn_sched_barrier(0);
#pragma unroll
            for (int t = 0; t < 4; ++t) { S[0][t] = mma16(kf[t], Q[0][ks], S[0][t]); S[1][t] = mma16(kf[t], Q[1][ks], S[1][t]); }
            __builtin_amdgcn_sched_barrier(0);
        }
    }
    __builtin_amdgcn_sched_barrier(0);
    bf16x8 P[2][2];
    const float NINF = -__builtin_inff();
#pragma unroll
    for (int rg = 0; rg < 2; ++rg) {
        float mx = NINF;
        if (full) {
#pragma unroll
            for (int t = 0; t < 4; ++t)
#pragma unroll
                for (int r = 0; r < 4; ++r) mx = fmaxf(mx, S[rg][t][r]);
        } else {
#pragma unroll
            for (int t = 0; t < 4; ++t)
#pragma unroll
                for (int r = 0; r < 4; ++r) { const bool ok = nb_valid<KIND>(trow[rg], kidx0 + 16 * t + 4 * fq + r); const float sv = ok ? S[rg][t][r] : NINF; S[rg][t][r] = sv; mx = fmaxf(mx, sv); }
        }
        if (KIND == 1) mx = lane_ok[rg] ? mx : NINF;
        float mn, scale_l = 1.0f;
        if (MODE == 2) { mn = m[rg]; scale_l = il[rg]; }
        else { mx = rows_max(mx) * NB_SC; mn = fmaxf(m[rg], mx); }
        const float mne = (KIND == 1) ? (lane_ok[rg] ? mn : 1e30f) : mn;
        float ps = 0.f;
#pragma unroll
        for (int t = 0; t < 4; ++t)
#pragma unroll
            for (int r = 0; r < 4; ++r) { float p = __builtin_amdgcn_exp2f(__builtin_fmaf(S[rg][t][r], NB_SC, -mne)); if (MODE == 2) p *= scale_l; ps += p; S[rg][t][r] = p; }
        if (MODE != 2) { const float al = __builtin_amdgcn_exp2f(m[rg] - mn); m[rg] = mn; l[rg] = l[rg] * al + ps;
            if (MODE == 0 && !__all(al == 1.0f)) {
#pragma unroll
                for (int dt = 0; dt < 8; ++dt) O[rg][dt] *= al; } }
        if (MODE == 2) {
#pragma unroll
            for (int t = 0; t < 4; ++t) { float G = (S[rg][t][0] + S[rg][t][1]) + (S[rg][t][2] + S[rg][t][3]), last = S[rg][t][3];
                G += __shfl_xor(G, 1); G += __shfl_xor(G, 2); last += __shfl_xor(last, 1); last += __shfl_xor(last, 2);
                const int j = (kidx0 >> 2) + 4 * t + fq, tok = tokl0 + rg * 4 + (fr >> 2);
                if ((fr & 3) == 0 && j < 128) { IMP[tok * 128 + j] += G; if (j + 1 < 128) IMP[tok * 128 + j + 1] += last; } } }
        if (MODE != 1) {
#pragma unroll
            for (int s = 0; s < 2; ++s) { u32x4 w; w.x = pg8::cvt_pk_bf16(S[rg][2 * s][0], S[rg][2 * s][1]); w.y = pg8::cvt_pk_bf16(S[rg][2 * s][2], S[rg][2 * s][3]); w.z = pg8::cvt_pk_bf16(S[rg][2 * s + 1][0], S[rg][2 * s + 1][1]); w.w = pg8::cvt_pk_bf16(S[rg][2 * s + 1][2], S[rg][2 * s + 1][3]);
                P[rg][s] = __builtin_bit_cast(bf16x8, w); } }
    }
    __builtin_amdgcn_sched_barrier(0);
    if (MODE != 1) {
        const int a = fr >> 2, p4 = fr & 3;
        const int vrow = 4 * fq + a, vx = (vrow & 7) << 1, vlo = 8 * (p4 & 1);
#define NB_VFRAG(s, dt) const s16x4 v0 = __builtin_amdgcn_ds_read_tr16_b64_v4i16((LAS s16x4*)(Vb + (32 * (s) + vrow) * 256 + (((2 * (dt) + (p4 >> 1)) ^ vx) << 4) + vlo)); \
                const s16x4 v1 = __builtin_amdgcn_ds_read_tr16_b64_v4i16((LAS s16x4*)(Vb + (32 * (s) + 16 + vrow) * 256 + (((2 * (dt) + (p4 >> 1)) ^ vx) << 4) + vlo)); \
                const bf16x8 vf = {v0[0], v0[1], v0[2], v0[3], v1[0], v1[1], v1[2], v1[3]};
        if (act[0] || act[1]) {
#pragma unroll
            for (int s = 0; s < 2; ++s)
#pragma unroll
                for (int dh = 0; dh < 2; ++dh) {
                    bf16x8 vfr[4];
#pragma unroll
                    for (int d4 = 0; d4 < 4; ++d4) { NB_VFRAG(s, 4 * dh + d4) vfr[d4] = vf; }
                    __builtin_amdgcn_sched_barrier(0);
#pragma unroll
                    for (int d4 = 0; d4 < 4; ++d4) { O[0][4 * dh + d4] = mma16(vfr[d4], P[0][s], O[0][4 * dh + d4]); O[1][4 * dh + d4] = mma16(vfr[d4], P[1][s], O[1][4 * dh + d4]); }
                    __builtin_amdgcn_sched_barrier(0);
                }
        }
#undef NB_VFRAG
#undef NB_KFRAG
    }
}
template <int KIND, int MODE>
__device__ __forceinline__ void flash_pass(LAS unsigned char* lds, const KVSrc& src, int b0, int b1, const bf16x8 (&Q)[2][4], f32x4 (&O)[2][8], float (&m)[2], float (&l)[2], const float (&il)[2],
                                           const int (&trow)[2], int tokl0, int tmin, int tid, int lane) {
    LAS float* IMP = (LAS float*)(lds + NB_IMP); const LAS unsigned* SEL = (const LAS unsigned*)(lds + NB_SEL);
    if (b1 <= b0) return;
    const int wave = __builtin_amdgcn_readfirstlane(tid >> 6), nb = b1 - b0;
    kv_dma(src, b0 * 64, lds, wave, lane);
    if (nb > 1) { kv_dma(src, (b0 + 1) * 64, lds + NB_STAGE, wave, lane); asm volatile("s_waitcnt vmcnt(4)" ::: "memory"); } else asm volatile("s_waitcnt vmcnt(0)" ::: "memory");
    __builtin_amdgcn_s_barrier();
    int sc = 0;
    for (int i = 0; i < nb; ++i) {
        const int b = b0 + i; const bool more2 = i + 2 < nb;
        int s2 = sc + 2; s2 = s2 >= 3 ? s2 - 3 : s2;
        if (more2) kv_dma(src, (b + 2) * 64, lds + s2 * NB_STAGE, wave, lane);
        bool lane_ok[2] = {true, true}, act[2] = {true, true};
        if (KIND == 1) {
#pragma unroll
            for (int rg = 0; rg < 2; ++rg) { const int tok = tokl0 + rg * 4 + ((lane & 15) >> 2); lane_ok[rg] = (SEL[tok * 4 + (b >> 5)] >> (b & 31)) & 1u; act[rg] = __any(lane_ok[rg]); } }
        bool full;
        if (KIND == 0) full = (b * 64 + 63 < NCMP) && ((b * 64 + 63) * 16 + 31 <= tmin);
        else if (KIND == 1) full = b * 64 + 63 <= tmin;
        else full = (b * 64 + 63 <= tmin) && (b * 64 > tmin + 7 - 512);
        flash_block<KIND, MODE>(lds + sc * NB_STAGE, Q, O, m, l, il, b * 64, trow, lane_ok, act, full, IMP, tokl0, lane);
        if (more2) asm volatile("s_waitcnt vmcnt(4)" ::: "memory"); else asm volatile("s_waitcnt vmcnt(0)" ::: "memory");
        asm volatile("s_waitcnt lgkmcnt(0)" ::: "memory");
        __builtin_amdgcn_s_barrier();
        sc = sc + 1 == 3 ? 0 : sc + 1;
    }
}
__device__ __forceinline__ void nb_emit(unsigned char* ws, f32x4 (&O)[2][8], const float (&f)[2], const int (&trow)[2], int g, int mode, int lane) {
    const int fr = lane & 15, fq = lane >> 4; const bf16* proj = (const bf16*)(ws + WS_PROJ);
#pragma unroll
    for (int rg = 0; rg < 2; ++rg) { const int t = trow[rg], head = g * 4 + (fr & 3), ch0 = head * 128 + 4 * fq; float* tp = (float*)(ws + WS_TF) + (size_t)t * DM + ch0;
        f32x4 tv[8]; u32x2 zw[8];
#pragma unroll
        for (int dt = 0; dt < 8; ++dt) { tv[dt] = (f32x4){0.f, 0.f, 0.f, 0.f}; zw[dt] = (u32x2){0u, 0u}; }
        if (mode > 0) {
#pragma unroll
            for (int dt = 0; dt < 8; ++dt) tv[dt] = *(const f32x4*)(tp + 16 * dt); }
        if (mode == 2) {
#pragma unroll
            for (int dt = 0; dt < 8; ++dt) zw[dt] = *(const u32x2*)(proj + (size_t)t * NPROJ + C_ZB + ch0 + 16 * dt); }
#pragma unroll
        for (int dt = 0; dt < 8; ++dt) { const f32x4 v = O[rg][dt] * f[rg] + tv[dt];
            if (mode < 2) *(f32x4*)(tp + 16 * dt) = v;
            else { u32x2 w; w.x = pg8::cvt_pk_bf16(v[0] * siluf(blo(zw[dt].x)), v[1] * siluf(bhi(zw[dt].x))); w.y = pg8::cvt_pk_bf16(v[2] * siluf(blo(zw[dt].y)), v[3] * siluf(bhi(zw[dt].y)));
                *(u32x2*)((bf16*)(ws + WS_YB) + (size_t)t * DM + ch0 + 16 * dt) = w; }
            O[rg][dt] = (f32x4){0.f, 0.f, 0.f, 0.f}; } }
}
__device__ __forceinline__ float nb_rowsum(float l) { return rows_sum(l); }

__device__ __forceinline__ void nsa_attn2_unit(ArgsP A, LAS unsigned char* lds, int qt, int g, int tid, int lane, int wave) {
    tid = fresh(tid); lane = fresh(lane); wave = fresh_s(wave);
    unsigned char* ws = A->ws; const bf16* proj = (const bf16*)(ws + WS_PROJ); const float* small = (const float*)(ws + WS_SMALL);
    LAS float* IMP = (LAS float*)(lds + NB_IMP); LAS unsigned* SEL = (LAS unsigned*)(lds + NB_SEL);
    const int t0 = qt * 64, tlast = t0 + 63, fr = lane & 15, fq = lane >> 4, tokl0 = wave * 8;
    int trow[2]; trow[0] = t0 + tokl0 + (fr >> 2); trow[1] = trow[0] + 4;
    bf16x8 Q[2][4];
#pragma unroll
    for (int rg = 0; rg < 2; ++rg)
#pragma unroll
        for (int ks = 0; ks < 4; ++ks) Q[rg][ks] = *(const bf16x8*)(proj + (size_t)trow[rg] * NPROJ + C_QB + (g * 4 + (fr & 3)) * 128 + 32 * ks + 8 * fq);
#pragma unroll
    for (int rg = 0; rg < 2; ++rg)
#pragma unroll
        for (int ks = 0; ks < 4; ++ks) asm volatile("" : "+v"(Q[rg][ks]));
    for (int i = tid; i < 64 * 128; i += 512) IMP[i] = 0.f;
    if (tid < 256) SEL[tid] = 0u;
    f32x4 O[2][8];
#pragma unroll
    for (int rg = 0; rg < 2; ++rg)
#pragma unroll
        for (int dt = 0; dt < 8; ++dt) O[rg][dt] = (f32x4){0.f, 0.f, 0.f, 0.f};
    float m[2], l[2], il[2] = {0.f, 0.f}, gate[2], f[2];
    const int curlast = tlast >> 6;
    { m[0] = m[1] = -1e30f; l[0] = l[1] = 0.f;
      KVSrc src{proj + C_KWB + g * 128, proj + C_VWB + g * 128, (size_t)NPROJ, L_SEQ - 1};
      const int kmin = t0 - 511 > 0 ? t0 - 511 : 0;
      flash_pass<2, 0>(lds, src, kmin >> 6, curlast + 1, Q, O, m, l, il, trow, tokl0, t0 + tokl0, tid, lane);
#pragma unroll
      for (int rg = 0; rg < 2; ++rg) { const float lr = nb_rowsum(l[rg]); gate[rg] = sigm(small[(size_t)trow[rg] * 256 + 32 + (g * 4 + (fr & 3)) * 3 + 2]); f[rg] = lr > 0.f ? gate[rg] / lr : 0.f; }
      nb_emit(ws, O, f, trow, g, 0, lane); }
    { m[0] = m[1] = -1e30f; l[0] = l[1] = 0.f;
      KVSrc src{(const bf16*)(ws + WS_KVC) + g * 128, (const bf16*)(ws + WS_KVC + 524288) + g * 128, (size_t)512, NCMP - 1};
      const int nt = ((tlast - 31) / 16) / 64 + 1;
      flash_pass<0, 1>(lds, src, 0, nt, Q, O, m, l, il, trow, tokl0, t0 + tokl0, tid, lane);
#pragma unroll
      for (int rg = 0; rg < 2; ++rg) { const float lr = nb_rowsum(l[rg]); il[rg] = lr > 0.f ? 1.0f / lr : 0.f; }
      flash_pass<0, 2>(lds, src, 0, nt, Q, O, m, l, il, trow, tokl0, t0 + tokl0, tid, lane);
#pragma unroll
      for (int rg = 0; rg < 2; ++rg) f[rg] = sigm(small[(size_t)trow[rg] * 256 + 32 + (g * 4 + (fr & 3)) * 3 + 0]);
      nb_emit(ws, O, f, trow, g, 1, lane); }
    __syncthreads();
#pragma unroll 1
    for (int tk = 0; tk < 8; ++tk) { const int tt = tokl0 + tk, t = t0 + tt, cur = t >> 6;
        unsigned u0, u1;
        { const int j0 = lane, j1 = lane + 64;
          const bool f0 = (j0 == 0) || (j0 == cur) || (j0 + 1 == cur), f1 = (j1 == cur) || (j1 + 1 == cur);
          u0 = f0 ? 0x7f800001u : (j0 <= cur ? __float_as_uint(IMP[tt * 128 + j0]) + 1u : 0u);
          u1 = f1 ? 0x7f800001u : (j1 <= cur ? __float_as_uint(IMP[tt * 128 + j1]) + 1u : 0u); }
        unsigned T = 0u;
#pragma unroll
        for (int bit = 31; bit >= 0; --bit) { const unsigned cand = T | (1u << bit);
            const int cnt = __popcll(__ballot(u0 >= cand)) + __popcll(__ballot(u1 >= cand));
            if (cnt >= 16) T = cand; }
        const unsigned long long g0 = __ballot(u0 > T), g1 = __ballot(u1 > T), e0 = __ballot(u0 == T), e1 = __ballot(u1 == T);
        const int need = 16 - (__popcll(g0) + __popcll(g1));
        const unsigned long long lt = (1ull << lane) - 1ull;
        const bool s0 = (u0 > T) || (u0 == T && __popcll(e0 & lt) < need);
        const bool s1 = (u1 > T) || (u1 == T && __popcll(e0) + __popcll(e1 & lt) < need);
        const unsigned long long m0 = __ballot(s0 && u0 != 0u), m1 = __ballot(s1 && u1 != 0u);
        if (lane == 0) { SEL[tt * 4 + 0] = (unsigned)m0; SEL[tt * 4 + 1] = (unsigned)(m0 >> 32); SEL[tt * 4 + 2] = (unsigned)m1; SEL[tt * 4 + 3] = (unsigned)(m1 >> 32); }
    }
    __syncthreads();
    { m[0] = m[1] = -1e30f; l[0] = l[1] = 0.f;
      KVSrc src{proj + C_KSB + g * 128, proj + C_VSB + g * 128, (size_t)NPROJ, L_SEQ - 1};
      flash_pass<1, 0>(lds, src, 0, curlast + 1, Q, O, m, l, il, trow, tokl0, t0 + tokl0, tid, lane);
#pragma unroll
      for (int rg = 0; rg < 2; ++rg) { const float lr = nb_rowsum(l[rg]); gate[rg] = sigm(small[(size_t)trow[rg] * 256 + 32 + (g * 4 + (fr & 3)) * 3 + 1]); f[rg] = lr > 0.f ? gate[rg] / lr : 0.f; }
      nb_emit(ws, O, f, trow, g, 2, lane); }
    __syncthreads();
}

__device__ __forceinline__ bf16x8 ldfrag_trN(const LAS bf16* img, int stride, int row0, int k0, int fr, int fq) {
    const int a = fr >> 2, p4 = fr & 3;
    const s16x4 v0 = __builtin_amdgcn_ds_read_tr16_b64_v4i16((LAS s16x4*)(img + (k0 + 8 * fq + a) * stride + row0 + 4 * p4));
    const s16x4 v1 = __builtin_amdgcn_ds_read_tr16_b64_v4i16((LAS s16x4*)(img + (k0 + 8 * fq + 4 + a) * stride + row0 + 4 * p4));
    return (bf16x8){v0[0], v0[1], v0[2], v0[3], v1[0], v1[1], v1[2], v1[3]};
}
__device__ __forceinline__ bf16x8 ldfrag_trP(const LAS bf16* img, int stride, int row0, int k0, int fr, int fq) {
    const int a = fr >> 2, p4 = fr & 3;
    const s16x4 v0 = __builtin_amdgcn_ds_read_tr16_b64_v4i16((LAS s16x4*)(img + (k0 + 4 * fq + a) * stride + row0 + 4 * p4));
    const s16x4 v1 = __builtin_amdgcn_ds_read_tr16_b64_v4i16((LAS s16x4*)(img + (k0 + 16 + 4 * fq + a) * stride + row0 + 4 * p4));
    return (bf16x8){v0[0], v0[1], v0[2], v0[3], v1[0], v1[1], v1[2], v1[3]};
}
__device__ __forceinline__ u32x4 pack8(const float (&o)[8]) { u32x4 w; w.x = pg8::cvt_pk_bf16(o[0], o[1]); w.y = pg8::cvt_pk_bf16(o[2], o[3]); w.z = pg8::cvt_pk_bf16(o[4], o[5]); w.w = pg8::cvt_pk_bf16(o[6], o[7]); return w; }
__device__ __forceinline__ void rotary8t(const u32x4 v, const float* rot, int t, int d0, float sc, float (&o)[8]) {
    const f32x4 r0 = *(const f32x4*)(rot + ((size_t)t * 128 + (d0 >> 1)) * 2), r1 = *(const f32x4*)(rot + ((size_t)t * 128 + (d0 >> 1)) * 2 + 4);
    const float x0 = blo(v.x), x1 = bhi(v.x), x2 = blo(v.y), x3 = bhi(v.y), x4 = blo(v.z), x5 = bhi(v.z), x6 = blo(v.w), x7 = bhi(v.w);
    o[0] = (x0 * r0[0] - x1 * r0[1]) * sc; o[1] = (x0 * r0[1] + x1 * r0[0]) * sc; o[2] = (x2 * r0[2] - x3 * r0[3]) * sc; o[3] = (x2 * r0[3] + x3 * r0[2]) * sc;
    o[4] = (x4 * r1[0] - x5 * r1[1]) * sc; o[5] = (x4 * r1[1] + x5 * r1[0]) * sc; o[6] = (x6 * r1[2] - x7 * r1[3]) * sc; o[7] = (x6 * r1[3] + x7 * r1[2]) * sc;
}

constexpr int SA2_XS = 0, SA2_BS = 69632, SA2_ACS = 106496, SA2_DTV = 108544;
__device__ __forceinline__ void ssd_states_unit2(ArgsP A, const LayerP& P, LAS unsigned char* lds, int c, int g, int tid, int lane, int wave) {
    tid = fresh(tid); lane = fresh(lane); wave = fresh_s(wave);
    unsigned char* ws = A->ws;
    const bf16* proj = (const bf16*)(ws + WS_PROJ); const float* small = (const float*)(ws + WS_SMALL);
    LAS bf16* XS = (LAS bf16*)(lds + SA2_XS); LAS bf16* BS = (LAS bf16*)(lds + SA2_BS);
    LAS float* acs = (LAS float*)(lds + SA2_ACS); LAS float* dtv = (LAS float*)(lds + SA2_DTV);
    const int t0 = c * 128;
    { const int l = tid >> 2, hh = tid & 3, h = g * 4 + hh, t = t0 + l;
      const float raw = small[(size_t)t * 256 + h] + P.dt_bias[h];
      const float dt = raw > 20.f ? raw : log1pf(expf(raw));
      const float a = -expf(P.a_log[h]) * dt;
      dtv[l * 4 + hh] = dt; acs[l * 4 + hh] = a;
      ((float*)(ws + WS_DTV))[(size_t)t * 32 + h] = dt; }
    __syncthreads();
    if (wave < 4) {
        const int hh = wave; const float v0 = acs[(2 * lane) * 4 + hh], v1 = acs[(2 * lane + 1) * 4 + hh]; float s = v0 + v1;
#pragma unroll
        for (int d = 1; d < 64; d <<= 1) { const float t = __shfl_up(s, d); if (lane >= d) s += t; }
        const float ex = s - (v0 + v1);
        acs[(2 * lane) * 4 + hh] = ex + v0; acs[(2 * lane + 1) * 4 + hh] = ex + v0 + v1;
    }
    __syncthreads();
    { const int l = tid >> 2, hh = tid & 3; ((float*)(ws + WS_ACS))[(size_t)(t0 + l) * 32 + g * 4 + hh] = acs[l * 4 + hh];
      if (tid < 4) ((float*)(ws + WS_CD))[c * 32 + g * 4 + tid] = __expf(acs[127 * 4 + tid]); }
#pragma unroll 4
    for (int item = fresh(tid); item < 48 * 128; item += 512) {
        const int l = item / 48, v = item % 48, t = t0 + l; float o[8];
        const bool isx = v < 32; const int hh = isx ? (v >> 3) : 0, n0 = (v - 32) * 8;
        const int col0 = isx ? C_XA + g * 256 + v * 8 : C_BA + g * 128 + n0, cch0 = isx ? g * 256 + v * 8 : 2048 + g * 128 + n0;
        conv8(proj, t, col0, P.conv_w, P.conv_b, cch0, o);
        const float sc = isx ? dtv[l * 4 + hh] * __expf(acs[127 * 4 + hh] - acs[l * 4 + hh]) : 1.0f;
#pragma unroll
        for (int i = 0; i < 8; ++i) o[i] *= sc;
        *(LAS u32x4*)(isx ? XS + l * 272 + v * 8 : BS + l * 144 + n0) = pack8(o);
    }
    __syncthreads();
    { f32x4 acc[2][8];
#pragma unroll
      for (int a = 0; a < 2; ++a)
#pragma unroll
          for (int b = 0; b < 8; ++b) acc[a][b] = (f32x4){0.f, 0.f, 0.f, 0.f};
      const int fr = lane & 15, fq = lane >> 4;
#pragma unroll
      for (int ks = 0; ks < 4; ++ks) {
          bf16x8 xf[2];
#pragma unroll
          for (int a = 0; a < 2; ++a) xf[a] = ldfrag_trP(XS, 272, wave * 32 + a * 16, ks * 32, fr, fq);
#pragma unroll
          for (int b = 0; b < 8; ++b) { const bf16x8 yf = ldfrag_trP(BS, 144, b * 16, ks * 32, fr, fq);
#pragma unroll
              for (int a = 0; a < 2; ++a) acc[a][b] = mma16(xf[a], yf, acc[a][b]); }
      }
      const int hh = wave >> 1, h = g * 4 + hh;
      float* st = (float*)(ws + WS_ST) + ((size_t)(c * 32 + h) * 64) * 128;
#pragma unroll
      for (int a = 0; a < 2; ++a)
#pragma unroll
          for (int b = 0; b < 8; ++b)
#pragma unroll
              for (int r = 0; r < 4; ++r) { const int p = (wave & 1) * 32 + a * 16 + fq * 4 + r, n = b * 16 + fr; st[(size_t)p * 128 + n] = acc[a][b][r]; }
    }
    __syncthreads();
}

constexpr int SC2_CM = 0, SC2_BM = 34816, SC2_MH = 69632, SC2_XS = 104448, SC2_PV = 122880, SC2_ACS = 140288, SC2_DTV = 142336;
__device__ __forceinline__ void ssd_out_unit2(ArgsP A, const LayerP& P, float* rowss, LAS unsigned char* lds, int c, int g, int tid, int lane, int wave) {
    tid = fresh(tid); lane = fresh(lane); wave = fresh_s(wave);
    unsigned char* ws = A->ws;
    const bf16* proj = (const bf16*)(ws + WS_PROJ);
    LAS bf16* CM = (LAS bf16*)(lds + SC2_CM); LAS bf16* BM = (LAS bf16*)(lds + SC2_BM); LAS bf16* MH = (LAS bf16*)(lds + SC2_MH);
    LAS bf16* XS = (LAS bf16*)(lds + SC2_XS); LAS bf16* PV = (LAS bf16*)(lds + SC2_PV);
    LAS float* acs = (LAS float*)(lds + SC2_ACS); LAS float* dtv = (LAS float*)(lds + SC2_DTV);
    const int t0 = c * 128, fr = lane & 15, fq = lane >> 4;
    { const int l = tid >> 2, hh = tid & 3; acs[l * 4 + hh] = ((const float*)(ws + WS_ACS))[(size_t)(t0 + l) * 32 + g * 4 + hh]; dtv[l * 4 + hh] = ((const float*)(ws + WS_DTV))[(size_t)(t0 + l) * 32 + g * 4 + hh]; }
#pragma unroll 4
    for (int item = fresh(tid); item < 32 * 128; item += 512) {
        const int l = item >> 5, v = item & 31, t = t0 + l; float o[8];
        const int n0 = (v & 15) * 8, ch = g * 128 + n0;
        conv8(proj, t, (v < 16 ? C_BA : C_CA) + ch, P.conv_w, P.conv_b, (v < 16 ? 2048 : 3072) + ch, o);
        *(LAS u32x4*)((v < 16 ? BM : CM) + l * 136 + n0) = pack8(o);
    }
    __syncthreads();
    f32x4 cb[8];
#pragma unroll
    for (int b = 0; b < 8; ++b) cb[b] = (f32x4){0.f, 0.f, 0.f, 0.f};
#pragma unroll
    for (int ks = 0; ks < 4; ++ks) { const bf16x8 xf = ldfrag(CM, 136, wave * 16 + fr, ks * 32 + fq * 8);
#pragma unroll
        for (int b = 0; b < 8; ++b) cb[b] = mma16(xf, ldfrag(BM, 136, b * 16 + fr, ks * 32 + fq * 8), cb[b]); }
    float ssq[4] = {0.f, 0.f, 0.f, 0.f};
    for (int hh = 0; hh < 4; ++hh) {
        const int h = g * 4 + hh;
#pragma unroll 2
        for (int item = fresh(tid); item < 8 * 128; item += 512) { const int l = item >> 3, v = item & 7, ch = h * 64 + v * 8; float o[8];
            conv8(proj, t0 + l, C_XA + ch, P.conv_w, P.conv_b, ch, o);
            *(LAS u32x4*)(XS + l * 72 + v * 8) = pack8(o); }
        { const float* st = (const float*)(ws + WS_ST) + ((size_t)(c * 32 + h) * 64) * 128;
#pragma unroll 2
          for (int item = fresh(tid); item < 64 * 16; item += 512) { const int p = item >> 4, n0 = (item & 15) * 8;
              const f32x4 a = *(const f32x4*)(st + p * 128 + n0), b = *(const f32x4*)(st + p * 128 + n0 + 4);
              u32x4 w; w.x = pg8::cvt_pk_bf16(a[0], a[1]); w.y = pg8::cvt_pk_bf16(a[2], a[3]); w.z = pg8::cvt_pk_bf16(b[0], b[1]); w.w = pg8::cvt_pk_bf16(b[2], b[3]);
              *(LAS u32x4*)(PV + p * 136 + n0) = w; } }
#pragma unroll
        for (int b = 0; b < 8; ++b)
#pragma unroll
            for (int r = 0; r < 4; ++r) { const int l = wave * 16 + fq * 4 + r, s = b * 16 + fr;
                const float v = (s <= l) ? cb[b][r] * __expf(acs[l * 4 + hh] - acs[s * 4 + hh]) * dtv[s * 4 + hh] : 0.f;
                MH[l * 136 + s] = (bf16)f2bf(v); }
        unsigned short zr[4][4];
#pragma unroll
        for (int r = 0; r < 4; ++r)
#pragma unroll
            for (int b = 0; b < 4; ++b) zr[r][b] = proj[(size_t)(t0 + wave * 16 + fq * 4 + r) * NPROJ + C_ZA + h * 64 + b * 16 + fr];
        __syncthreads();
        f32x4 yd[4], yo[4];
#pragma unroll
        for (int b = 0; b < 4; ++b) { yd[b] = (f32x4){0.f, 0.f, 0.f, 0.f}; yo[b] = (f32x4){0.f, 0.f, 0.f, 0.f}; }
#pragma unroll
        for (int ks = 0; ks < 4; ++ks) { const bf16x8 mf = ldfrag(MH, 136, wave * 16 + fr, ks * 32 + fq * 8), cf = ldfrag(CM, 136, wave * 16 + fr, ks * 32 + fq * 8);
#pragma unroll
            for (int b = 0; b < 4; ++b) { yd[b] = mma16(mf, ldfrag_trN(XS, 72, b * 16, ks * 32, fr, fq), yd[b]); yo[b] = mma16(cf, ldfrag(PV, 136, b * 16 + fr, ks * 32 + fq * 8), yo[b]); } }
        const float dsk = P.d_skip[h];
#pragma unroll
        for (int r = 0; r < 4; ++r) { const int l = wave * 16 + fq * 4 + r, t = t0 + l; const float ea = __expf(acs[l * 4 + hh]);
#pragma unroll
            for (int b = 0; b < 4; ++b) { const int p = b * 16 + fr, ch = h * 64 + p;
                const float xs = bf2f(XS[l * 72 + p]);
                const float y = yd[b][r] + yo[b][r] * ea + xs * dsk;
                const float z = bf2f(zr[r][b]);
                const float yg = y * siluf(z);
                ssq[r] += yg * yg;
                ((bf16*)(ws + WS_YA))[(size_t)t * DM + ch] = (bf16)f2bf(yg * P.ssm_norm[ch]); } }
        __syncthreads();
    }
#pragma unroll
    for (int r = 0; r < 4; ++r) { float s = ssq[r]; s += __shfl_xor(s, 1); s += __shfl_xor(s, 2); s += __shfl_xor(s, 4); s += __shfl_xor(s, 8);
        if (fr == 0) atomicAdd(rowss + t0 + wave * 16 + fq * 4 + r, s); }
}

constexpr int RA2_VS = 0, RA2_KS = 69632;
__device__ __forceinline__ void ret_kv_unit2(ArgsP A, LAS unsigned char* lds, int c, int h, int tid, int lane, int wave) {
    tid = fresh(tid); lane = fresh(lane); wave = fresh_s(wave);
    unsigned char* ws = A->ws; const bf16* proj = (const bf16*)(ws + WS_PROJ); const float* rot = (const float*)(ws + WS_ROT);
    LAS bf16* VS = (LAS bf16*)(lds + RA2_VS); LAS bf16* KS = (LAS bf16*)(lds + RA2_KS);
    const int t0 = c * 128; const float lg = ret_logg(h);
#pragma unroll 4
    for (int item = fresh(tid); item < 32 * 128; item += 512) { const int j = item >> 5, v = item & 31;
        *(LAS u32x4*)(VS + j * 272 + v * 8) = *(const u32x4*)(proj + (size_t)(t0 + j) * NPROJ + C_VC + h * 256 + v * 8); }
#pragma unroll 4
    for (int item = fresh(tid); item < 32 * 128; item += 512) { const int j = item >> 5, d0 = (item & 31) * 8, t = t0 + j; float o[8];
        const u32x4 w = *(const u32x4*)(proj + (size_t)t * NPROJ + C_KC + h * 256 + d0);
        rotary8t(w, rot, t, d0, 0.0625f * __expf(lg * (float)(127 - j)), o);
        *(LAS u32x4*)(KS + j * 272 + d0) = pack8(o); }
    __syncthreads();
    const int fr = lane & 15, fq = lane >> 4;
    float* out = (float*)(ws + WS_KVT) + (size_t)(c * 8 + h) * 65536;
    for (int half = 0; half < 2; ++half) {
        f32x4 acc[2][8];
#pragma unroll
        for (int a = 0; a < 2; ++a)
#pragma unroll
            for (int b = 0; b < 8; ++b) acc[a][b] = (f32x4){0.f, 0.f, 0.f, 0.f};
#pragma unroll
        for (int ks = 0; ks < 4; ++ks) { bf16x8 xf[2];
#pragma unroll
            for (int a = 0; a < 2; ++a) xf[a] = ldfrag_trP(VS, 272, wave * 32 + a * 16, ks * 32, fr, fq);
#pragma unroll
            for (int b = 0; b < 8; ++b) { const bf16x8 yf = ldfrag_trP(KS, 272, half * 128 + b * 16, ks * 32, fr, fq);
#pragma unroll
                for (int a = 0; a < 2; ++a) acc[a][b] = mma16(xf[a], yf, acc[a][b]); } }
#pragma unroll
        for (int a = 0; a < 2; ++a)
#pragma unroll
            for (int b = 0; b < 8; ++b)
#pragma unroll
                for (int r = 0; r < 4; ++r) { const int e = wave * 32 + a * 16 + fq * 4 + r, d = half * 128 + b * 16 + fr; out[(size_t)e * 256 + d] = acc[a][b][r]; }
    }
    __syncthreads();
}

constexpr int RC2_Q = 0, RC2_K = 67584, RC2_S = 67584, RC2_VS = 102400, RC2_RT = 67584;
__device__ __forceinline__ void ret_out_unit2(ArgsP A, const LayerP& P, LAS unsigned char* lds, int c, int h, int tid, int lane, int wave) {
    tid = fresh(tid); lane = fresh(lane); wave = fresh_s(wave);
    unsigned char* ws = A->ws; const bf16* proj = (const bf16*)(ws + WS_PROJ); const float* rot = (const float*)(ws + WS_ROT);
    LAS bf16* Q = (LAS bf16*)(lds + RC2_Q); LAS bf16* K = (LAS bf16*)(lds + RC2_K); LAS bf16* S = (LAS bf16*)(lds + RC2_S);
    LAS bf16* VS = (LAS bf16*)(lds + RC2_VS); LAS bf16* RT = (LAS bf16*)(lds + RC2_RT);
    const int t0 = c * 128, fr = lane & 15, fq = lane >> 4; const float lg = ret_logg(h);
#pragma unroll 8
    for (int item = fresh(tid); item < 64 * 128; item += 512) { const int j = item >> 6, v = item & 63, t = t0 + j, d0 = (v & 31) * 8; float o[8];
        const u32x4 w = *(const u32x4*)(proj + (size_t)t * NPROJ + (v < 32 ? C_QC : C_KC) + h * 256 + d0);
        rotary8t(w, rot, t, d0, v < 32 ? 1.0f : 0.0625f, o);
        *(LAS u32x4*)((v < 32 ? Q : K) + j * 264 + d0) = pack8(o); }
    __syncthreads();
    f32x4 sc[8];
#pragma unroll
    for (int b = 0; b < 8; ++b) sc[b] = (f32x4){0.f, 0.f, 0.f, 0.f};
#pragma unroll
    for (int ks = 0; ks < 8; ++ks) { const bf16x8 xf = ldfrag(Q, 264, wave * 16 + fr, ks * 32 + fq * 8);
#pragma unroll
        for (int b = 0; b < 8; ++b) sc[b] = mma16(xf, ldfrag(K, 264, b * 16 + fr, ks * 32 + fq * 8), sc[b]); }
    __syncthreads();
#pragma unroll
    for (int b = 0; b < 8; ++b)
#pragma unroll
        for (int r = 0; r < 4; ++r) { const int i = wave * 16 + fq * 4 + r, j = b * 16 + fr;
            S[i * 136 + j] = (bf16)f2bf(i >= j ? sc[b][r] * __expf(lg * (float)(i - j)) : 0.f); }
    f32x4 o[16];
#pragma unroll
    for (int b = 0; b < 16; ++b) o[b] = (f32x4){0.f, 0.f, 0.f, 0.f};
#pragma unroll
    for (int eh = 0; eh < 2; ++eh) {
#pragma unroll 4
        for (int item = fresh(tid); item < 16 * 128; item += 512) { const int j = item >> 4, v = item & 15;
            *(LAS u32x4*)(VS + j * 136 + v * 8) = *(const u32x4*)(proj + (size_t)(t0 + j) * NPROJ + C_VC + h * 256 + eh * 128 + v * 8); }
        __syncthreads();
#pragma unroll
        for (int ks = 0; ks < 4; ++ks) { const bf16x8 xf = ldfrag(S, 136, wave * 16 + fr, ks * 32 + fq * 8);
#pragma unroll
            for (int b = 0; b < 8; ++b) o[eh * 8 + b] = mma16(xf, ldfrag_trN(VS, 136, b * 16, ks * 32, fr, fq), o[eh * 8 + b]); }
        __syncthreads();
    }
    const float* kvt = (const float*)(ws + WS_KVT) + (size_t)(c * 8 + h) * 65536;
    float xi[4];
#pragma unroll
    for (int r = 0; r < 4; ++r) xi[r] = __expf(lg * (float)(wave * 16 + fq * 4 + r + 1));
#pragma unroll
    for (int eq = 0; eq < 4; ++eq) {
#pragma unroll 4
        for (int item = fresh(tid); item < 64 * 32; item += 512) { const int e = item >> 5, d0 = (item & 31) * 8;
            const f32x4 a = *(const f32x4*)(kvt + (size_t)(eq * 64 + e) * 256 + d0), b = *(const f32x4*)(kvt + (size_t)(eq * 64 + e) * 256 + d0 + 4);
            u32x4 w; w.x = pg8::cvt_pk_bf16(a[0], a[1]); w.y = pg8::cvt_pk_bf16(a[2], a[3]); w.z = pg8::cvt_pk_bf16(b[0], b[1]); w.w = pg8::cvt_pk_bf16(b[2], b[3]);
            *(LAS u32x4*)(RT + e * 264 + d0) = w; }
        __syncthreads();
        f32x4 cr[4];
#pragma unroll
        for (int b = 0; b < 4; ++b) cr[b] = (f32x4){0.f, 0.f, 0.f, 0.f};
#pragma unroll
        for (int ks = 0; ks < 8; ++ks) { const bf16x8 xf = ldfrag(Q, 264, wave * 16 + fr, ks * 32 + fq * 8);
#pragma unroll
            for (int b = 0; b < 4; ++b) cr[b] = mma16(xf, ldfrag(RT, 264, b * 16 + fr, ks * 32 + fq * 8), cr[b]); }
#pragma unroll
        for (int b = 0; b < 4; ++b)
#pragma unroll
            for (int r = 0; r < 4; ++r) o[eq * 4 + b][r] += cr[b][r] * xi[r];
        __syncthreads();
    }
#pragma unroll
    for (int r = 0; r < 4; ++r) {
        float s = 0.f;
#pragma unroll
        for (int b = 0; b < 16; ++b) s += o[b][r];
        s += __shfl_xor(s, 1); s += __shfl_xor(s, 2); s += __shfl_xor(s, 4); s += __shfl_xor(s, 8);
        const float mu = s * (1.0f / 256.0f); float q = 0.f;
#pragma unroll
        for (int b = 0; b < 16; ++b) { const float d = o[b][r] - mu; q += d * d; }
        q += __shfl_xor(q, 1); q += __shfl_xor(q, 2); q += __shfl_xor(q, 4); q += __shfl_xor(q, 8);
        const float rs = rsqrtf(q * (1.0f / 256.0f) + EPS);
        const int t = t0 + wave * 16 + fq * 4 + r;
#pragma unroll
        for (int hb = 0; hb < 16; hb += 8) {
            unsigned short zv[8]; float nw[8];
#pragma unroll
            for (int b = 0; b < 8; ++b) { const int ch = h * 256 + (hb + b) * 16 + fr; zv[b] = proj[(size_t)t * NPROJ + C_ZC + ch]; nw[b] = P.ret_norm[ch]; }
#pragma unroll
            for (int b = 0; b < 8; ++b) { const int ch = h * 256 + (hb + b) * 16 + fr;
                ((bf16*)(ws + WS_YC))[(size_t)t * DM + ch] = (bf16)f2bf((o[hb + b][r] - mu) * rs * nw[b] * siluf(bf2f(zv[b]))); } }
    }
    __syncthreads();
}

__device__ __forceinline__ void norm_pass1(const float* xin, const float* o, const float* rowss, const float* gain, float* x1, bf16* h2, int gw, int NGW, int lane) {
    for (int m = gw; m < L_SEQ; m += NGW) {
        const float rs = rsqrtf(rowss[m] * (1.0f / 2048.0f) + EPS); f32x4 v[8]; float s = 0.f;
#pragma unroll
        for (int j = 0; j < 8; ++j) { const size_t off = (size_t)m * DM + 4 * lane + 256 * j; const f32x4 xo = *(const f32x4*)(xin + off), oo = *(const f32x4*)(o + off), g = *(const f32x4*)(gain + 4 * lane + 256 * j);
            v[j] = xo + oo * rs * g; *(f32x4*)(x1 + off) = v[j]; s += (v[j][0] * v[j][0] + v[j][1] * v[j][1]) + (v[j][2] * v[j][2] + v[j][3] * v[j][3]); }
        const float r2 = rsqrtf(wave_sum(s) * (1.0f / 2048.0f) + EPS);
#pragma unroll
        for (int j = 0; j < 8; ++j) { u32x2 w; w.x = pk2(v[j][0] * r2, v[j][1] * r2); w.y = pk2(v[j][2] * r2, v[j][3] * r2); *(u32x2*)(h2 + (size_t)m * DM + 4 * lane + 256 * j) = w; }
    }
}
__device__ __forceinline__ void norm_pass2(const float* x1, const float* vv, const float* rowss, const float* gain, float* xout, bf16* hn, const float* gain_next, int gw, int NGW, int lane) {
    for (int m = gw; m < L_SEQ; m += NGW) {
        const float rs = rsqrtf(rowss[m] * (1.0f / 2048.0f) + EPS); f32x4 v[8]; float s = 0.f;
#pragma unroll
        for (int j = 0; j < 8; ++j) { const size_t off = (size_t)m * DM + 4 * lane + 256 * j; const f32x4 xo = *(const f32x4*)(x1 + off), oo = *(const f32x4*)(vv + off), g = *(const f32x4*)(gain + 4 * lane + 256 * j);
            v[j] = xo + oo * rs * g; *(f32x4*)(xout + off) = v[j]; s += (v[j][0] * v[j][0] + v[j][1] * v[j][1]) + (v[j][2] * v[j][2] + v[j][3] * v[j][3]); }
        if (hn) { const float r2 = rsqrtf(wave_sum(s) * (1.0f / 2048.0f) + EPS);
#pragma unroll
            for (int j = 0; j < 8; ++j) { const f32x4 g = *(const f32x4*)(gain_next + 4 * lane + 256 * j);
                u32x2 w; w.x = pk2(v[j][0] * r2 * g[0], v[j][1] * r2 * g[1]); w.y = pk2(v[j][2] * r2 * g[2], v[j][3] * r2 * g[3]); *(u32x2*)(hn + (size_t)m * DM + 4 * lane + 256 * j) = w; } }
    }
}

#ifndef PHMASK
#define PHMASK 0xFFFF
#endif
#define PHEN(k) ((PHMASK >> (k)) & 1)
#ifndef REP_PHASE
#define REP_PHASE -1
#endif
#define REP(k) ((REP_PHASE == (k)) ? 2 : 1)
#define JUNKSS ((float*)(ws + 768 * 1024))
#ifndef SUBMASK
#define SUBMASK 0xFFFF
#endif
#define SUBEN(k) ((SUBMASK >> (k)) & 1)
constexpr int PH_PER_LAYER = 10, N_PHASES = 1 + NLAYER * PH_PER_LAYER;
__global__ void __launch_bounds__(512, 2) hyb_fwd(Args Aval) {
    extern __shared__ __attribute__((aligned(16))) unsigned char lds_raw[];
    LAS unsigned char* lds = (LAS unsigned char*)lds_raw;
    const int wave = __builtin_amdgcn_readfirstlane((int)threadIdx.x >> 6);
    const int G = gridDim.x, bid = blockIdx.x;
    { const int tid0 = threadIdx.x;
      for (int u = tid0; u < 128; u += 512) ((LAS unsigned*)(lds + MISC_OFF))[u] = 0u;
      if (tid0 < 128) ((LAS float*)(lds + MISC_OFF + 512))[tid0] = (float)exp2(-(double)(2 * tid0) * (13.287712379549449 / 256.0)); }
#define lane ((int)__builtin_amdgcn_mbcnt_hi(~0u, __builtin_amdgcn_mbcnt_lo(~0u, 0u)))
#define tid (wave * 64 + lane)
    __syncthreads();
    int lo, hi, use_bar; XcdBarrier bar;
    { ArgsP A = argp(); lo = A->ph_lo; hi = A->ph_hi; use_bar = A->use_bar;
      bar.bar = (unsigned*)(A->ws + WS_CTL) + CW_BAR; bar.x = 0; bar.st = (volatile LAS unsigned*)(lds + MISC_OFF) + 8;
      if (use_bar) bar = xcd_barrier_post((unsigned*)(A->ws + WS_CTL) + CW_BAR, (volatile LAS unsigned*)(lds + MISC_OFF) + 8); }
#define IN(k) (lo <= (k) && (k) < hi)
#define SEAM(k) do { if (use_bar && IN(k) && IN((k) + 1)) xcd_barrier(bar); } while (0)
#define LAYERP(P) LayerP P; P.conv_w = A->in[5] + (size_t)l * 4 * 4096; P.conv_b = A->in[6] + (size_t)l * 4096; P.dt_bias = A->in[7] + l * 32; P.a_log = A->in[8] + l * 32; P.d_skip = A->in[9] + l * 32; \
        P.ssm_norm = A->in[10] + l * 2048; P.ret_norm = A->in[14] + l * 2048
#define ROWSS(k) ((float*)(ws + ROWSS_OFF) + (l * 3 + (k)) * L_SEQ)

    if (PHEN(0) && IN(0)) for (int rep = 0; rep < REP(0); ++rep) { ArgsP A = argp(); phase_prologue(A, lds, fresh(tid), fresh(lane), fresh_s(wave), G, bid); }
    SEAM(0);

    for (int l = 0; l < NLAYER; ++l) {
        const int pb = 1 + l * PH_PER_LAYER;
        if (PHEN(1) && IN(pb + 0)) for (int rep = 0; rep < REP(1); ++rep) { ArgsP A = argp(); unsigned char* ws = A->ws;
            pg8::Gemm g{(const bf16*)(ws + WS_HBF), (const bf16*)(ws + WS_WIN + (size_t)l * SZ_WIN), L_SEQ, NPAD, DM}; pg8::StaticOrder S; S.init(L_SEQ, NPAD, G, bid);
            pg8::EpiInProj E{(bf16*)(ws + WS_PROJ), NPROJ, (float*)(ws + WS_SMALL), NPROJ / 256};
            pg8::gemm_phase<pg8::EpiInProj, pg8::StaticOrder, true, true>(lds, g, S, E, wave);
        }
        SEAM(pb + 0);
        if (PHEN(2) && IN(pb + 1)) for (int rep = 0; rep < REP(2); ++rep) {
            if (SUBEN(1)) { ArgsP A = argp(); LAYERP(P);
              for (int u = bid; u < 512; u += G) ssd_states_unit2(A, P, lds, u >> 3, u & 7, tid, lane, wave); }
            if (SUBEN(2)) { ArgsP A = argp();
              for (int u = bid; u < 512; u += G) ret_kv_unit2(A, lds, u >> 3, u & 7, tid, lane, wave); }
            if (SUBEN(3)) { ArgsP A = argp(); nsa_im2col(A, fresh(tid), bid, G);
              if (l == 0 && bid == G - 1) { unsigned char* ws = A->ws;
                  for (int o = fresh(tid); o < 1024; o += 512) { const float* pp = (const float*)(ws + WS_HBP) + (size_t)(o >> 8) * 64 * 256 + (o & 255); float s = 0.f;
                      for (int ck = 0; ck < 64; ++ck) s += pp[ck * 256];
                      ((float*)(ws + WS_HB))[o] = s; } } }
        }
        SEAM(pb + 1);
        if (PHEN(3) && IN(pb + 2)) {
            for (int rep = 0; rep < REP(3); ++rep)
#pragma unroll
            for (int s = 0; s < 2; ++s) { ArgsP A = argp(); unsigned char* ws = A->ws;
                pg8::Gemm g{(const bf16*)(ws + WS_AIM + (size_t)s * 16 * MiB), (const bf16*)(ws + WS_WC1 + (size_t)(l * 2 + s) * 2 * MiB), 2048, 256, 4096}; pg8::StaticOrder S; S.init(2048, 256, G, (bid + G - 8 * s) % G);
                pg8::EpiCmp1 E{(bf16*)(ws + WS_HID + (size_t)s * MiB), (const float*)(ws + WS_HB) + (l * 2 + s) * 256};
                pg8::gemm_phase<pg8::EpiCmp1, pg8::StaticOrder, true, true>(lds, g, S, E, wave);
                __syncthreads();
            }
            if (bid >= 16) { ArgsP A = argp(); ssd_scan(A, fresh(tid), bid - 16, G - 16); ret_scan(A, fresh(tid), bid - 16, G - 16); }
        }
        SEAM(pb + 2);
        if (PHEN(4) && IN(pb + 3)) for (int rep = 0; rep < REP(4); ++rep) {
#pragma unroll
            for (int s = 0; s < 2; ++s) { ArgsP A = argp(); unsigned char* ws = A->ws;
                pg8::Gemm g{(const bf16*)(ws + WS_HID + (size_t)s * MiB), (const bf16*)(ws + WS_WC2 + (size_t)(l * 2 + s) * 131072), 2048, 256, 256}; pg8::StaticOrder S; S.init(2048, 256, G, (bid + G - 8 * s) % G);
                pg8::EpiCmp2 E{(bf16*)(ws + WS_KVC + (size_t)s * 524288)};
                pg8::gemm_phase<pg8::EpiCmp2, pg8::StaticOrder, true, true>(lds, g, S, E, wave);
                __syncthreads();
            }
            if (SUBEN(5)) { ArgsP A = argp(); unsigned char* ws = A->ws; LAYERP(P);
              for (int u = bid; u < 512; u += G) ssd_out_unit2(A, P, rep ? JUNKSS : ROWSS(0), lds, u >> 3, u & 7, tid, lane, wave); }
            if (SUBEN(6)) { ArgsP A = argp(); LAYERP(P);
              for (int u = bid; u < 512; u += G) ret_out_unit2(A, P, lds, u >> 3, u & 7, tid, lane, wave); }
        }
        SEAM(pb + 3);
        if (PHEN(5) && IN(pb + 4)) for (int rep = 0; rep < REP(5); ++rep) { ArgsP A = argp();
            for (int u = bid; u < 512; u += G) { const int idx = u >> 2, g = u & 3; const int qt = idx < 64 ? idx : 191 - idx;
                nsa_attn2_unit(A, lds, qt, g, tid, lane, wave); }
        }
        SEAM(pb + 4);
        if (PHEN(6) && IN(pb + 5)) for (int rep = 0; rep < REP(6); ++rep) {
            { ArgsP A = argp(); unsigned char* ws = A->ws;
              pg8::Gemm g{(const bf16*)(ws + WS_YA), (const bf16*)(ws + WS_WBR + (size_t)(l * 3 + 0) * 8 * MiB), L_SEQ, DM, DM}; pg8::StaticOrder S; S.init(L_SEQ, DM, G, bid);
              pg8::EpiBranch<0> E{(bf16*)(ws + WS_TF), (bf16*)(ws + WS_MB), (const bf16*)(ws + WS_PROJ) + C_GM, NPROJ, ROWSS(0), EPS};
              pg8::gemm_phase<pg8::EpiBranch<0>, pg8::StaticOrder, true, true>(lds, g, S, E, wave); }
            __syncthreads();
            { ArgsP A = argp(); unsigned char* ws = A->ws;
              pg8::Gemm g{(const bf16*)(ws + WS_YB), (const bf16*)(ws + WS_WBR + (size_t)(l * 3 + 1) * 8 * MiB), L_SEQ, DM, DM}; pg8::StaticOrder S; S.init(L_SEQ, DM, G, bid);
              pg8::EpiBranch<1> E{(bf16*)(ws + WS_TF), (bf16*)(ws + WS_MB), (const bf16*)(ws + WS_PROJ) + C_GM + 2048, NPROJ, ROWSS(0), EPS};
              pg8::gemm_phase<pg8::EpiBranch<1>, pg8::StaticOrder, true, true>(lds, g, S, E, wave); }
            __syncthreads();
            { ArgsP A = argp(); unsigned char* ws = A->ws;
              pg8::Gemm g{(const bf16*)(ws + WS_YC), (const bf16*)(ws + WS_WBR + (size_t)(l * 3 + 2) * 8 * MiB), L_SEQ, DM, DM}; pg8::StaticOrder S; S.init(L_SEQ, DM, G, bid);
              pg8::EpiBranch<2> E{(bf16*)(ws + WS_TF), (bf16*)(ws + WS_MB), (const bf16*)(ws + WS_PROJ) + C_GM + 4096, NPROJ, ROWSS(0), EPS};
              pg8::gemm_phase<pg8::EpiBranch<2>, pg8::StaticOrder, true, true>(lds, g, S, E, wave); }
        }
        SEAM(pb + 5);
        if (PHEN(7) && IN(pb + 6)) for (int rep = 0; rep < REP(7); ++rep) { ArgsP A = argp(); unsigned char* ws = A->ws;
            pg8::Gemm g{(const bf16*)(ws + WS_MB), (const bf16*)(ws + WS_WOUT + (size_t)l * 8 * MiB), L_SEQ, DM, DM}; pg8::StaticOrder S; S.init(L_SEQ, DM, G, bid);
            pg8::EpiRowSS<0> E{(float*)(ws + WS_TF), nullptr, rep ? JUNKSS : ROWSS(1)};
            pg8::gemm_phase<pg8::EpiRowSS<0>, pg8::StaticOrder, true, true>(lds, g, S, E, wave);
        }
        SEAM(pb + 6);
        if (PHEN(8) && IN(pb + 7)) for (int rep = 0; rep < REP(8); ++rep) {
            if (SUBEN(0)) { ArgsP A = argp(); unsigned char* ws = A->ws;
              pg8::Gemm g{(const bf16*)(ws + WS_PBF) + (size_t)l * L_SEQ * PDIM, (const bf16*)(ws + WS_WPP + (size_t)l * MiB), L_SEQ, DM, fresh_s(PDIM)}; pg8::StaticOrder S; S.init(L_SEQ, DM, G, bid);
              pg8::EpiF32 E{(float*)(ws + WS_EBUF), DM};
              pg8::gemm_phase<pg8::EpiF32, pg8::StaticOrder, true, true>(lds, g, S, E, wave); }
            __syncthreads();
          { ArgsP A = argp(); unsigned char* ws = A->ws;
            norm_pass1(l == 0 ? A->in[0] : (const float*)(ws + WS_XL), (const float*)(ws + WS_TF), ROWSS(1), A->in[3] + l * 2048, (float*)(ws + WS_X1), (bf16*)(ws + WS_HBF), bid * 8 + fresh_s(wave), G * 8, fresh(lane)); } }
        SEAM(pb + 7);
        if (PHEN(9) && IN(pb + 8)) for (int rep = 0; rep < REP(7); ++rep) { ArgsP A = argp(); unsigned char* ws = A->ws;
            pg8::Gemm g{(const bf16*)(ws + WS_HBF), (const bf16*)(ws + WS_WGATE + (size_t)l * 8 * MiB), L_SEQ, DM, DM}; pg8::StaticOrder S; S.init(L_SEQ, DM, G, bid);
            pg8::EpiRowSS<1> E{(float*)(ws + WS_TF), (const float*)(ws + WS_EBUF), rep ? JUNKSS : ROWSS(2)};
            pg8::gemm_phase<pg8::EpiRowSS<1>, pg8::StaticOrder, true, true>(lds, g, S, E, wave);
        }
        SEAM(pb + 8);
        if (PHEN(10) && IN(pb + 9)) for (int rep = 0; rep < REP(8); ++rep) { ArgsP A = argp(); unsigned char* ws = A->ws;
            norm_pass2((const float*)(ws + WS_X1), (const float*)(ws + WS_TF), ROWSS(2), A->in[19] + l * 2048, l == NLAYER - 1 ? A->out : (float*)(ws + WS_XL),
                       l + 1 < NLAYER ? (bf16*)(ws + WS_HBF) : nullptr, l + 1 < NLAYER ? A->in[2] + (l + 1) * 2048 : nullptr, bid * 8 + fresh_s(wave), G * 8, fresh(lane)); }
        SEAM(pb + 9);
    }
#undef IN
#undef SEAM
#undef lane
#undef tid
}

#ifndef MK_ONE_LAUNCH
#define MK_ONE_LAUNCH 1
#endif
extern "C" void kernel_launch(void* const* d_in, const int* in_sizes, int n_in, void* d_out, int out_size, void* d_ws, size_t ws_size, hipStream_t stream) {
    static int grid = 0;
    if (grid == 0) {
        if (n_in != 20 || out_size != L_SEQ * DM || ws_size < WS_END) { fprintf(stderr, "kernel_launch: unexpected shapes (n_in %d, out %d, ws %zu < %zu)\n", n_in, out_size, ws_size, (size_t)WS_END); grid = -1; return; }
        int dev = 0, cus = 0, per_cu = 0;
        if (hipGetDevice(&dev) != hipSuccess || hipDeviceGetAttribute(&cus, hipDeviceAttributeMultiprocessorCount, dev) != hipSuccess) { grid = -1; return; }
        if (hipFuncSetAttribute((const void*)hyb_fwd, hipFuncAttributeMaxDynamicSharedMemorySize, LDS_BYTES) != hipSuccess) { fprintf(stderr, "kernel_launch: hipFuncSetAttribute failed\n"); grid = -1; return; }
        if (hipOccupancyMaxActiveBlocksPerMultiprocessor(&per_cu, (const void*)hyb_fwd, 512, LDS_BYTES) != hipSuccess || per_cu < 1) { fprintf(stderr, "kernel_launch: occupancy query says %d\n", per_cu); (void)hipGetLastError(); grid = -1; return; }
        grid = cus;
    }
    if (grid < 0) return;
    if (hipMemsetAsync((char*)d_ws + WS_CTL, 0, CTL_ZERO_BYTES, stream) != hipSuccess) return;
    Args a{};
    for (int i = 0; i < 20; ++i) a.in[i] = (const float*)d_in[i];
    a.out = (float*)d_out; a.ws = (unsigned char*)d_ws; a.pad = 0;
#if MK_ONE_LAUNCH
    a.ph_lo = 0; a.ph_hi = N_PHASES; a.use_bar = 1;
    hipLaunchKernelGGL(hyb_fwd, dim3(grid), dim3(512), LDS_BYTES, stream, a);
#else
    for (int ph = 0; ph < N_PHASES; ++ph) { a.ph_lo = ph; a.ph_hi = ph + 1; a.use_bar = 0; hipLaunchKernelGGL(hyb_fwd, dim3(grid), dim3(512), LDS_BYTES, stream, a); }
#endif
}
```
